# Optimizing an MI355X kernel written in HIP

```python
import math
import jax, jax.numpy as jnp
from jax import lax
import numpy as np

D_MODEL = 1024
BATCH = 4
SEQ = 8192
DEPTH = 1

N_META = 16
RWKV_WIDTH = D_MODEL // 2
HEAD_DIM = 64
RWKV_HEADS = RWKV_WIDTH // HEAD_DIM
W_LORA = 64
A_LORA = 64
G_LORA = 128
RWKV_PROJ = 3 * RWKV_WIDTH + W_LORA + A_LORA + G_LORA
RWKV_SPLITS = [RWKV_WIDTH, 2 * RWKV_WIDTH, 3 * RWKV_WIDTH, 3 * RWKV_WIDTH + W_LORA, 3 * RWKV_WIDTH + W_LORA + A_LORA]
GN_EPS = 64e-5
S5_WIDTH = D_MODEL // 2
S5_GROUP = 16
S5_GROUPS = S5_WIDTH // S5_GROUP
S5_STATE = 64
N_BRANCH = 2
PROJ_WIDTH = RWKV_PROJ + S5_WIDTH + N_BRANCH * D_MODEL
D_FF = 2816
CONV_W = 3
RMS_EPS = 1e-6

kernel_name = "rwkv7_s5_gated_hybrid_block"


def _rms_norm(x, g):
    xf = x.astype(jnp.float32)
    y = xf * lax.rsqrt(jnp.mean(xf * xf, axis=-1, keepdims=True) + RMS_EPS)
    return (y * g.astype(jnp.float32)).astype(x.dtype)


def _token_shift(p):
    return jnp.pad(p, ((0, 0), (1, 0), (0, 0)))[:, :-1, :]


def _rwkv7_step(S, inp):
    r_t, w_t, k_t, v_t, kk_t, b_t = inp
    sa = jnp.einsum('bhvk,bhk->bhv', S, -kk_t)
    S = S * w_t[:, :, None, :] + sa[..., None] * b_t[:, :, None, :] + v_t[..., None] * k_t[:, :, None, :]
    y = jnp.einsum('bhvk,bhk->bhv', S, r_t)
    return S, y


def _rwkv7_branch(p, mu, w0, w_up, a0, a_up, g_up, k_k, k_a, r_k, ln_g, ln_b, w_branch):
    f32 = jnp.float32
    bsz, t_len, _ = p.shape
    p = p + (_token_shift(p) - p) * mu
    r, k, v, wd, ad, gd = jnp.split(p, RWKV_SPLITS, axis=-1)
    w_log = -jax.nn.softplus(-(w0 + jnp.tanh(wd) @ w_up)) - 0.5
    decay = jnp.exp(-jnp.exp(w_log.astype(f32)))
    a = jax.nn.sigmoid(a0 + ad @ a_up)
    g = jax.nn.sigmoid(gd) @ g_up

    def heads(t):
        return t.astype(f32).reshape(bsz, t_len, RWKV_HEADS, HEAD_DIM)

    kk = heads(k * k_k)
    kk = kk / jnp.maximum(jnp.linalg.norm(kk, axis=-1, keepdims=True), 1e-12)
    k = k * (1 + (a - 1) * k_a)
    r_h, k_h, v_h, w_h, a_h = heads(r), heads(k), heads(v), heads(decay), heads(a)

    def tm(t):
        return jnp.moveaxis(t, 1, 0)

    s0 = jnp.zeros((bsz, RWKV_HEADS, HEAD_DIM, HEAD_DIM), f32)
    _, y = lax.scan(_rwkv7_step, s0, (tm(r_h), tm(w_h), tm(k_h), tm(v_h), tm(kk), tm(kk * a_h)))
    y = jnp.moveaxis(y, 0, 1)
    mean = jnp.mean(y, axis=-1, keepdims=True)
    var = jnp.mean(jnp.square(y - mean), axis=-1, keepdims=True)
    y = ((y - mean) * lax.rsqrt(var + GN_EPS)).reshape(bsz, t_len, RWKV_WIDTH)
    y = y * ln_g.astype(f32) + ln_b.astype(f32)
    bonus = jnp.sum(r_h * k_h * r_k.astype(f32), axis=-1, keepdims=True) * v_h
    y = (y + bonus.reshape(bsz, t_len, RWKV_WIDTH)) * g.astype(f32)
    return y.astype(p.dtype) @ w_branch


def _ssm_combine(e1, e2):
    a1, b1 = e1
    a2, b2 = e2
    return a1 * a2, a2 * b1 + b2


def _s5_branch(u, lam_re, lam_im, log_dt, b_re, b_im, c_re, c_im, d, w_glu):
    f32 = jnp.float32
    bsz, t_len, _ = u.shape
    ut = jnp.moveaxis(u.astype(f32).reshape(bsz, t_len, S5_GROUPS, S5_GROUP), 1, 0)
    lam = lax.complex(jnp.minimum(lam_re.astype(f32), -1e-4), lam_im.astype(f32))
    dt = jnp.exp(log_dt.astype(f32))[:, None]
    lam_bar = jnp.exp(lam * dt)
    b_bar = ((lam_bar - 1) / lam)[..., None] * lax.complex(b_re.astype(f32), b_im.astype(f32))
    bu = jnp.einsum('tbgh,gnh->tbgn', ut.astype(jnp.complex64), b_bar)
    a_el = jnp.broadcast_to(lam_bar, (t_len, 1) + lam_bar.shape)
    _, xs = lax.associative_scan(_ssm_combine, (a_el, bu), axis=0)
    c = lax.complex(c_re.astype(f32), c_im.astype(f32))
    y = jnp.einsum('tbgn,ghn->tbgh', xs, c).real + d.astype(f32).reshape(S5_GROUPS, S5_GROUP) * ut
    y = jnp.moveaxis(y, 0, 1).reshape(bsz, t_len, S5_WIDTH)
    y = jax.nn.gelu(y).astype(u.dtype)
    z = y @ w_glu
    return z[..., :D_MODEL] * jax.nn.sigmoid(z[..., D_MODEL:])


def _causal_dwconv(a, w, b):
    c = w.shape[-1]
    y = lax.conv_general_dilated(a, w[:, None, :].astype(a.dtype), window_strides=(1,),
                                 padding=[(CONV_W - 1, 0)], dimension_numbers=('NWC', 'WIO', 'NWC'),
                                 feature_group_count=c)
    return y + b


def setup_inputs(seed: int = 0) -> dict:
    key = jax.random.key(seed)
    ks = iter(jax.random.split(key, 40))
    L = DEPTH

    def nrm(shape, scale):
        return jax.random.normal(next(ks), shape, jnp.float32) * scale

    def unif(shape, lo, hi):
        return jax.random.uniform(next(ks), shape, jnp.float32, lo, hi)

    lam_im0 = jnp.broadcast_to(math.pi * jnp.arange(S5_STATE, dtype=jnp.float32), (L, S5_GROUPS, S5_STATE))
    return {
        "x": nrm((BATCH, SEQ, D_MODEL), 1.0),
        "meta_tokens": nrm((N_META, D_MODEL), 1.0),
        "norm_mix_pre": 1.0 + nrm((L, D_MODEL), 0.02),
        "norm_mix_post": 1.0 + nrm((L, D_MODEL), 0.02),
        "w_in": nrm((L, D_MODEL, PROJ_WIDTH), D_MODEL ** -0.5),
        "rwkv_shift_mu": unif((L, RWKV_PROJ), 0.0, 1.0),
        "rwkv_w0": unif((L, RWKV_WIDTH), -6.0, 1.0),
        "rwkv_w_up": nrm((L, W_LORA, RWKV_WIDTH), 0.1),
        "rwkv_a0": nrm((L, RWKV_WIDTH), 0.1),
        "rwkv_a_up": nrm((L, A_LORA, RWKV_WIDTH), 0.1),
        "rwkv_g_up": nrm((L, G_LORA, RWKV_WIDTH), G_LORA ** -0.5),
        "rwkv_k_k": 0.85 + nrm((L, RWKV_WIDTH), 0.02),
        "rwkv_k_a": 1.0 + nrm((L, RWKV_WIDTH), 0.02),
        "rwkv_r_k": nrm((L, RWKV_HEADS, HEAD_DIM), 0.1),
        "rwkv_ln_gain": 1.0 + nrm((L, RWKV_WIDTH), 0.02),
        "rwkv_ln_bias": nrm((L, RWKV_WIDTH), 0.02),
        "rwkv_w_branch": nrm((L, RWKV_WIDTH, D_MODEL), RWKV_WIDTH ** -0.5),
        "s5_lambda_re": -0.5 + nrm((L, S5_GROUPS, S5_STATE), 0.01),
        "s5_lambda_im": lam_im0 + nrm((L, S5_GROUPS, S5_STATE), 0.01),
        "s5_log_dt": unif((L, S5_GROUPS), math.log(1e-3), math.log(1e-1)),
        "s5_b_re": nrm((L, S5_GROUPS, S5_STATE, S5_GROUP), (2 * S5_GROUP) ** -0.5),
        "s5_b_im": nrm((L, S5_GROUPS, S5_STATE, S5_GROUP), (2 * S5_GROUP) ** -0.5),
        "s5_c_re": nrm((L, S5_GROUPS, S5_GROUP, S5_STATE), (2 * S5_STATE) ** -0.5),
        "s5_c_im": nrm((L, S5_GROUPS, S5_GROUP, S5_STATE), (2 * S5_STATE) ** -0.5),
        "s5_d": nrm((L, S5_WIDTH), 1.0),
        "s5_w_glu": nrm((L, S5_WIDTH, 2 * D_MODEL), S5_WIDTH ** -0.5),
        "w_out": nrm((L, D_MODEL, D_MODEL), D_MODEL ** -0.5),
        "norm_ffn_pre": 1.0 + nrm((L, D_MODEL), 0.02),
        "norm_ffn_post": 1.0 + nrm((L, D_MODEL), 0.02),
        "ffn_w_up": nrm((L, D_MODEL, 2 * D_FF), D_MODEL ** -0.5),
        "ffn_conv_w": nrm((L, CONV_W, D_FF), CONV_W ** -0.5),
        "ffn_conv_b": nrm((L, D_FF), 0.02),
        "ffn_w_down": nrm((L, D_FF, D_MODEL), D_FF ** -0.5),
    }


def reference(x, meta_tokens, norm_mix_pre, norm_mix_post, w_in, rwkv_shift_mu, rwkv_w0, rwkv_w_up,
              rwkv_a0, rwkv_a_up, rwkv_g_up, rwkv_k_k, rwkv_k_a, rwkv_r_k, rwkv_ln_gain, rwkv_ln_bias,
              rwkv_w_branch, s5_lambda_re, s5_lambda_im, s5_log_dt, s5_b_re, s5_b_im, s5_c_re, s5_c_im,
              s5_d, s5_w_glu, w_out, norm_ffn_pre, norm_ffn_post, ffn_w_up, ffn_conv_w, ffn_conv_b,
              ffn_w_down):
    bsz = x.shape[0]
    meta = jnp.broadcast_to(meta_tokens[None].astype(x.dtype), (bsz, N_META, D_MODEL))
    h = jnp.concatenate([meta, x], axis=1)
    for l in range(DEPTH):
        hn = _rms_norm(h, norm_mix_pre[l])
        proj = hn @ w_in[l]
        p_rwkv = proj[..., :RWKV_PROJ]
        u_s5 = proj[..., RWKV_PROJ:RWKV_PROJ + S5_WIDTH]
        gates = jax.nn.sigmoid(proj[..., RWKV_PROJ + S5_WIDTH:])
        y_a = _rwkv7_branch(p_rwkv, rwkv_shift_mu[l], rwkv_w0[l], rwkv_w_up[l], rwkv_a0[l], rwkv_a_up[l],
                            rwkv_g_up[l], rwkv_k_k[l], rwkv_k_a[l], rwkv_r_k[l], rwkv_ln_gain[l],
                            rwkv_ln_bias[l], rwkv_w_branch[l])
        y_b = _s5_branch(u_s5, s5_lambda_re[l], s5_lambda_im[l], s5_log_dt[l], s5_b_re[l], s5_b_im[l],
                         s5_c_re[l], s5_c_im[l], s5_d[l], s5_w_glu[l])
        mix = (gates[..., :D_MODEL] * y_a + gates[..., D_MODEL:] * y_b) @ w_out[l]
        h = h + _rms_norm(mix, norm_mix_post[l])
        hn = _rms_norm(h, norm_ffn_pre[l])
        up = hn @ ffn_w_up[l]
        a = _causal_dwconv(up[..., :D_FF], ffn_conv_w[l], ffn_conv_b[l])
        f = (jax.nn.gelu(a, approximate=True) * up[..., D_FF:]) @ ffn_w_down[l]
        h = h + _rms_norm(f, norm_ffn_post[l])
    return h[:, N_META:, :]
```

```cpp
#include <hip/hip_runtime.h>
#include <hip/hip_cooperative_groups.h>
#include <cstdio>
#include <cstdint>
namespace cg = cooperative_groups;
namespace pg8 {
#define PG8_LAS __attribute__((address_space(3)))
typedef unsigned short bf16_t;
typedef short bf16x8 __attribute__((ext_vector_type(8)));
typedef float f32x4 __attribute__((ext_vector_type(4)));
typedef unsigned u32x4 __attribute__((ext_vector_type(4)));
constexpr int BM = 256, BK = 64, HALF = 128, HTB = HALF * BK * 2  , STAGE_BYTES = 8 * HTB, NXCD = 8, WGM = 8;

__host__ __device__ __forceinline__ int lds_byte(int r, int c) { const int st = (r >> 4) * 2 + (c >> 5), rr = r & 15, cc = c & 31, ob = rr * 64 + cc * 2; return st * 1024 + (ob ^ (((ob >> 9) & 1) << 5)); }
__host__ __device__ __forceinline__ void stage_rc(int b, int& R, int& C) { const int st = b / 1024, sb = b % 1024, swz = sb ^ (((sb >> 9) & 1) << 5); R = (st >> 1) * 16 + swz / 64; C = (st & 1) * 32 + (swz % 64) / 2; }
__host__ __device__ __forceinline__ int perm32(int rho) { const int n = rho >> 4, i = rho & 15; return 8 * (i >> 2) + 4 * n + (i & 3); }

struct Unit { int pm, pn; };
struct Gemm { const bf16_t* A; const bf16_t* Bt; int M, N, K, lda, ldb; };

struct StaticOrder {
    int nM, nN, nwg, G, c;
    __host__ __device__ void init(int M, int N, int G_, int c_) { nM = M / BM; nN = N / BM; nwg = nM * nN; G = G_; c = c_; }
    __host__ __device__ bool next(int i, Unit& u) const {
        const long L = (long)i * G + c; if (L >= nwg) return false;
        int wgid = (int)L; { const int q = nwg / NXCD, r = nwg % NXCD, xcd = wgid % NXCD, off = wgid / NXCD; wgid = (xcd < r ? xcd * (q + 1) : r * (q + 1) + (xcd - r) * q) + off; }
        const int nig = WGM * nN, gid = wgid / nig, fm = gid * WGM, gsz = (nM - fm) < WGM ? (nM - fm) : WGM;
        u.pm = fm + ((wgid % nig) % gsz); u.pn = (wgid % nig) / gsz; return true;
    }
    __device__ __forceinline__ void a_ready(const Unit&) const {}
    __device__ __forceinline__ void done(const Unit&) const {}
};


template <class F> struct EpiF {
    static constexpr bool PERM = true, AFTER_DRAIN = false; F f;
    __device__ __forceinline__ void operator()(const f32x4 (&acc)[2][2][4][2], const Unit& u, int wr, int wc, int fr, int fq) const {
        const int cw = wc * 32 + 8 * fq;
#pragma unroll
        for (int ai = 0; ai < 2; ++ai)
#pragma unroll
            for (int m = 0; m < 4; ++m) {
                const int row = u.pm * BM + ai * HALF + wr * 64 + m * 16 + fr;
                f(row, u.pn, cw, acc[ai][0][m][0], acc[ai][0][m][1], acc[ai][1][m][0], acc[ai][1][m][1]);
            }
    }
};
template <class Epi, class Sched, bool ALIGN_EPI = false, bool SP2 = false>
__device__ __forceinline__ void gemm_phase(PG8_LAS unsigned char* lds, const Gemm g, const Sched& S, const Epi& E) {
    const int tid = threadIdx.x, wid = __builtin_amdgcn_readfirstlane(tid >> 6), lane = tid & 63, wr = wid >> 2, wc = wid & 3, fr = lane & 15, fq = lane >> 4;
    const int K = g.K, nt = K / BK;
    unsigned voffA[2], voffB[2];
#pragma unroll
    for (int i = 0; i < 2; ++i) { int R, C; stage_rc(tid * 16 + i * 8192, R, C); const int Rb = Epi::PERM ? ((R & ~31) + perm32(R & 31)) : R;
        voffA[i] = (unsigned)(R * g.lda + C) * 2u; voffB[i] = (unsigned)(Rb * g.ldb + C) * 2u; }
    const size_t kstep = (size_t)(BK * 2);
    const size_t hstepA = (size_t)HALF * g.lda * 2, hstepB = (size_t)HALF * g.ldb * 2;
    const size_t tstepA = 2 * hstepA, tstepB = 2 * hstepB;
    const unsigned ldsw = (unsigned)wid * 1024u;
    const int aoff = lds_byte(wr * 64 + fr, fq * 8), boff = lds_byte(wc * 32 + fr, fq * 8);
#define PG8_SA(b, h) (((b) * 2 + (h)) * HTB)
#define PG8_SB(b, h) ((4 + (b) * 2 + (h)) * HTB)
#define PG8_STAGE(bufoff, gbase, voff) do { _Pragma("unroll") for (int _i = 0; _i < 2; ++_i) \
        __builtin_amdgcn_global_load_lds((const unsigned*)((const char*)(gbase) + (voff)[_i]), (PG8_LAS unsigned*)(lds + (bufoff) + ldsw + _i * 8192), 16, 0, 0); } while (0)
#define PG8_LDA(dst, b, h) do { _Pragma("unroll") for (int m = 0; m < 4; ++m) _Pragma("unroll") for (int k = 0; k < 2; ++k) dst[m][k] = *(const PG8_LAS bf16x8*)(lds + PG8_SA(b, h) + aoff + m * 2048 + k * 1024); } while (0)
#define PG8_LDB(dst, b, h) do { _Pragma("unroll") for (int n = 0; n < 2; ++n) _Pragma("unroll") for (int k = 0; k < 2; ++k) dst[n][k] = *(const PG8_LAS bf16x8*)(lds + PG8_SB(b, h) + boff + n * 2048 + k * 1024); } while (0)
#define PG8_MMA(ai, bj, At, Bt) do { __builtin_amdgcn_s_setprio(1); _Pragma("unroll") for (int m = 0; m < 4; ++m) _Pragma("unroll") for (int n = 0; n < 2; ++n) _Pragma("unroll") for (int k = 0; k < 2; ++k) \
        acc[ai][bj][m][n] = __builtin_amdgcn_mfma_f32_16x16x32_bf16(Bt[n][k], At[m][k], acc[ai][bj][m][n], 0, 0, 0); __builtin_amdgcn_s_setprio(0); } while (0)
#define PG8_WAIT_V(n) asm volatile("s_waitcnt vmcnt(" #n ")" ::: "memory")
#define PG8_WAIT_L(n) asm volatile("s_waitcnt lgkmcnt(" #n ")" ::: "memory")
#define PG8_BAR __builtin_amdgcn_s_barrier()
#define PG8_SCHED __builtin_amdgcn_sched_barrier(0)
    Unit cur, nxt; int ui = 0;
    if (!S.next(0, cur)) return;
    f32x4 acc[2][2][4][2];
#pragma unroll
    for (int a = 0; a < 2; ++a)
#pragma unroll
        for (int b = 0; b < 2; ++b)
#pragma unroll
            for (int m = 0; m < 4; ++m)
#pragma unroll
                for (int n = 0; n < 2; ++n) acc[a][b][m][n] = (f32x4){0.f, 0.f, 0.f, 0.f};
    bf16x8 At[4][2], B0[2][2], B1[2][2];
    const char* cA = (const char*)g.A + (size_t)cur.pm * tstepA; const char* cB = (const char*)g.Bt + (size_t)cur.pn * tstepB;
    S.a_ready(cur);
    if constexpr (SP2) {
        PG8_STAGE(PG8_SB(0, 0), cB, voffB); PG8_STAGE(PG8_SB(0, 1), cB + hstepB, voffB); PG8_STAGE(PG8_SA(0, 0), cA, voffA); PG8_STAGE(PG8_SA(0, 1), cA + hstepA, voffA);
        if (wr == 1) PG8_BAR;
        PG8_WAIT_V(2); PG8_BAR;
        PG8_STAGE(PG8_SB(1, 0), cB + kstep, voffB); PG8_STAGE(PG8_SA(1, 0), cA + kstep, voffA); PG8_STAGE(PG8_SB(1, 1), cB + hstepB + kstep, voffB);
        PG8_WAIT_V(6); PG8_BAR;
    } else {
        PG8_STAGE(PG8_SB(0, 0), cB, voffB); PG8_STAGE(PG8_SA(0, 0), cA, voffA); PG8_STAGE(PG8_SB(0, 1), cB + hstepB, voffB); PG8_STAGE(PG8_SA(0, 1), cA + hstepA, voffA);
        if (wr == 1) PG8_BAR;
        PG8_WAIT_V(4); PG8_BAR;
        PG8_STAGE(PG8_SB(1, 0), cB + kstep, voffB); PG8_STAGE(PG8_SA(1, 0), cA + kstep, voffA); PG8_STAGE(PG8_SB(1, 1), cB + hstepB + kstep, voffB);
        PG8_WAIT_V(6); PG8_BAR;
    }
    for (;;) {
        const bool has_next = S.next(ui + 1, nxt);
        const char* nA = has_next ? (const char*)g.A + (size_t)nxt.pm * tstepA : cA; const char* nB = has_next ? (const char*)g.Bt + (size_t)nxt.pn * tstepB : cB;
        for (int t = 0; t < nt; t += 2) {
            const bool last = (t == nt - 2);
            const char* a1 = cA + (size_t)(t + 1) * kstep;
            const char* a2 = last ? nA : cA + (size_t)(t + 2) * kstep; const char* b2 = last ? nB : cB + (size_t)(t + 2) * kstep;
            const char* a3 = a2 + kstep; const char* b3 = b2 + kstep;
            if (last && has_next) S.a_ready(nxt);
            if constexpr (SP2) {
            PG8_LDB(B0, 0, 0); PG8_LDB(B1, 0, 1); PG8_SCHED; PG8_LDA(At, 0, 0); PG8_STAGE(PG8_SA(1, 1), a1 + hstepA, voffA);
            PG8_WAIT_V(8); PG8_WAIT_L(0); PG8_BAR; PG8_MMA(0, 0, At, B0); PG8_MMA(0, 1, At, B1); PG8_BAR; PG8_SCHED;
            PG8_LDA(At, 0, 1); PG8_STAGE(PG8_SB(0, 0), b2, voffB); PG8_STAGE(PG8_SB(0, 1), b2 + hstepB, voffB); PG8_STAGE(PG8_SA(0, 0), a2, voffA);
            PG8_WAIT_V(8); PG8_WAIT_L(0); PG8_BAR; PG8_MMA(1, 0, At, B0); PG8_MMA(1, 1, At, B1); PG8_BAR; PG8_SCHED;
            PG8_LDB(B0, 1, 0); PG8_LDB(B1, 1, 1); PG8_SCHED; PG8_LDA(At, 1, 0); PG8_STAGE(PG8_SA(0, 1), a2 + hstepA, voffA);
            PG8_WAIT_V(8); PG8_WAIT_L(0); PG8_BAR; PG8_MMA(0, 0, At, B0); PG8_MMA(0, 1, At, B1); PG8_BAR; PG8_SCHED;
            PG8_LDA(At, 1, 1); PG8_STAGE(PG8_SB(1, 0), b3, voffB); PG8_STAGE(PG8_SB(1, 1), b3 + hstepB, voffB); PG8_STAGE(PG8_SA(1, 0), a3, voffA);
            PG8_WAIT_V(8); PG8_WAIT_L(0); PG8_BAR; PG8_MMA(1, 0, At, B0); PG8_MMA(1, 1, At, B1); PG8_BAR; PG8_SCHED;
            } else {
            PG8_LDB(B0, 0, 0); PG8_SCHED; PG8_LDA(At, 0, 0); PG8_STAGE(PG8_SA(1, 1), a1 + hstepA, voffA);
            PG8_WAIT_L(8); PG8_BAR; PG8_WAIT_L(0); PG8_MMA(0, 0, At, B0); PG8_BAR; PG8_SCHED;
            PG8_LDB(B1, 0, 1); PG8_STAGE(PG8_SB(0, 0), b2, voffB);
            PG8_BAR; PG8_WAIT_L(0); PG8_MMA(0, 1, At, B1); PG8_BAR;
            PG8_LDA(At, 0, 1); PG8_STAGE(PG8_SA(0, 0), a2, voffA);
            PG8_BAR; PG8_WAIT_L(0); PG8_MMA(1, 0, At, B0); PG8_BAR; PG8_SCHED;
            PG8_STAGE(PG8_SB(0, 1), b2 + hstepB, voffB);
            PG8_WAIT_V(6); PG8_BAR; PG8_MMA(1, 1, At, B1); PG8_BAR;
            PG8_LDB(B0, 1, 0); PG8_SCHED; PG8_LDA(At, 1, 0); PG8_STAGE(PG8_SA(0, 1), a2 + hstepA, voffA);
            PG8_WAIT_L(8); PG8_BAR; PG8_WAIT_L(0); PG8_MMA(0, 0, At, B0); PG8_BAR; PG8_SCHED;
            PG8_LDB(B1, 1, 1); PG8_STAGE(PG8_SB(1, 0), b3, voffB);
            PG8_BAR; PG8_WAIT_L(0); PG8_MMA(0, 1, At, B1); PG8_BAR;
            PG8_LDA(At, 1, 1); PG8_STAGE(PG8_SA(1, 0), a3, voffA);
            PG8_BAR; PG8_WAIT_L(0); PG8_MMA(1, 0, At, B0); PG8_BAR; PG8_SCHED;
            PG8_STAGE(PG8_SB(1, 1), b3 + hstepB, voffB);
            PG8_WAIT_V(6); PG8_BAR; PG8_MMA(1, 1, At, B1); PG8_BAR;
            }
        }
        if constexpr (ALIGN_EPI) { if (wr == 0) PG8_BAR; }
        if constexpr (!Epi::AFTER_DRAIN) { E(acc, cur, wr, wc, fr, fq); S.done(cur); }
        if (!has_next) break;
#pragma unroll
        for (int a = 0; a < 2; ++a)
#pragma unroll
            for (int b = 0; b < 2; ++b)
#pragma unroll
                for (int m = 0; m < 4; ++m)
#pragma unroll
                    for (int n = 0; n < 2; ++n) acc[a][b][m][n] = (f32x4){0.f, 0.f, 0.f, 0.f};
        cur = nxt; cA = nA; cB = nB; ++ui;
        if constexpr (ALIGN_EPI) { if (wr == 1) PG8_BAR; }
    }
    PG8_WAIT_V(0);
    if constexpr (!ALIGN_EPI) { if (wr == 0) PG8_BAR; }
    PG8_BAR;
    if constexpr (Epi::AFTER_DRAIN) { E.fused(acc, cur, wr, wc, fr, fq, lds, wid, lane); S.done(cur); }
#undef PG8_SA
#undef PG8_SB
#undef PG8_STAGE
#undef PG8_LDA
#undef PG8_LDB
#undef PG8_MMA
#undef PG8_WAIT_V
#undef PG8_WAIT_L
#undef PG8_BAR
#undef PG8_SCHED
}
}

#define LAS __attribute__((address_space(3)))
typedef unsigned short bf16;
typedef float f32x4 __attribute__((ext_vector_type(4)));
typedef unsigned v4u __attribute__((ext_vector_type(4)));
typedef unsigned v2u __attribute__((ext_vector_type(2)));

constexpr int NB = 4, SEQ = 8192, D = 1024, TP = 8256, PADR = 48, MP = NB * TP;
constexpr int RW = 512, PROJW = 4352, DFF = 2816, UPW = 2 * DFF;
constexpr int C_K = 512, C_V = 1024, C_WD = 1536, C_AD = 1600, C_GD = 1664, C_U = 1792, C_GA = 2304, C_GB = 3328;
constexpr size_t QB = (size_t)MP * 512 * 2;
constexpr size_t WO_WIN = 1u << 20, WO_WBR = WO_WIN + (size_t)PROJW * D * 2, WO_WGLU = WO_WBR + (size_t)D * RW * 2, WO_WOUT = WO_WGLU + (size_t)2 * D * RW * 2,
                 WO_WUP = WO_WOUT + (size_t)D * D * 2, WO_WDN = WO_WUP + (size_t)UPW * D * 2, WO_END = WO_WDN + (size_t)D * DFF * 2;
static_assert(WO_END <= QB, "weights fit in the first quantum");
constexpr size_t WS_HN = QB, WS_R = QB, WS_K = 2 * QB, WS_PROJ = 3 * QB, WS_V = 11 * QB + QB / 2, WS_KK = WS_V + QB, WS_BB = WS_KK + QB, WS_LW = WS_BB + QB, WS_END = WS_LW + QB;
constexpr size_t WS_YB = WS_KK, WS_MIXIN = QB, WS_MIX = WS_V, WS_HN2 = QB, WS_UP = 3 * QB, WS_F = QB;
static_assert(WS_END <= 536870912ull, "workspace");
constexpr int LDS_BYTES = 135168;

__device__ __forceinline__ float bf2f(unsigned h) { return __uint_as_float(h << 16); }
__device__ __forceinline__ unsigned f2bf(float f) { unsigned u = __float_as_uint(f); return (u + 0x7fffu + ((u >> 16) & 1u)) >> 16; }
__device__ __forceinline__ unsigned pk2(float lo, float hi) { return f2bf(lo) | (f2bf(hi) << 16); }
__device__ __forceinline__ void unpack8(const v4u q, float (&o)[8]) {
    o[0] = __uint_as_float(q.x << 16); o[1] = __uint_as_float(q.x & 0xffff0000u); o[2] = __uint_as_float(q.y << 16); o[3] = __uint_as_float(q.y & 0xffff0000u);
    o[4] = __uint_as_float(q.z << 16); o[5] = __uint_as_float(q.z & 0xffff0000u); o[6] = __uint_as_float(q.w << 16); o[7] = __uint_as_float(q.w & 0xffff0000u);
}
__device__ __forceinline__ v4u pack8(const float (&o)[8]) { v4u w; w.x = pk2(o[0], o[1]); w.y = pk2(o[2], o[3]); w.z = pk2(o[4], o[5]); w.w = pk2(o[6], o[7]); return w; }
__device__ __forceinline__ float wave_sum(float v) {
#pragma unroll
    for (int o = 1; o < 64; o <<= 1) v += __shfl_xor(v, o);
    return v;
}
__device__ __forceinline__ float sigm(float x) { return 1.f / (1.f + __expf(-x)); }
__device__ __forceinline__ float gelu_t(float x) { const float z = 0.7978845608f * (x + 0.044715f * x * x * x); const float t = 1.f - 2.f / (__expf(2.f * z) + 1.f); return 0.5f * x * (1.f + t); }

struct FStoreBf16 { bf16* O; int ldc;
    __device__ __forceinline__ void operator()(int row, int pn, int cw, f32x4 a00, f32x4 a01, f32x4 a10, f32x4 a11) const {
        bf16* p = O + (size_t)row * ldc + pn * 256 + cw;
        v4u w; w.x = pk2(a00[0], a00[1]); w.y = pk2(a00[2], a00[3]); w.z = pk2(a01[0], a01[1]); w.w = pk2(a01[2], a01[3]); *(v4u*)p = w;
        w.x = pk2(a10[0], a10[1]); w.y = pk2(a10[2], a10[3]); w.z = pk2(a11[0], a11[1]); w.w = pk2(a11[2], a11[3]); *(v4u*)(p + 128) = w; } };
struct FStoreF32 { float* O; int ldc;
    __device__ __forceinline__ void operator()(int row, int pn, int cw, f32x4 a00, f32x4 a01, f32x4 a10, f32x4 a11) const {
        float* p = O + (size_t)row * ldc + pn * 256 + cw;
        *(f32x4*)p = a00; *(f32x4*)(p + 4) = a01; *(f32x4*)(p + 128) = a10; *(f32x4*)(p + 132) = a11; } };
struct FGlu { bf16* YB;
    __device__ __forceinline__ void operator()(int row, int pn, int cw, f32x4 a00, f32x4 a01, f32x4 a10, f32x4 a11) const {
        float y[8];
#pragma unroll
        for (int e = 0; e < 4; ++e) { y[e] = a00[e] * sigm(a10[e]); y[4 + e] = a01[e] * sigm(a11[e]); }
        *(v4u*)(YB + (size_t)row * D + pn * 128 + cw) = pack8(y); } };
struct FMixin { const bf16* PROJ; const bf16* YB; bf16* MIXIN;
    __device__ __forceinline__ void one(int row, int col, f32x4 a0, f32x4 a1) const {
        float ga[8], gb[8], yb[8], o[8];
        unpack8(*(const v4u*)(PROJ + (size_t)row * PROJW + C_GA + col), ga); unpack8(*(const v4u*)(PROJ + (size_t)row * PROJW + C_GB + col), gb);
        unpack8(*(const v4u*)(YB + (size_t)row * D + col), yb);
#pragma unroll
        for (int e = 0; e < 4; ++e) { o[e] = sigm(ga[e]) * a0[e] + sigm(gb[e]) * yb[e]; o[4 + e] = sigm(ga[4 + e]) * a1[e] + sigm(gb[4 + e]) * yb[4 + e]; }
        *(v4u*)(MIXIN + (size_t)row * D + col) = pack8(o); }
    __device__ __forceinline__ void operator()(int row, int pn, int cw, f32x4 a00, f32x4 a01, f32x4 a10, f32x4 a11) const {
        one(row, pn * 256 + cw, a00, a01); one(row, pn * 256 + 128 + cw, a10, a11); } };

struct Args { const float* in[33]; float* out; unsigned char* ws; };

__device__ __forceinline__ void transpose_item(const float* W, int K, int N, bf16* WT, int glu, float* scr, int item, int lane) {
    const int nblk = N / 32, kb = item / nblk, nb = item % nblk, k0 = 64 * kb, n0 = 32 * nb;
#pragma unroll 8
    for (int i = 0; i < 32; ++i) { const int kk = 2 * i + (lane >> 5); scr[kk * 33 + (lane & 31)] = W[(size_t)(k0 + kk) * N + n0 + (lane & 31)]; }
    asm volatile("s_waitcnt lgkmcnt(0)" ::: "memory");
    int d0 = n0; if (glu) { const int bj = n0 / 1024, rem = n0 % 1024; d0 = 256 * (rem / 128) + 128 * bj + (rem % 128); }
    const int c = lane & 7;
#pragma unroll
    for (int j = 0; j < 4; ++j) { const int n = (lane >> 3) + 8 * j; const float* s = scr + (8 * c) * 33 + n;
        v4u o; o.x = pk2(s[0 * 33], s[1 * 33]); o.y = pk2(s[2 * 33], s[3 * 33]); o.z = pk2(s[4 * 33], s[5 * 33]); o.w = pk2(s[6 * 33], s[7 * 33]);
        *(v4u*)(WT + (size_t)(d0 + n) * K + k0 + 8 * c) = o; }
    asm volatile("s_waitcnt lgkmcnt(0)" ::: "memory");
}

__device__ __forceinline__ float shiftv(const bf16* PROJ, int row, int j, int col, float mu) {
    const float cur = bf2f(PROJ[(size_t)row * PROJW + col]); const float prev = j > 0 ? bf2f(PROJ[(size_t)(row - 1) * PROJW + col]) : 0.f;
    return cur + (prev - cur) * mu;
}

__global__ void __launch_bounds__(512, 2) mega(Args a) {
    extern __shared__ __attribute__((aligned(16))) unsigned char lds[];
    cg::grid_group grid = cg::this_grid();
    const int tid = threadIdx.x, lane = tid & 63, wave = __builtin_amdgcn_readfirstlane(tid >> 6);
    const int G = gridDim.x, gw = blockIdx.x * 8 + wave, NGW = G * 8;
    unsigned char* ws = a.ws;
    const float* x = a.in[0]; const float* meta = a.in[1];
    bf16* WIN_T = (bf16*)(ws + WO_WIN); bf16* WBR_T = (bf16*)(ws + WO_WBR); bf16* WGLU_T = (bf16*)(ws + WO_WGLU); bf16* WOUT_T = (bf16*)(ws + WO_WOUT);
    bf16* WUP_T = (bf16*)(ws + WO_WUP); bf16* WDN_T = (bf16*)(ws + WO_WDN);
    bf16* HN = (bf16*)(ws + WS_HN); bf16* PROJ = (bf16*)(ws + WS_PROJ);
    bf16* RB = (bf16*)(ws + WS_R); bf16* KB = (bf16*)(ws + WS_K); bf16* VB = (bf16*)(ws + WS_V); bf16* KKB = (bf16*)(ws + WS_KK); bf16* BBB = (bf16*)(ws + WS_BB); bf16* LWB = (bf16*)(ws + WS_LW);
    bf16* YB = (bf16*)(ws + WS_YB); bf16* MIXIN = (bf16*)(ws + WS_MIXIN); float* MIX = (float*)(ws + WS_MIX); bf16* HN2 = (bf16*)(ws + WS_HN2); bf16* UP = (bf16*)(ws + WS_UP); bf16* FB = (bf16*)(ws + WS_F);
    LAS unsigned char* ldsl = (LAS unsigned char*)lds;

    {
        float* scr = (float*)(lds + wave * 16384);
        constexpr int I0 = 16 * 136, I1 = 8 * 32, I2 = 8 * 64, I3 = 16 * 32, I4 = 16 * 176, I5 = 44 * 32;
        for (int it = gw; it < I0 + I1 + I2 + I3 + I4 + I5; it += NGW) {
            int r = it;
            if (r < I0) { transpose_item(a.in[4], D, PROJW, WIN_T, 0, scr, r, lane); continue; } r -= I0;
            if (r < I1) { transpose_item(a.in[16], RW, D, WBR_T, 0, scr, r, lane); continue; } r -= I1;
            if (r < I2) { transpose_item(a.in[25], RW, 2 * D, WGLU_T, 1, scr, r, lane); continue; } r -= I2;
            if (r < I3) { transpose_item(a.in[26], D, D, WOUT_T, 0, scr, r, lane); continue; } r -= I3;
            if (r < I4) { transpose_item(a.in[29], D, UPW, WUP_T, 0, scr, r, lane); continue; } r -= I4;
            transpose_item(a.in[32], DFF, D, WDN_T, 0, scr, r, lane);
        }
        const float* g = a.in[2];
        for (int row = gw; row < MP; row += NGW) {
            const int b = row / TP, j = row - b * TP;
            v2u* o = (v2u*)(HN + (size_t)row * D) + lane;
            if (j < PADR) {
#pragma unroll
                for (int jj = 0; jj < 4; ++jj) o[64 * jj] = (v2u){0u, 0u};
                continue; }
            const float* src = j < 64 ? meta + (size_t)(j - PADR) * D : x + ((size_t)b * SEQ + (j - 64)) * D;
            f32x4 v[4]; float ss = 0.f;
#pragma unroll
            for (int jj = 0; jj < 4; ++jj) { v[jj] = ((const f32x4*)src)[lane + 64 * jj]; ss += (v[jj].x * v[jj].x + v[jj].y * v[jj].y) + (v[jj].z * v[jj].z + v[jj].w * v[jj].w); }
            const float rstd = rsqrtf(wave_sum(ss) * (1.f / D) + 1e-6f);
#pragma unroll
            for (int jj = 0; jj < 4; ++jj) { const f32x4 g4 = ((const f32x4*)g)[lane + 64 * jj];
                o[64 * jj] = (v2u){pk2(v[jj].x * rstd * g4.x, v[jj].y * rstd * g4.y), pk2(v[jj].z * rstd * g4.z, v[jj].w * rstd * g4.w)}; }
        }
    }
    grid.sync();
    { pg8::Gemm g{HN, WIN_T, MP, PROJW, D, D, D}; pg8::StaticOrder S; S.init(MP, PROJW, G, (int)blockIdx.x);
      pg8::EpiF<FStoreBf16> E{{PROJ, PROJW}};
      pg8::gemm_phase<pg8::EpiF<FStoreBf16>, pg8::StaticOrder, true, true>(ldsl, g, S, E); }
    grid.sync();
    {
        float* tw = (float*)lds; float* adl = tw + 8 * 64;
        const float* mu = a.in[5]; const float* w0 = a.in[6]; const float* w_up = a.in[7]; const float* a0 = a.in[8]; const float* a_up = a.in[9];
        const float* k_k = a.in[11]; const float* k_a = a.in[12];
        const int c = tid;
        for (int grp = blockIdx.x; grp < MP / 8; grp += G) {
            const int row0 = grp * 8;
            { const int tok = tid >> 6, i = tid & 63, row = row0 + tok, j = row % TP;
              tw[tok * 64 + i] = tanhf(shiftv(PROJ, row, j, C_WD + i, mu[C_WD + i]));
              adl[tok * 64 + i] = shiftv(PROJ, row, j, C_AD + i, mu[C_AD + i]); }
            __syncthreads();
            float accw[8], acca[8];
#pragma unroll
            for (int t = 0; t < 8; ++t) { accw[t] = w0[c]; acca[t] = a0[c]; }
            for (int i = 0; i < 64; ++i) { const float wu = w_up[i * RW + c], au = a_up[i * RW + c];
#pragma unroll
                for (int t = 0; t < 8; ++t) { accw[t] += tw[t * 64 + i] * wu; acca[t] += adl[t * 64 + i] * au; } }
            const float kkc = k_k[c], kac = k_a[c], mur = mu[c], muk = mu[C_K + c], muv = mu[C_V + c];
#pragma unroll
            for (int t = 0; t < 8; ++t) {
                const int row = row0 + t, j = row % TP;
                const float r = shiftv(PROJ, row, j, c, mur), k = shiftv(PROJ, row, j, C_K + c, muk), v = shiftv(PROJ, row, j, C_V + c, muv);
                const float lw = -0.60653066f * sigm(accw[t]);
                const float av = sigm(acca[t]);
                const float kkv = k * kkc; const float n2 = wave_sum(kkv * kkv); const float kk = kkv / fmaxf(sqrtf(n2), 1e-12f);
                const float k2 = k * (1.f + (av - 1.f) * kac);
                const size_t o = (size_t)row * RW + c;
                RB[o] = (bf16)f2bf(r); KB[o] = (bf16)f2bf(k2); VB[o] = (bf16)f2bf(v); KKB[o] = (bf16)f2bf(kk); BBB[o] = (bf16)f2bf(kk * av); LWB[o] = (bf16)f2bf(lw);
            }
            __syncthreads();
        }
    }
    grid.sync();
    for (int unit = blockIdx.x; unit < 48; unit += G) {
        if (unit < 32) {
            const int b = unit >> 3, h = unit & 7, vrow = tid >> 3, kg = tid & 7;
            float S[8];
#pragma unroll
            for (int i = 0; i < 8; ++i) S[i] = 0.f;
            const int colk = h * 64 + kg * 8, colv = h * 64 + vrow;
            for (int j0 = PADR; j0 < TP; j0 += 4) {
                v4u qkk[4], qb[4], qk[4], qr[4], qw[4]; unsigned vv[4];
#pragma unroll
                for (int u = 0; u < 4; ++u) { const size_t row = (size_t)b * TP + j0 + u; const size_t off = row * RW + colk;
                    qkk[u] = *(const v4u*)(KKB + off); qb[u] = *(const v4u*)(BBB + off); qk[u] = *(const v4u*)(KB + off); qr[u] = *(const v4u*)(RB + off); qw[u] = *(const v4u*)(LWB + off);
                    vv[u] = VB[row * RW + colv]; }
#pragma unroll
                for (int u = 0; u < 4; ++u) {
                    float kk[8], bb[8], kx[8], rx[8], wx[8];
                    unpack8(qkk[u], kk); unpack8(qb[u], bb); unpack8(qk[u], kx); unpack8(qr[u], rx); unpack8(qw[u], wx);
                    float sa = 0.f;
#pragma unroll
                    for (int i = 0; i < 8; ++i) sa += S[i] * kk[i];
                    sa += __shfl_xor(sa, 1); sa += __shfl_xor(sa, 2); sa += __shfl_xor(sa, 4); sa = -sa;
                    const float v = bf2f(vv[u]); float y = 0.f;
#pragma unroll
                    for (int i = 0; i < 8; ++i) { S[i] = S[i] * __expf(wx[i]) + sa * bb[i] + v * kx[i]; y += S[i] * rx[i]; }
                    y += __shfl_xor(y, 1); y += __shfl_xor(y, 2); y += __shfl_xor(y, 4);
                    if (kg == 0) VB[((size_t)b * TP + j0 + u) * RW + colv] = (bf16)f2bf(y);
                }
            }
        } else {
            const int id = (unit - 32) * 8 + wave, b = id >> 5, g = id & 31, n = lane;
            float* xs = (float*)lds + wave * 128;
            const float lre = fminf(a.in[17][g * 64 + n], -1e-4f), lim = a.in[18][g * 64 + n], dt = __expf(a.in[19][g]);
            const float mag = __expf(lre * dt); float sn, cs; sincosf(lim * dt, &sn, &cs);
            const float lbr = mag * cs, lbi = mag * sn;
            const float den = lre * lre + lim * lim; const float nr = lbr - 1.f, ni = lbi;
            const float cr = (nr * lre + ni * lim) / den, ci = (ni * lre - nr * lim) / den;
            float bre[16], bim[16], cre[16], cim[16];
#pragma unroll
            for (int i = 0; i < 16; ++i) { const float br = a.in[20][(g * 64 + n) * 16 + i], bi = a.in[21][(g * 64 + n) * 16 + i]; bre[i] = cr * br - ci * bi; bim[i] = cr * bi + ci * br; }
            const int hh = lane & 15, part = lane >> 4;
#pragma unroll
            for (int i = 0; i < 16; ++i) { cre[i] = a.in[22][(g * 16 + hh) * 64 + part * 16 + i]; cim[i] = a.in[23][(g * 16 + hh) * 64 + part * 16 + i]; }
            const float dd = a.in[24][g * 16 + hh];
            float xr = 0.f, xi = 0.f;
            for (int j0 = PADR; j0 < TP; j0 += 8) {
                v4u ua[8], ub[8]; unsigned uo[8];
#pragma unroll
                for (int u = 0; u < 8; ++u) { const bf16* p = PROJ + ((size_t)b * TP + j0 + u) * PROJW + C_U + g * 16; ua[u] = *(const v4u*)p; ub[u] = *(const v4u*)(p + 8); uo[u] = p[hh]; }
#pragma unroll
                for (int u = 0; u < 8; ++u) {
                    float uf[16];
                    { float t0[8], t1[8]; unpack8(ua[u], t0); unpack8(ub[u], t1);
#pragma unroll
                      for (int i = 0; i < 8; ++i) { uf[i] = t0[i]; uf[8 + i] = t1[i]; } }
                    float bur = 0.f, bui = 0.f;
#pragma unroll
                    for (int i = 0; i < 16; ++i) { bur += bre[i] * uf[i]; bui += bim[i] * uf[i]; }
                    const float nxr = lbr * xr - lbi * xi + bur, nxi = lbr * xi + lbi * xr + bui; xr = nxr; xi = nxi;
                    xs[n] = xr; xs[64 + n] = xi;
                    asm volatile("s_waitcnt lgkmcnt(0)" ::: "memory");
                    float acc = 0.f;
#pragma unroll
                    for (int i = 0; i < 16; ++i) acc += cre[i] * xs[part * 16 + i] - cim[i] * xs[64 + part * 16 + i];
                    asm volatile("s_waitcnt lgkmcnt(0)" ::: "memory");
                    acc += __shfl_xor(acc, 16); acc += __shfl_xor(acc, 32);
                    const float y = gelu_t(acc + dd * bf2f(uo[u]));
                    if (part == 0) PROJ[((size_t)b * TP + j0 + u) * PROJW + C_U + g * 16 + hh] = (bf16)f2bf(y);
                }
            }
        }
    }
    grid.sync();
    {
        float* sg = (float*)lds;
        const float* mu = a.in[5]; const float* g_up = a.in[10]; const float* r_k = a.in[13]; const float* ln_g = a.in[14]; const float* ln_b = a.in[15];
        const int c = tid;
        for (int grp = blockIdx.x; grp < MP / 8; grp += G) {
            const int row0 = grp * 8;
#pragma unroll
            for (int p = 0; p < 2; ++p) { const int tok = tid >> 6, i = (tid & 63) + 64 * p, row = row0 + tok, j = row % TP;
                sg[tok * 128 + i] = sigm(shiftv(PROJ, row, j, C_GD + i, mu[C_GD + i])); }
            __syncthreads();
            float accg[8];
#pragma unroll
            for (int t = 0; t < 8; ++t) accg[t] = 0.f;
            for (int i = 0; i < 128; ++i) { const float gu = g_up[i * RW + c];
#pragma unroll
                for (int t = 0; t < 8; ++t) accg[t] += sg[t * 128 + i] * gu; }
            const float rkc = r_k[c], lg = ln_g[c], lb = ln_b[c], muv = mu[C_V + c];
#pragma unroll
            for (int t = 0; t < 8; ++t) {
                const int row = row0 + t, j = row % TP; const size_t o = (size_t)row * RW + c;
                const float y = bf2f(VB[o]); const float mean = wave_sum(y) * (1.f / 64.f); const float dv = y - mean; const float var = wave_sum(dv * dv) * (1.f / 64.f);
                const float yn = dv * rsqrtf(var + 64e-5f) * lg + lb;
                const float r = bf2f(RB[o]), k2 = bf2f(KB[o]); const float v = shiftv(PROJ, row, j, C_V + c, muv);
                const float bonus = wave_sum(r * k2 * rkc) * v;
                VB[o] = (bf16)f2bf((yn + bonus) * accg[t]);
            }
            __syncthreads();
        }
    }
    grid.sync();
    { pg8::Gemm g{PROJ + C_U, WGLU_T, MP, 2 * D, RW, PROJW, RW}; pg8::StaticOrder S; S.init(MP, 2 * D, G, (int)blockIdx.x);
      pg8::EpiF<FGlu> E{{YB}};
      pg8::gemm_phase<pg8::EpiF<FGlu>, pg8::StaticOrder, true, true>(ldsl, g, S, E); }
    grid.sync();
    { pg8::Gemm g{VB, WBR_T, MP, D, RW, RW, RW}; pg8::StaticOrder S; S.init(MP, D, G, (int)blockIdx.x);
      pg8::EpiF<FMixin> E{{PROJ, YB, MIXIN}};
      pg8::gemm_phase<pg8::EpiF<FMixin>, pg8::StaticOrder, true, true>(ldsl, g, S, E); }
    grid.sync();
    { pg8::Gemm g{MIXIN, WOUT_T, MP, D, D, D, D}; pg8::StaticOrder S; S.init(MP, D, G, (int)blockIdx.x);
      pg8::EpiF<FStoreF32> E{{MIX, D}};
      pg8::gemm_phase<pg8::EpiF<FStoreF32>, pg8::StaticOrder, true, true>(ldsl, g, S, E); }
    grid.sync();
    {
        const float* gp = a.in[3]; const float* gf = a.in[27];
        for (int row = gw; row < MP; row += NGW) {
            const int b = row / TP, j = row - b * TP;
            v2u* o = (v2u*)(HN2 + (size_t)row * D) + lane;
            if (j < PADR) {
#pragma unroll
                for (int jj = 0; jj < 4; ++jj) o[64 * jj] = (v2u){0u, 0u};
                continue; }
            const float* src = j < 64 ? meta + (size_t)(j - PADR) * D : x + ((size_t)b * SEQ + (j - 64)) * D;
            const f32x4* mr = (const f32x4*)(MIX + (size_t)row * D);
            f32x4 m[4], hv[4]; float ss = 0.f;
#pragma unroll
            for (int jj = 0; jj < 4; ++jj) { m[jj] = mr[lane + 64 * jj]; hv[jj] = ((const f32x4*)src)[lane + 64 * jj]; ss += (m[jj].x * m[jj].x + m[jj].y * m[jj].y) + (m[jj].z * m[jj].z + m[jj].w * m[jj].w); }
            const float rstd = rsqrtf(wave_sum(ss) * (1.f / D) + 1e-6f); float s2 = 0.f;
#pragma unroll
            for (int jj = 0; jj < 4; ++jj) { const f32x4 g4 = ((const f32x4*)gp)[lane + 64 * jj]; hv[jj] = hv[jj] + m[jj] * rstd * g4;
                s2 += (hv[jj].x * hv[jj].x + hv[jj].y * hv[jj].y) + (hv[jj].z * hv[jj].z + hv[jj].w * hv[jj].w); }
            const float rstd2 = rsqrtf(wave_sum(s2) * (1.f / D) + 1e-6f);
            if (j >= 64) { f32x4* od = (f32x4*)(a.out + ((size_t)b * SEQ + (j - 64)) * D);
#pragma unroll
                for (int jj = 0; jj < 4; ++jj) od[lane + 64 * jj] = hv[jj]; }
#pragma unroll
            for (int jj = 0; jj < 4; ++jj) { const f32x4 g4 = ((const f32x4*)gf)[lane + 64 * jj];
                o[64 * jj] = (v2u){pk2(hv[jj].x * rstd2 * g4.x, hv[jj].y * rstd2 * g4.y), pk2(hv[jj].z * rstd2 * g4.z, hv[jj].w * rstd2 * g4.w)}; }
        }
    }
    grid.sync();
    { pg8::Gemm g{HN2, WUP_T, MP, UPW, D, D, D}; pg8::StaticOrder S; S.init(MP, UPW, G, (int)blockIdx.x);
      pg8::EpiF<FStoreBf16> E{{UP, UPW}};
      pg8::gemm_phase<pg8::EpiF<FStoreBf16>, pg8::StaticOrder, true, true>(ldsl, g, S, E); }
    grid.sync();
    {
        const float* cw = a.in[30]; const float* cb = a.in[31];
        const size_t total = (size_t)MP * (DFF / 8);
        for (size_t idx = (size_t)blockIdx.x * 512 + tid; idx < total; idx += (size_t)G * 512) {
            const int row = (int)(idx / (DFF / 8)), c = (int)(idx % (DFF / 8)) * 8, j = row % TP;
            const bf16* p = UP + (size_t)row * UPW + c;
            float a0[8], a1[8], a2[8], gt[8], o[8];
            unpack8(*(const v4u*)p, a0); unpack8(*(const v4u*)(p + DFF), gt);
            if (j >= 1) unpack8(*(const v4u*)(p - UPW), a1); else {
#pragma unroll
                for (int e = 0; e < 8; ++e) a1[e] = 0.f; }
            if (j >= 2) unpack8(*(const v4u*)(p - 2 * UPW), a2); else {
#pragma unroll
                for (int e = 0; e < 8; ++e) a2[e] = 0.f; }
#pragma unroll
            for (int e = 0; e < 8; ++e) { const float cv = cw[c + e] * a2[e] + cw[DFF + c + e] * a1[e] + cw[2 * DFF + c + e] * a0[e] + cb[c + e]; o[e] = gelu_t(cv) * gt[e]; }
            *(v4u*)(UP + (size_t)row * UPW + DFF + c) = pack8(o);
        }
    }
    grid.sync();
    { pg8::Gemm g{UP + DFF, WDN_T, MP, D, DFF, UPW, DFF}; pg8::StaticOrder S; S.init(MP, D, G, (int)blockIdx.x);
      pg8::EpiF<FStoreBf16> E{{FB, D}};
      pg8::gemm_phase<pg8::EpiF<FStoreBf16>, pg8::StaticOrder, true, true>(ldsl, g, S, E); }
    grid.sync();
    {
        const float* gq = a.in[28];
        for (int r = gw; r < NB * SEQ; r += NGW) {
            const int b = r / SEQ, t = r - b * SEQ; const int row = b * TP + 64 + t;
            const v2u* fr = (const v2u*)(FB + (size_t)row * D);
            f32x4 fv[4]; float ss = 0.f;
#pragma unroll
            for (int jj = 0; jj < 4; ++jj) { const v2u q = fr[lane + 64 * jj]; fv[jj] = (f32x4){__uint_as_float(q.x << 16), __uint_as_float(q.x & 0xffff0000u), __uint_as_float(q.y << 16), __uint_as_float(q.y & 0xffff0000u)};
                ss += (fv[jj].x * fv[jj].x + fv[jj].y * fv[jj].y) + (fv[jj].z * fv[jj].z + fv[jj].w * fv[jj].w); }
            const float rstd = rsqrtf(wave_sum(ss) * (1.f / D) + 1e-6f);
            f32x4* od = (f32x4*)(a.out + (size_t)r * D);
#pragma unroll
            for (int jj = 0; jj < 4; ++jj) { const f32x4 g4 = ((const f32x4*)gq)[lane + 64 * jj]; od[lane + 64 * jj] = od[lane + 64 * jj] + fv[jj] * rstd * g4; }
        }
    }
}

extern "C" void kernel_launch(void* const* d_in, const int* in_sizes, int n_in, void* d_out, int out_size, void* d_ws, size_t ws_size, hipStream_t stream) {
    static int grid = 0;
    if (grid == 0) {
        if (n_in != 33 || ws_size < WS_END) { fprintf(stderr, "kernel_launch: unexpected n_in %d / ws_size %zu\n", n_in, ws_size); grid = -1; return; }
        int dev = 0, cus = 0, per_cu = 0;
        (void)hipGetDevice(&dev); (void)hipDeviceGetAttribute(&cus, hipDeviceAttributeMultiprocessorCount, dev);
        (void)hipFuncSetAttribute((const void*)mega, hipFuncAttributeMaxDynamicSharedMemorySize, LDS_BYTES);
        (void)hipOccupancyMaxActiveBlocksPerMultiprocessor(&per_cu, (const void*)mega, 512, LDS_BYTES);
        if (per_cu < 1) { fprintf(stderr, "kernel_launch: occupancy query says %d blocks/CU\n", per_cu); per_cu = 1; }
        (void)hipGetLastError();
        grid = cus * per_cu;
    }
    if (grid < 0) return;
    Args a{};
    for (int i = 0; i < 33; ++i) a.in[i] = (const float*)d_in[i];
    a.out = (float*)d_out; a.ws = (unsigned char*)d_ws;
    void* args[] = {&a};
    hipError_t e = hipLaunchCooperativeKernel((const void*)mega, dim3(grid), dim3(512), args, LDS_BYTES, stream);
    if (e != hipSuccess) fprintf(stderr, "cooperative launch failed: %s (grid %d)\n", hipGetErrorString(e), grid);
}
```

```cpp
#include <hip/hip_runtime.h>
#include <hip/hip_cooperative_groups.h>
#include <cstdio>
#include <cstdint>
namespace cg = cooperative_groups;
namespace pg8 {
#define PG8_LAS __attribute__((address_space(3)))
typedef unsigned short bf16_t;
typedef short bf16x8 __attribute__((ext_vector_type(8)));
typedef float f32x4 __attribute__((ext_vector_type(4)));
typedef unsigned u32x4 __attribute__((ext_vector_type(4)));
constexpr int BM = 256, BK = 64, HALF = 128, HTB = HALF * BK * 2  , STAGE_BYTES = 8 * HTB, NXCD = 8, WGM = 8;

__host__ __device__ __forceinline__ int lds_byte(int r, int c) { const int st = (r >> 4) * 2 + (c >> 5), rr = r & 15, cc = c & 31, ob = rr * 64 + cc * 2; return st * 1024 + (ob ^ (((ob >> 9) & 1) << 5)); }
__host__ __device__ __forceinline__ void stage_rc(int b, int& R, int& C) { const int st = b / 1024, sb = b % 1024, swz = sb ^ (((sb >> 9) & 1) << 5); R = (st >> 1) * 16 + swz / 64; C = (st & 1) * 32 + (swz % 64) / 2; }
__host__ __device__ __forceinline__ int perm32(int rho) { const int n = rho >> 4, i = rho & 15; return 8 * (i >> 2) + 4 * n + (i & 3); }

struct Unit { int pm, pn; };
struct Gemm { const bf16_t* A; const bf16_t* Bt; int M, N, K, lda, ldb; };

struct StaticOrder {
    int nM, nN, nwg, G, c;
    __host__ __device__ void init(int M, int N, int G_, int c_) { nM = M / BM; nN = N / BM; nwg = nM * nN; G = G_; c = c_; }
    __host__ __device__ bool next(int i, Unit& u) const {
        const long L = (long)i * G + c; if (L >= nwg) return false;
        int wgid = (int)L; { const int q = nwg / NXCD, r = nwg % NXCD, xcd = wgid % NXCD, off = wgid / NXCD; wgid = (xcd < r ? xcd * (q + 1) : r * (q + 1) + (xcd - r) * q) + off; }
        const int nig = WGM * nN, gid = wgid / nig, fm = gid * WGM, gsz = (nM - fm) < WGM ? (nM - fm) : WGM;
        u.pm = fm + ((wgid % nig) % gsz); u.pn = (wgid % nig) / gsz; return true;
    }
    __device__ __forceinline__ void a_ready(const Unit&) const {}
    __device__ __forceinline__ void done(const Unit&) const {}
};


template <class F> struct EpiF {
    static constexpr bool PERM = true, AFTER_DRAIN = false; F f;
    __device__ __forceinline__ void operator()(const f32x4 (&acc)[2][2][4][2], const Unit& u, int wr, int wc, int fr, int fq) const {
        const int cw = wc * 32 + 8 * fq;
#pragma unroll
        for (int ai = 0; ai < 2; ++ai)
#pragma unroll
            for (int m = 0; m < 4; ++m) {
                const int row = u.pm * BM + ai * HALF + wr * 64 + m * 16 + fr;
                f(row, u.pn, cw, acc[ai][0][m][0], acc[ai][0][m][1], acc[ai][1][m][0], acc[ai][1][m][1]);
            }
    }
};
template <class Epi, class Sched, bool ALIGN_EPI = false, bool SP2 = false>
__device__ __forceinline__ void gemm_phase(PG8_LAS unsigned char* lds, const Gemm g, const Sched& S, const Epi& E) {
    const int tid = threadIdx.x, wid = __builtin_amdgcn_readfirstlane(tid >> 6), lane = tid & 63, wr = wid >> 2, wc = wid & 3, fr = lane & 15, fq = lane >> 4;
    const int K = g.K, nt = K / BK;
    unsigned voffA[2], voffB[2];
#pragma unroll
    for (int i = 0; i < 2; ++i) { int R, C; stage_rc(tid * 16 + i * 8192, R, C); const int Rb = Epi::PERM ? ((R & ~31) + perm32(R & 31)) : R;
        voffA[i] = (unsigned)(R * g.lda + C) * 2u; voffB[i] = (unsigned)(Rb * g.ldb + C) * 2u; }
    const size_t kstep = (size_t)(BK * 2);
    const size_t hstepA = (size_t)HALF * g.lda * 2, hstepB = (size_t)HALF * g.ldb * 2;
    const size_t tstepA = 2 * hstepA, tstepB = 2 * hstepB;
    const unsigned ldsw = (unsigned)wid * 1024u;
    const int aoff = lds_byte(wr * 64 + fr, fq * 8), boff = lds_byte(wc * 32 + fr, fq * 8);
#define PG8_SA(b, h) (((b) * 2 + (h)) * HTB)
#define PG8_SB(b, h) ((4 + (b) * 2 + (h)) * HTB)
#define PG8_STAGE(bufoff, gbase, voff) do { _Pragma("unroll") for (int _i = 0; _i < 2; ++_i) \
        __builtin_amdgcn_global_load_lds((const unsigned*)((const char*)(gbase) + (voff)[_i]), (PG8_LAS unsigned*)(lds + (bufoff) + ldsw + _i * 8192), 16, 0, 0); } while (0)
#define PG8_LDA(dst, b, h) do { _Pragma("unroll") for (int m = 0; m < 4; ++m) _Pragma("unroll") for (int k = 0; k < 2; ++k) dst[m][k] = *(const PG8_LAS bf16x8*)(lds + PG8_SA(b, h) + aoff + m * 2048 + k * 1024); } while (0)
#define PG8_LDB(dst, b, h) do { _Pragma("unroll") for (int n = 0; n < 2; ++n) _Pragma("unroll") for (int k = 0; k < 2; ++k) dst[n][k] = *(const PG8_LAS bf16x8*)(lds + PG8_SB(b, h) + boff + n * 2048 + k * 1024); } while (0)
#define PG8_MMA(ai, bj, At, Bt) do { __builtin_amdgcn_s_setprio(1); _Pragma("unroll") for (int m = 0; m < 4; ++m) _Pragma("unroll") for (int n = 0; n < 2; ++n) _Pragma("unroll") for (int k = 0; k < 2; ++k) \
        acc[ai][bj][m][n] = __builtin_amdgcn_mfma_f32_16x16x32_bf16(Bt[n][k], At[m][k], acc[ai][bj][m][n], 0, 0, 0); __builtin_amdgcn_s_setprio(0); } while (0)
#define PG8_WAIT_V(n) asm volatile("s_waitcnt vmcnt(" #n ")" ::: "memory")
#define PG8_WAIT_L(n) asm volatile("s_waitcnt lgkmcnt(" #n ")" ::: "memory")
#define PG8_BAR __builtin_amdgcn_s_barrier()
#define PG8_SCHED __builtin_amdgcn_sched_barrier(0)
    Unit cur, nxt; int ui = 0;
    if (!S.next(0, cur)) return;
    f32x4 acc[2][2][4][2];
#pragma unroll
    for (int a = 0; a < 2; ++a)
#pragma unroll
        for (int b = 0; b < 2; ++b)
#pragma unroll
            for (int m = 0; m < 4; ++m)
#pragma unroll
                for (int n = 0; n < 2; ++n) acc[a][b][m][n] = (f32x4){0.f, 0.f, 0.f, 0.f};
    bf16x8 At[4][2], B0[2][2], B1[2][2];
    const char* cA = (const char*)g.A + (size_t)cur.pm * tstepA; const char* cB = (const char*)g.Bt + (size_t)cur.pn * tstepB;
    S.a_ready(cur);
    if constexpr (SP2) {
        PG8_STAGE(PG8_SB(0, 0), cB, voffB); PG8_STAGE(PG8_SB(0, 1), cB + hstepB, voffB); PG8_STAGE(PG8_SA(0, 0), cA, voffA); PG8_STAGE(PG8_SA(0, 1), cA + hstepA, voffA);
        if (wr == 1) PG8_BAR;
        PG8_WAIT_V(2); PG8_BAR;
        PG8_STAGE(PG8_SB(1, 0), cB + kstep, voffB); PG8_STAGE(PG8_SA(1, 0), cA + kstep, voffA); PG8_STAGE(PG8_SB(1, 1), cB + hstepB + kstep, voffB);
        PG8_WAIT_V(6); PG8_BAR;
    } else {
        PG8_STAGE(PG8_SB(0, 0), cB, voffB); PG8_STAGE(PG8_SA(0, 0), cA, voffA); PG8_STAGE(PG8_SB(0, 1), cB + hstepB, voffB); PG8_STAGE(PG8_SA(0, 1), cA + hstepA, voffA);
        if (wr == 1) PG8_BAR;
        PG8_WAIT_V(4); PG8_BAR;
        PG8_STAGE(PG8_SB(1, 0), cB + kstep, voffB); PG8_STAGE(PG8_SA(1, 0), cA + kstep, voffA); PG8_STAGE(PG8_SB(1, 1), cB + hstepB + kstep, voffB);
        PG8_WAIT_V(6); PG8_BAR;
    }
    for (;;) {
        const bool has_next = S.next(ui + 1, nxt);
        const char* nA = has_next ? (const char*)g.A + (size_t)nxt.pm * tstepA : cA; const char* nB = has_next ? (const char*)g.Bt + (size_t)nxt.pn * tstepB : cB;
        for (int t = 0; t < nt; t += 2) {
            const bool last = (t == nt - 2);
            const char* a1 = cA + (size_t)(t + 1) * kstep;
            const char* a2 = last ? nA : cA + (size_t)(t + 2) * kstep; const char* b2 = last ? nB : cB + (size_t)(t + 2) * kstep;
            const char* a3 = a2 + kstep; const char* b3 = b2 + kstep;
            if (last && has_next) S.a_ready(nxt);
            if constexpr (SP2) {
            PG8_LDB(B0, 0, 0); PG8_LDB(B1, 0, 1); PG8_SCHED; PG8_LDA(At, 0, 0); PG8_STAGE(PG8_SA(1, 1), a1 + hstepA, voffA);
            PG8_WAIT_V(8); PG8_WAIT_L(0); PG8_BAR; PG8_MMA(0, 0, At, B0); PG8_MMA(0, 1, At, B1); PG8_BAR; PG8_SCHED;
            PG8_LDA(At, 0, 1); PG8_STAGE(PG8_SB(0, 0), b2, voffB); PG8_STAGE(PG8_SB(0, 1), b2 + hstepB, voffB); PG8_STAGE(PG8_SA(0, 0), a2, voffA);
            PG8_WAIT_V(8); PG8_WAIT_L(0); PG8_BAR; PG8_MMA(1, 0, At, B0); PG8_MMA(1, 1, At, B1); PG8_BAR; PG8_SCHED;
            PG8_LDB(B0, 1, 0); PG8_LDB(B1, 1, 1); PG8_SCHED; PG8_LDA(At, 1, 0); PG8_STAGE(PG8_SA(0, 1), a2 + hstepA, voffA);
            PG8_WAIT_V(8); PG8_WAIT_L(0); PG8_BAR; PG8_MMA(0, 0, At, B0); PG8_MMA(0, 1, At, B1); PG8_BAR; PG8_SCHED;
            PG8_LDA(At, 1, 1); PG8_STAGE(PG8_SB(1, 0), b3, voffB); PG8_STAGE(PG8_SB(1, 1), b3 + hstepB, voffB); PG8_STAGE(PG8_SA(1, 0), a3, voffA);
            PG8_WAIT_V(8); PG8_WAIT_L(0); PG8_BAR; PG8_MMA(1, 0, At, B0); PG8_MMA(1, 1, At, B1); PG8_BAR; PG8_SCHED;
            } else {
            PG8_LDB(B0, 0, 0); PG8_SCHED; PG8_LDA(At, 0, 0); PG8_STAGE(PG8_SA(1, 1), a1 + hstepA, voffA);
            PG8_WAIT_L(8); PG8_BAR; PG8_WAIT_L(0); PG8_MMA(0, 0, At, B0); PG8_BAR; PG8_SCHED;
            PG8_LDB(B1, 0, 1); PG8_STAGE(PG8_SB(0, 0), b2, voffB);
            PG8_BAR; PG8_WAIT_L(0); PG8_MMA(0, 1, At, B1); PG8_BAR;
            PG8_LDA(At, 0, 1); PG8_STAGE(PG8_SA(0, 0), a2, voffA);
            PG8_BAR; PG8_WAIT_L(0); PG8_MMA(1, 0, At, B0); PG8_BAR; PG8_SCHED;
            PG8_STAGE(PG8_SB(0, 1), b2 + hstepB, voffB);
            PG8_WAIT_V(6); PG8_BAR; PG8_MMA(1, 1, At, B1); PG8_BAR;
            PG8_LDB(B0, 1, 0); PG8_SCHED; PG8_LDA(At, 1, 0); PG8_STAGE(PG8_SA(0, 1), a2 + hstepA, voffA);
            PG8_WAIT_L(8); PG8_BAR; PG8_WAIT_L(0); PG8_MMA(0, 0, At, B0); PG8_BAR; PG8_SCHED;
            PG8_LDB(B1, 1, 1); PG8_STAGE(PG8_SB(1, 0), b3, voffB);
            PG8_BAR; PG8_WAIT_L(0); PG8_MMA(0, 1, At, B1); PG8_BAR;
            PG8_LDA(At, 1, 1); PG8_STAGE(PG8_SA(1, 0), a3, voffA);
            PG8_BAR; PG8_WAIT_L(0); PG8_MMA(1, 0, At, B0); PG8_BAR; PG8_SCHED;
            PG8_STAGE(PG8_SB(1, 1), b3 + hstepB, voffB);
            PG8_WAIT_V(6); PG8_BAR; PG8_MMA(1, 1, At, B1); PG8_BAR;
            }
        }
        if constexpr (ALIGN_EPI) { if (wr == 0) PG8_BAR; }
        if constexpr (!Epi::AFTER_DRAIN) { E(acc, cur, wr, wc, fr, fq); S.done(cur); }
        if (!has_next) break;
#pragma unroll
        for (int a = 0; a < 2; ++a)
#pragma unroll
            for (int b = 0; b < 2; ++b)
#pragma unroll
                for (int m = 0; m < 4; ++m)
#pragma unroll
                    for (int n = 0; n < 2; ++n) acc[a][b][m][n] = (f32x4){0.f, 0.f, 0.f, 0.f};
        cur = nxt; cA = nA; cB = nB; ++ui;
        if constexpr (ALIGN_EPI) { if (wr == 1) PG8_BAR; }
    }
    PG8_WAIT_V(0);
    if constexpr (!ALIGN_EPI) { if (wr == 0) PG8_BAR; }
    PG8_BAR;
    if constexpr (Epi::AFTER_DRAIN) { E.fused(acc, cur, wr, wc, fr, fq, lds, wid, lane); S.done(cur); }
#undef PG8_SA
#undef PG8_SB
#undef PG8_STAGE
#undef PG8_LDA
#undef PG8_LDB
#undef PG8_MMA
#undef PG8_WAIT_V
#undef PG8_WAIT_L
#undef PG8_BAR
#undef PG8_SCHED
}
}

#define LAS __attribute__((address_space(3)))
typedef unsigned short bf16;
typedef float f32x4 __attribute__((ext_vector_type(4)));
typedef unsigned v4u __attribute__((ext_vector_type(4)));
typedef unsigned v2u __attribute__((ext_vector_type(2)));

constexpr int NB = 4, SEQ = 8192, D = 1024, TP = 8256, PADR = 48, MP = NB * TP;
constexpr int RW = 512, PROJW = 4352, DFF = 2816, UPW = 2 * DFF;
constexpr int C_K = 512, C_V = 1024, C_WD = 1536, C_AD = 1600, C_GD = 1664, C_U = 1792, C_GA = 2304, C_GB = 3328;
constexpr size_t QB = (size_t)MP * 512 * 2;
constexpr size_t WO_WIN = 1u << 20, WO_WBR = WO_WIN + (size_t)PROJW * D * 2, WO_WGLU = WO_WBR + (size_t)D * RW * 2, WO_WOUT = WO_WGLU + (size_t)2 * D * RW * 2,
                 WO_WUP = WO_WOUT + (size_t)D * D * 2, WO_WDN = WO_WUP + (size_t)UPW * D * 2, WO_END = WO_WDN + (size_t)D * DFF * 2;
static_assert(WO_END <= QB, "weights fit in the first quantum");
constexpr size_t WO_WUPT = WO_END, WO_AUPT = WO_WUPT + 65536, WO_GUPT = WO_AUPT + 65536, WO_END2 = WO_GUPT + 131072;
static_assert(WO_END2 <= QB, "small tables fit in the first quantum");
constexpr size_t WS_HN = QB, WS_GF = QB, WS_HF = 2 * QB, WS_PROJ = 3 * QB, WS_YR = 11 * QB + QB / 2, WS_QT = WS_YR + QB, WS_YB = WS_QT + QB, WS_BON = WS_YB + 2 * QB, WS_END = WS_BON + (size_t)MP * 8 * 4;
constexpr size_t WS_MIXIN = QB, WS_MIX = WS_YR, WS_HN2 = QB, WS_UP = 3 * QB, WS_F = QB;
constexpr int NCH = 129, NUNIT = NB * 8 * NCH, S5UNITS = NB * 32 * NCH;
constexpr size_t WO_BRT = WO_END2, WO_CRT = WO_BRT + 131072, WO_LAM = WO_CRT + 131072, WO_LAM64 = WO_LAM + 16384, WO_END3 = WO_LAM64 + 16384;
static_assert(WO_END3 <= QB, "S5 tables fit in the first quantum");
constexpr size_t WS_Z = WS_YB, WS_X0 = WS_Z + (size_t)NB * NCH * 4096 * 4;
static_assert(WS_END <= 536870912ull, "workspace");
constexpr int OP = 72, OPB = 64 * OP * 2, MISC_OFF = 17 * OPB;
constexpr int LDS_BYTES = 159744;
typedef short bf16x8 __attribute__((ext_vector_type(8)));

__device__ __forceinline__ float bf2f(unsigned h) { return __uint_as_float(h << 16); }
__device__ __forceinline__ unsigned f2bf(float f) { unsigned u = __float_as_uint(f); return (u + 0x7fffu + ((u >> 16) & 1u)) >> 16; }
__device__ __forceinline__ unsigned pk2(float lo, float hi) { return f2bf(lo) | (f2bf(hi) << 16); }
__device__ __forceinline__ void unpack8(const v4u q, float (&o)[8]) {
    o[0] = __uint_as_float(q.x << 16); o[1] = __uint_as_float(q.x & 0xffff0000u); o[2] = __uint_as_float(q.y << 16); o[3] = __uint_as_float(q.y & 0xffff0000u);
    o[4] = __uint_as_float(q.z << 16); o[5] = __uint_as_float(q.z & 0xffff0000u); o[6] = __uint_as_float(q.w << 16); o[7] = __uint_as_float(q.w & 0xffff0000u);
}
__device__ __forceinline__ v4u pack8(const float (&o)[8]) { v4u w; w.x = pk2(o[0], o[1]); w.y = pk2(o[2], o[3]); w.z = pk2(o[4], o[5]); w.w = pk2(o[6], o[7]); return w; }
__device__ __forceinline__ float wave_sum(float v) {
#pragma unroll
    for (int o = 1; o < 64; o <<= 1) v += __shfl_xor(v, o);
    return v;
}
__device__ __forceinline__ float sigm(float x) { return 1.f / (1.f + __expf(-x)); }
__device__ __forceinline__ float gelu_t(float x) { const float z = 0.7978845608f * (x + 0.044715f * x * x * x); const float t = 1.f - 2.f / (__expf(2.f * z) + 1.f); return 0.5f * x * (1.f + t); }

#define SLOT(i) (ldsl + (i) * OPB)
__device__ __forceinline__ bf16x8 ldfrag(const LAS unsigned char* buf, int r0, int ks, int lane) { return *(const LAS bf16x8*)(buf + ((r0 + (lane & 15)) * OP + 32 * ks + 8 * (lane >> 4)) * 2); }
__device__ __forceinline__ f32x4 tmm(const LAS unsigned char* X, int x0, const LAS unsigned char* Y, int y0, f32x4 acc, int lane) {
#pragma unroll
    for (int ks = 0; ks < 2; ++ks) acc = __builtin_amdgcn_mfma_f32_16x16x32_bf16(ldfrag(X, x0, ks, lane), ldfrag(Y, y0, ks, lane), acc, 0, 0, 0);
    return acc; }
__device__ __forceinline__ void st4(LAS unsigned char* buf, int y, int x, f32x4 v) { *(LAS v2u*)(buf + (y * OP + x) * 2) = (v2u){pk2(v[0], v[1]), pk2(v[2], v[3])}; }
struct FStoreBf16 { bf16* O; int ldc;
    __device__ __forceinline__ void operator()(int row, int pn, int cw, f32x4 a00, f32x4 a01, f32x4 a10, f32x4 a11) const {
        bf16* p = O + (size_t)row * ldc + pn * 256 + cw;
        v4u w; w.x = pk2(a00[0], a00[1]); w.y = pk2(a00[2], a00[3]); w.z = pk2(a01[0], a01[1]); w.w = pk2(a01[2], a01[3]); *(v4u*)p = w;
        w.x = pk2(a10[0], a10[1]); w.y = pk2(a10[2], a10[3]); w.z = pk2(a11[0], a11[1]); w.w = pk2(a11[2], a11[3]); *(v4u*)(p + 128) = w; } };
struct FStoreF32 { float* O; int ldc;
    __device__ __forceinline__ void operator()(int row, int pn, int cw, f32x4 a00, f32x4 a01, f32x4 a10, f32x4 a11) const {
        float* p = O + (size_t)row * ldc + pn * 256 + cw;
        *(f32x4*)p = a00; *(f32x4*)(p + 4) = a01; *(f32x4*)(p + 128) = a10; *(f32x4*)(p + 132) = a11; } };
struct FGlu { bf16* YB;
    __device__ __forceinline__ void operator()(int row, int pn, int cw, f32x4 a00, f32x4 a01, f32x4 a10, f32x4 a11) const {
        float y[8];
#pragma unroll
        for (int e = 0; e < 4; ++e) { y[e] = a00[e] * sigm(a10[e]); y[4 + e] = a01[e] * sigm(a11[e]); }
        *(v4u*)(YB + (size_t)row * D + pn * 128 + cw) = pack8(y); } };
struct FMixin { const bf16* PROJ; const bf16* YB; bf16* MIXIN;
    __device__ __forceinline__ void one(int row, int col, f32x4 a0, f32x4 a1) const {
        float ga[8], gb[8], yb[8], o[8];
        unpack8(*(const v4u*)(PROJ + (size_t)row * PROJW + C_GA + col), ga); unpack8(*(const v4u*)(PROJ + (size_t)row * PROJW + C_GB + col), gb);
        unpack8(*(const v4u*)(YB + (size_t)row * D + col), yb);
#pragma unroll
        for (int e = 0; e < 4; ++e) { o[e] = sigm(ga[e]) * a0[e] + sigm(gb[e]) * yb[e]; o[4 + e] = sigm(ga[4 + e]) * a1[e] + sigm(gb[4 + e]) * yb[4 + e]; }
        *(v4u*)(MIXIN + (size_t)row * D + col) = pack8(o); }
    __device__ __forceinline__ void operator()(int row, int pn, int cw, f32x4 a00, f32x4 a01, f32x4 a10, f32x4 a11) const {
        one(row, pn * 256 + cw, a00, a01); one(row, pn * 256 + 128 + cw, a10, a11); } };

template <bool OUT> __device__ __forceinline__ void s5_unit(int id, bf16* PROJ, const bf16* BRT, const bf16* CRT, const float* LAM, const float* dvec, float* Z, const float* X0, LAS unsigned char* wl, int lane) {
    const int b = id / (32 * NCH), rem = id % (32 * NCH), g = rem / NCH, c0 = rem % NCH, row0 = b * TP + 64 * c0, lj = lane & 15, lq = lane >> 4, n = lane;
    LAS float* BU = (LAS float*)wl; LAS unsigned char* Xs = wl + 10240;
    const bf16x8 zf = {0, 0, 0, 0, 0, 0, 0, 0};
    bf16x8 bfrag[8];
#pragma unroll
    for (int nt = 0; nt < 8; ++nt) bfrag[nt] = lq < 2 ? *(const bf16x8*)(BRT + ((size_t)(g * 128 + 16 * nt + lj) * 16 + 8 * lq)) : zf;
    bf16x8 cfrag[4]; float dd[4];
    if (OUT) {
#pragma unroll
        for (int ks = 0; ks < 4; ++ks) cfrag[ks] = *(const bf16x8*)(CRT + ((size_t)(g * 16 + lj) * 128 + 32 * ks + 8 * lq));
#pragma unroll
        for (int r = 0; r < 4; ++r) dd[r] = dvec[g * 16 + 4 * lq + r];
    }
    const float lr = LAM[(g * 64 + n) * 2], li = LAM[(g * 64 + n) * 2 + 1];
    const size_t zi = ((size_t)(b * NCH + c0)) * 4096 + g * 128 + n;
    float xr = 0.f, xi = 0.f;
    if (OUT) { xr = X0[zi]; xi = X0[zi + 64]; }
#pragma unroll 1
    for (int rd = 0; rd < 4; ++rd) {
        bf16* up = PROJ + (size_t)(row0 + 16 * rd + lj) * PROJW + C_U + g * 16;
        const bf16x8 ufrag = lq < 2 ? *(const bf16x8*)(up + 8 * lq) : zf;
        v2u u4 = {0u, 0u}; if (OUT) u4 = *(const v2u*)(up + 4 * lq);
#pragma unroll
        for (int nt = 0; nt < 8; ++nt) { const f32x4 d = __builtin_amdgcn_mfma_f32_16x16x32_bf16(ufrag, bfrag[nt], (f32x4){0.f, 0.f, 0.f, 0.f}, 0, 0, 0);
            *(LAS f32x4*)(BU + (16 * nt + lj) * 20 + 4 * lq) = d; }
        asm volatile("s_waitcnt lgkmcnt(0)" ::: "memory");
#pragma unroll
        for (int t4 = 0; t4 < 4; ++t4) {
            const f32x4 br = *(const LAS f32x4*)(BU + n * 20 + 4 * t4), bi = *(const LAS f32x4*)(BU + (64 + n) * 20 + 4 * t4);
#pragma unroll
            for (int r = 0; r < 4; ++r) {
                const float nxr = lr * xr - li * xi + br[r], nxi = lr * xi + li * xr + bi[r]; xr = nxr; xi = nxi;
                if (OUT) { *(LAS bf16*)(Xs + ((4 * t4 + r) * 136 + n) * 2) = (bf16)f2bf(xr); *(LAS bf16*)(Xs + ((4 * t4 + r) * 136 + 64 + n) * 2) = (bf16)f2bf(xi); }
            }
        }
        if (OUT) {
            asm volatile("s_waitcnt lgkmcnt(0)" ::: "memory");
            f32x4 y = {0.f, 0.f, 0.f, 0.f};
#pragma unroll
            for (int ks = 0; ks < 4; ++ks) y = __builtin_amdgcn_mfma_f32_16x16x32_bf16(cfrag[ks], *(const LAS bf16x8*)(Xs + (lj * 136 + 32 * ks + 8 * lq) * 2), y, 0, 0, 0);
            const float u0 = __uint_as_float(u4.x << 16), u1 = __uint_as_float(u4.x & 0xffff0000u), u2 = __uint_as_float(u4.y << 16), u3 = __uint_as_float(u4.y & 0xffff0000u);
            *(v2u*)(up + 4 * lq) = (v2u){pk2(gelu_t(y[0] + dd[0] * u0), gelu_t(y[1] + dd[1] * u1)), pk2(gelu_t(y[2] + dd[2] * u2), gelu_t(y[3] + dd[3] * u3))};
        }
        asm volatile("s_waitcnt lgkmcnt(0)" ::: "memory");
    }
    if (!OUT) { Z[zi] = xr; Z[zi + 64] = xi; }
}

struct Args { const float* in[33]; float* out; unsigned char* ws; };

__device__ __forceinline__ void transpose_item(const float* W, int K, int N, bf16* WT, int glu, float* scr, int item, int lane) {
    const int nblk = N / 32, kb = item / nblk, nb = item % nblk, k0 = 64 * kb, n0 = 32 * nb;
#pragma unroll 8
    for (int i = 0; i < 32; ++i) { const int kk = 2 * i + (lane >> 5); scr[kk * 33 + (lane & 31)] = W[(size_t)(k0 + kk) * N + n0 + (lane & 31)]; }
    asm volatile("s_waitcnt lgkmcnt(0)" ::: "memory");
    int d0 = n0; if (glu) { const int bj = n0 / 1024, rem = n0 % 1024; d0 = 256 * (rem / 128) + 128 * bj + (rem % 128); }
    const int c = lane & 7;
#pragma unroll
    for (int j = 0; j < 4; ++j) { const int n = (lane >> 3) + 8 * j; const float* s = scr + (8 * c) * 33 + n;
        v4u o; o.x = pk2(s[0 * 33], s[1 * 33]); o.y = pk2(s[2 * 33], s[3 * 33]); o.z = pk2(s[4 * 33], s[5 * 33]); o.w = pk2(s[6 * 33], s[7 * 33]);
        *(v4u*)(WT + (size_t)(d0 + n) * K + k0 + 8 * c) = o; }
    asm volatile("s_waitcnt lgkmcnt(0)" ::: "memory");
}

__device__ __forceinline__ float shiftv(const bf16* PROJ, int row, int j, int col, float mu) {
    const float cur = bf2f(PROJ[(size_t)row * PROJW + col]); const float prev = j > 0 ? bf2f(PROJ[(size_t)(row - 1) * PROJW + col]) : 0.f;
    return cur + (prev - cur) * mu;
}

__global__ void __launch_bounds__(512, 2) mega(Args a) {
    extern __shared__ __attribute__((aligned(16))) unsigned char lds[];
    cg::grid_group grid = cg::this_grid();
    const int tid = threadIdx.x, lane = tid & 63, wave = __builtin_amdgcn_readfirstlane(tid >> 6);
    const int G = gridDim.x, gw = blockIdx.x * 8 + wave, NGW = G * 8;
    unsigned char* ws = a.ws;
    const float* x = a.in[0]; const float* meta = a.in[1];
    bf16* WIN_T = (bf16*)(ws + WO_WIN); bf16* WBR_T = (bf16*)(ws + WO_WBR); bf16* WGLU_T = (bf16*)(ws + WO_WGLU); bf16* WOUT_T = (bf16*)(ws + WO_WOUT);
    bf16* WUP_T = (bf16*)(ws + WO_WUP); bf16* WDN_T = (bf16*)(ws + WO_WDN);
    bf16* HN = (bf16*)(ws + WS_HN); bf16* PROJ = (bf16*)(ws + WS_PROJ);
    bf16* GF = (bf16*)(ws + WS_GF); bf16* HF = (bf16*)(ws + WS_HF); bf16* YR = (bf16*)(ws + WS_YR); bf16* QT = (bf16*)(ws + WS_QT); float* BON = (float*)(ws + WS_BON);
    bf16* BRT = (bf16*)(ws + WO_BRT); bf16* CRT = (bf16*)(ws + WO_CRT); float* LAM = (float*)(ws + WO_LAM); float* LAM64 = (float*)(ws + WO_LAM64); float* ZB = (float*)(ws + WS_Z); float* X0B = (float*)(ws + WS_X0);
    bf16* WUPT = (bf16*)(ws + WO_WUPT); bf16* AUPT = (bf16*)(ws + WO_AUPT); bf16* GUPT = (bf16*)(ws + WO_GUPT);
    bf16* YB = (bf16*)(ws + WS_YB); bf16* MIXIN = (bf16*)(ws + WS_MIXIN); float* MIX = (float*)(ws + WS_MIX); bf16* HN2 = (bf16*)(ws + WS_HN2); bf16* UP = (bf16*)(ws + WS_UP); bf16* FB = (bf16*)(ws + WS_F);
    LAS unsigned char* ldsl = (LAS unsigned char*)lds;

    {
        float* scr = (float*)(lds + wave * 16384);
        constexpr int I0 = 16 * 136, I1 = 8 * 32, I2 = 8 * 64, I3 = 16 * 32, I4 = 16 * 176, I5 = 44 * 32, I6 = 16, I7 = 16, I8 = 32;
        for (int it = gw; it < I0 + I1 + I2 + I3 + I4 + I5 + I6 + I7 + I8; it += NGW) {
            int r = it;
            if (r < I0) { transpose_item(a.in[4], D, PROJW, WIN_T, 0, scr, r, lane); continue; } r -= I0;
            if (r < I1) { transpose_item(a.in[16], RW, D, WBR_T, 0, scr, r, lane); continue; } r -= I1;
            if (r < I2) { transpose_item(a.in[25], RW, 2 * D, WGLU_T, 1, scr, r, lane); continue; } r -= I2;
            if (r < I3) { transpose_item(a.in[26], D, D, WOUT_T, 0, scr, r, lane); continue; } r -= I3;
            if (r < I4) { transpose_item(a.in[29], D, UPW, WUP_T, 0, scr, r, lane); continue; } r -= I4;
            if (r < I5) { transpose_item(a.in[32], DFF, D, WDN_T, 0, scr, r, lane); continue; } r -= I5;
            if (r < I6) { transpose_item(a.in[7], 64, RW, WUPT, 0, scr, r, lane); continue; } r -= I6;
            if (r < I7) { transpose_item(a.in[9], 64, RW, AUPT, 0, scr, r, lane); continue; } r -= I7;
            transpose_item(a.in[10], 128, RW, GUPT, 0, scr, r, lane);
        }
        {
            const int gt = blockIdx.x * 512 + tid;
            if (gt < 2048) {
                const int g = gt >> 6, n = gt & 63;
                const float lre = fminf(a.in[17][gt], -1e-4f), lim = a.in[18][gt], dt = __expf(a.in[19][g]);
                const float mag = __expf(lre * dt); float sn, cs; sincosf(lim * dt, &sn, &cs);
                const float lbr = mag * cs, lbi = mag * sn;
                LAM[gt * 2] = lbr; LAM[gt * 2 + 1] = lbi;
                const float m64 = __expf(64.f * lre * dt); float s64, c64; sincosf(64.f * lim * dt, &s64, &c64);
                LAM64[gt * 2] = m64 * c64; LAM64[gt * 2 + 1] = m64 * s64;
                const float den = lre * lre + lim * lim, nr = lbr - 1.f, ni = lbi;
                const float cr = (nr * lre + ni * lim) / den, ci = (ni * lre - nr * lim) / den;
                for (int i = 0; i < 16; ++i) { const float br = a.in[20][gt * 16 + i], bi = a.in[21][gt * 16 + i];
                    BRT[(size_t)(g * 128 + n) * 16 + i] = (bf16)f2bf(cr * br - ci * bi); BRT[(size_t)(g * 128 + 64 + n) * 16 + i] = (bf16)f2bf(cr * bi + ci * br); }
            }
            for (int idx = gt; idx < 32 * 16 * 128; idx += G * 512) { const int n2 = idx & 127, gh = idx >> 7;
                CRT[idx] = (bf16)f2bf(n2 < 64 ? a.in[22][gh * 64 + n2] : -a.in[23][gh * 64 + n2 - 64]); }
        }
        const float* g = a.in[2];
        for (int row = gw; row < MP; row += NGW) {
            const int b = row / TP, j = row - b * TP;
            v2u* o = (v2u*)(HN + (size_t)row * D) + lane;
            if (j < PADR) {
#pragma unroll
                for (int jj = 0; jj < 4; ++jj) o[64 * jj] = (v2u){0u, 0u};
                continue; }
            const float* src = j < 64 ? meta + (size_t)(j - PADR) * D : x + ((size_t)b * SEQ + (j - 64)) * D;
            f32x4 v[4]; float ss = 0.f;
#pragma unroll
            for (int jj = 0; jj < 4; ++jj) { v[jj] = ((const f32x4*)src)[lane + 64 * jj]; ss += (v[jj].x * v[jj].x + v[jj].y * v[jj].y) + (v[jj].z * v[jj].z + v[jj].w * v[jj].w); }
            const float rstd = rsqrtf(wave_sum(ss) * (1.f / D) + 1e-6f);
#pragma unroll
            for (int jj = 0; jj < 4; ++jj) { const f32x4 g4 = ((const f32x4*)g)[lane + 64 * jj];
                o[64 * jj] = (v2u){pk2(v[jj].x * rstd * g4.x, v[jj].y * rstd * g4.y), pk2(v[jj].z * rstd * g4.z, v[jj].w * rstd * g4.w)}; }
        }
    }
    grid.sync();
    { pg8::Gemm g{HN, WIN_T, MP, PROJW, D, D, D}; pg8::StaticOrder S; S.init(MP, PROJW, G, (int)blockIdx.x);
      pg8::EpiF<FStoreBf16> E{{PROJ, PROJW}};
      pg8::gemm_phase<pg8::EpiF<FStoreBf16>, pg8::StaticOrder, true, true>(ldsl, g, S, E); }
    grid.sync();
    {
        const float* mu = a.in[5]; const float* w0 = a.in[6]; const float* a0 = a.in[8]; const float* k_k = a.in[11]; const float* k_a = a.in[12]; const float* r_k = a.in[13];
        float* tot = (float*)(lds + MISC_OFF); float* WCs = tot + 512;
        float* WLf = (float*)(lds + 13 * OPB); float* ALf = WLf + 64 * 68;
        const int ty = wave >> 1, txb = 2 * (wave & 1), lj = lane & 15, lq = lane >> 4, y0 = 16 * ty, yy = y0 + lj;
        for (int unit = blockIdx.x; unit < NUNIT; unit += G) {
            const int c0 = unit % NCH, bh = unit / NCH, b = bh >> 3, h = bh & 7, row0 = b * TP + 64 * c0, tq = wave, c = lane, hc = h * 64 + c;
            float rs[8], ks[8], vs[8];
            {
                float rv[9], kv[9], vv[9], wdv[9], adv[9];
#pragma unroll
                for (int i = 0; i < 9; ++i) {
                    const bool valid = (c0 > 0) || (8 * tq + i > 0);
                    const bf16* p = PROJ + (size_t)(row0 + 8 * tq + i - (valid ? 1 : 0)) * PROJW;
                    rv[i] = valid ? bf2f(p[hc]) : 0.f; kv[i] = valid ? bf2f(p[C_K + hc]) : 0.f; vv[i] = valid ? bf2f(p[C_V + hc]) : 0.f;
                    wdv[i] = valid ? bf2f(p[C_WD + c]) : 0.f; adv[i] = valid ? bf2f(p[C_AD + c]) : 0.f;
                }
                const float mur = mu[hc], muk = mu[C_K + hc], muv = mu[C_V + hc], muw = mu[C_WD + c], mua = mu[C_AD + c];
#pragma unroll
                for (int u = 0; u < 8; ++u) {
                    rs[u] = rv[u + 1] + (rv[u] - rv[u + 1]) * mur; ks[u] = kv[u + 1] + (kv[u] - kv[u + 1]) * muk; vs[u] = vv[u + 1] + (vv[u] - vv[u + 1]) * muv;
                    const float wd = wdv[u + 1] + (wdv[u] - wdv[u + 1]) * muw, ad = adv[u + 1] + (adv[u] - adv[u + 1]) * mua;
                    *(LAS bf16*)(SLOT(11) + ((8 * tq + u) * OP + c) * 2) = (bf16)f2bf(tanhf(wd));
                    *(LAS bf16*)(SLOT(12) + ((8 * tq + u) * OP + c) * 2) = (bf16)f2bf(ad);
                }
            }
            __syncthreads();
#pragma unroll
            for (int e = 0; e < 2; ++e) {
                const int x0 = 16 * (txb + e), xs = x0 + 4 * lq;
                f32x4 aw = {0.f, 0.f, 0.f, 0.f}, aa = {0.f, 0.f, 0.f, 0.f};
#pragma unroll
                for (int kq = 0; kq < 2; ++kq) {
                    const bf16x8 fw = *(const bf16x8*)(WUPT + (size_t)(h * 64 + x0 + lj) * 64 + 32 * kq + 8 * lq);
                    const bf16x8 fa = *(const bf16x8*)(AUPT + (size_t)(h * 64 + x0 + lj) * 64 + 32 * kq + 8 * lq);
                    aw = __builtin_amdgcn_mfma_f32_16x16x32_bf16(fw, ldfrag(SLOT(11), y0, kq, lane), aw, 0, 0, 0);
                    aa = __builtin_amdgcn_mfma_f32_16x16x32_bf16(fa, ldfrag(SLOT(12), y0, kq, lane), aa, 0, 0, 0);
                }
                *(f32x4*)(WLf + yy * 68 + xs) = aw; *(f32x4*)(ALf + yy * 68 + xs) = aa;
            }
            __syncthreads();
            {
                float lw[8], av[8], cum[8];
                const float w0c = w0[hc], a0c = a0[hc], kkc = k_k[hc], kac = k_a[hc], rkc = r_k[hc];
#pragma unroll
                for (int u = 0; u < 8; ++u) { const int t = 8 * tq + u; lw[u] = -0.60653066f * sigm(w0c + WLf[t * 68 + c]); av[u] = sigm(a0c + ALf[t * 68 + c]); }
                cum[0] = lw[0];
#pragma unroll
                for (int u = 1; u < 8; ++u) cum[u] = cum[u - 1] + lw[u];
                tot[tq * 64 + c] = cum[7];
                __syncthreads();
                float off = 0.f, all = 0.f;
#pragma unroll
                for (int w = 0; w < 8; ++w) { const float tv = tot[w * 64 + c]; all += tv; off += (w < tq) ? tv : 0.f; }
                float kkdT[8], bdT[8], kdT[8];
#pragma unroll
                for (int u = 0; u < 8; ++u) {
                    const int t = 8 * tq + u; const float ci = off + cum[u], cx = ci - lw[u];
                    const float kkv = ks[u] * kkc; const float n2 = wave_sum(kkv * kkv); const float kk = kkv / fmaxf(sqrtf(n2), 1e-12f);
                    const float k2 = ks[u] * (1.f + (av[u] - 1.f) * kac), bb = kk * av[u];
                    const float em = __expf(-ci), ed = __expf(all - ci);
                    kkdT[u] = kk * __expf(cx); bdT[u] = bb * ed; kdT[u] = k2 * ed;
                    *(LAS bf16*)(SLOT(0) + (t * OP + c) * 2) = (bf16)f2bf(kkdT[u]);
                    *(LAS bf16*)(SLOT(1) + (t * OP + c) * 2) = (bf16)f2bf(bb * em);
                    *(LAS bf16*)(SLOT(2) + (t * OP + c) * 2) = (bf16)f2bf(k2 * em);
                    *(LAS bf16*)(SLOT(3) + (t * OP + c) * 2) = (bf16)f2bf(rs[u] * __expf(ci));
                    const float rk = wave_sum(rs[u] * k2 * rkc);
                    if (lane == 0) BON[(size_t)(row0 + t) * 8 + h] = rk;
                }
                *(LAS v4u*)(SLOT(4) + (c * OP + 8 * tq) * 2) = pack8(kkdT);
                *(LAS v4u*)(SLOT(5) + (c * OP + 8 * tq) * 2) = pack8(bdT);
                *(LAS v4u*)(SLOT(6) + (c * OP + 8 * tq) * 2) = pack8(kdT);
                *(LAS v4u*)(SLOT(7) + (c * OP + 8 * tq) * 2) = pack8(vs);
                if (tq == 0) WCs[c] = __expf(all);
            }
            __syncthreads();
            f32x4 Pacc[2];
#pragma unroll
            for (int e = 0; e < 2; ++e) {
                const int x0 = 16 * (txb + e), xs = x0 + 4 * lq; const f32x4 z = {0.f, 0.f, 0.f, 0.f};
                f32x4 v = tmm(SLOT(1), x0, SLOT(0), y0, z, lane);
#pragma unroll
                for (int r = 0; r < 4; ++r) { v[r] = (xs + r < yy) ? v[r] : 0.f; Pacc[e][r] = ((xs + r == yy) ? 1.f : 0.f) - v[r]; }
                st4(SLOT(11), yy, xs, v); st4(SLOT(15), yy, xs, Pacc[e]);
                v = tmm(SLOT(0), x0, SLOT(1), y0, z, lane);
#pragma unroll
                for (int r = 0; r < 4; ++r) v[r] = (yy < xs + r) ? v[r] : 0.f;
                st4(SLOT(12), yy, xs, v);
                v = tmm(SLOT(2), x0, SLOT(0), y0, z, lane);
#pragma unroll
                for (int r = 0; r < 4; ++r) v[r] = (xs + r < yy) ? v[r] : 0.f;
                st4(SLOT(8), yy, xs, v);
                v = tmm(SLOT(1), x0, SLOT(3), y0, z, lane);
#pragma unroll
                for (int r = 0; r < 4; ++r) v[r] = (xs + r <= yy) ? v[r] : 0.f;
                st4(SLOT(9), yy, xs, v);
                v = tmm(SLOT(2), x0, SLOT(3), y0, z, lane);
#pragma unroll
                for (int r = 0; r < 4; ++r) v[r] = (xs + r <= yy) ? v[r] : 0.f;
                st4(SLOT(10), yy, xs, v);
            }
            __syncthreads();
#pragma unroll
            for (int e = 0; e < 2; ++e) {
                const int x0 = 16 * (txb + e), xs = x0 + 4 * lq; const f32x4 z = {0.f, 0.f, 0.f, 0.f};
                st4(SLOT(13), yy, xs, tmm(SLOT(12), x0, SLOT(11), y0, z, lane));
                st4(SLOT(14), yy, xs, tmm(SLOT(11), x0, SLOT(12), y0, z, lane));
                st4(SLOT(1), yy, xs, tmm(SLOT(8), x0, SLOT(7), y0, z, lane));
            }
            __syncthreads();
#define NEUMANN_STAGE(LT_cur, L_cur, P_cur, P_nxt, L_nxt, LT_nxt, DO_SQ, DO_SQ_L) \
            _Pragma("unroll") for (int e = 0; e < 2; ++e) { \
                const int x0 = 16 * (txb + e), xs = x0 + 4 * lq; const f32x4 z = {0.f, 0.f, 0.f, 0.f}; \
                Pacc[e] = tmm(SLOT(LT_cur), x0, SLOT(P_cur), y0, Pacc[e], lane); st4(SLOT(P_nxt), yy, xs, Pacc[e]); \
                if (DO_SQ_L) st4(SLOT(L_nxt), yy, xs, tmm(SLOT(LT_cur), x0, SLOT(L_cur), y0, z, lane)); \
                if (DO_SQ) st4(SLOT(LT_nxt), yy, xs, tmm(SLOT(L_cur), x0, SLOT(LT_cur), y0, z, lane)); \
            } __syncthreads();
            NEUMANN_STAGE(14, 13, 15, 16, 11, 12, true, true)
            NEUMANN_STAGE(12, 11, 16, 15, 13, 14, true, true)
            NEUMANN_STAGE(14, 13, 15, 16, 11, 12, true, true)
            NEUMANN_STAGE(12, 11, 16, 15, 13, 14, true, false)
            NEUMANN_STAGE(14, 13, 15, 16, 11, 12, false, false)
#pragma unroll
            for (int e = 0; e < 2; ++e) {
                const int x0 = 16 * (txb + e), xs = x0 + 4 * lq; const f32x4 z = {0.f, 0.f, 0.f, 0.f};
                st4(SLOT(0), yy, xs, tmm(SLOT(16), x0, SLOT(4), y0, z, lane));
                f32x4 v = tmm(SLOT(16), x0, SLOT(1), y0, z, lane);
                st4(SLOT(2), yy, xs, -v);
            }
            __syncthreads();
#pragma unroll
            for (int e = 0; e < 2; ++e) {
                const int tx = txb + e, x0 = 16 * tx, xs = x0 + 4 * lq; const f32x4 z = {0.f, 0.f, 0.f, 0.f};
                f32x4 v = tmm(SLOT(0), x0, SLOT(5), y0, z, lane);
                const float wc = WCs[yy];
#pragma unroll
                for (int r = 0; r < 4; ++r) v[r] = ((xs + r == yy) ? wc : 0.f) - v[r];
                *(v2u*)(GF + (size_t)unit * 4096 + ((ty * 2 + (tx >> 1)) * 64 + lane) * 8 + 4 * (tx & 1)) = (v2u){pk2(v[0], v[1]), pk2(v[2], v[3])};
                v = tmm(SLOT(5), x0, SLOT(2), y0, z, lane); v = tmm(SLOT(6), x0, SLOT(7), y0, v, lane);
                *(v2u*)(HF + (size_t)unit * 4096 + ((ty * 4 + tx) * 64 + lane) * 4) = (v2u){pk2(v[0], v[1]), pk2(v[2], v[3])};
                v = tmm(SLOT(0), x0, SLOT(9), y0, z, lane);
                { const v2u rd = *(const LAS v2u*)(SLOT(3) + (yy * OP + xs) * 2);
                  v[0] = __uint_as_float(rd.x << 16) - v[0]; v[1] = __uint_as_float(rd.x & 0xffff0000u) - v[1]; v[2] = __uint_as_float(rd.y << 16) - v[2]; v[3] = __uint_as_float(rd.y & 0xffff0000u) - v[3]; }
                *(v2u*)(QT + (size_t)unit * 4096 + yy * 64 + xs) = (v2u){pk2(v[0], v[1]), pk2(v[2], v[3])};
                v = tmm(SLOT(2), x0, SLOT(9), y0, z, lane); v = tmm(SLOT(7), x0, SLOT(10), y0, v, lane);
                *(v2u*)(YR + (size_t)(row0 + yy) * RW + h * 64 + xs) = (v2u){pk2(v[0], v[1]), pk2(v[2], v[3])};
            }
            __syncthreads();
        }
        for (int wu = gw; wu < S5UNITS; wu += NGW) s5_unit<false>(wu, PROJ, BRT, CRT, LAM, a.in[24], ZB, X0B, ldsl + wave * 14592, lane);
    }
    grid.sync();
    for (int unit = blockIdx.x; unit < 48; unit += G) {
        if (unit < 32) {
            const int bh = unit;
            const bf16* gsrc = GF + (size_t)bh * NCH * 4096; bf16* hsrc = HF + (size_t)bh * NCH * 4096;
            constexpr int DEPTH = 7;
            if (wave >= 4) {
                const int lt = tid - 256;
#define CH_ISSUE(step) do { const int st_ = (step) < NCH ? (step) : NCH - 1; const unsigned so_ = (unsigned)((step) & 7) * 16384u + (unsigned)(wave - 4) * 1024u; \
                    __builtin_amdgcn_global_load_lds((const unsigned*)(gsrc + (size_t)st_ * 4096 + lt * 8), (LAS unsigned*)(ldsl + so_), 16, 0, 0); \
                    __builtin_amdgcn_global_load_lds((const unsigned*)(gsrc + (size_t)st_ * 4096 + 2048 + lt * 8), (LAS unsigned*)(ldsl + so_ + 4096), 16, 0, 0); \
                    __builtin_amdgcn_global_load_lds((const unsigned*)(hsrc + (size_t)st_ * 4096 + lt * 8), (LAS unsigned*)(ldsl + so_ + 8192), 16, 0, 0); \
                    __builtin_amdgcn_global_load_lds((const unsigned*)(hsrc + (size_t)st_ * 4096 + 2048 + lt * 8), (LAS unsigned*)(ldsl + so_ + 12288), 16, 0, 0); } while (0)
                for (int s = 0; s < DEPTH; ++s) CH_ISSUE(s);
                for (int cidx = 0; cidx < NCH; ++cidx) {
                    asm volatile("s_waitcnt vmcnt(24)" ::: "memory");
                    __builtin_amdgcn_s_barrier();
                    CH_ISSUE(cidx + DEPTH);
                }
                asm volatile("s_waitcnt vmcnt(0)" ::: "memory");
            } else {
                const int vq = wave;
                f32x4 acc[4];
#pragma unroll
                for (int i = 0; i < 4; ++i) acc[i] = (f32x4){0.f, 0.f, 0.f, 0.f};
                for (int cidx = 0; cidx < NCH; ++cidx) {
                    __builtin_amdgcn_s_barrier();
                    const LAS unsigned char* base = ldsl + (cidx & 7) * 16384;
                    bf16x8 bfr[2];
#pragma unroll
                    for (int s = 0; s < 2; ++s) { v4u w; w.x = pk2(acc[2 * s][0], acc[2 * s][1]); w.y = pk2(acc[2 * s][2], acc[2 * s][3]); w.z = pk2(acc[2 * s + 1][0], acc[2 * s + 1][1]); w.w = pk2(acc[2 * s + 1][2], acc[2 * s + 1][3]);
                        bfr[s] = __builtin_bit_cast(bf16x8, w); }
                    f32x4 nacc[4];
#pragma unroll
                    for (int tk = 0; tk < 4; ++tk) {
                        const v2u hv = *(const LAS v2u*)(base + 8192 + ((vq * 4 + tk) * 64 + lane) * 8);
                        nacc[tk] = (f32x4){__uint_as_float(hv.x << 16), __uint_as_float(hv.x & 0xffff0000u), __uint_as_float(hv.y << 16), __uint_as_float(hv.y & 0xffff0000u)};
#pragma unroll
                        for (int s = 0; s < 2; ++s) nacc[tk] = __builtin_amdgcn_mfma_f32_16x16x32_bf16(*(const LAS bf16x8*)(base + ((tk * 2 + s) * 64 + lane) * 16), bfr[s], nacc[tk], 0, 0, 0);
                    }
#pragma unroll
                    for (int tk = 0; tk < 4; ++tk) { acc[tk] = nacc[tk];
                        *(v2u*)(hsrc + (size_t)cidx * 4096 + ((vq * 4 + tk) * 64 + lane) * 4) = (v2u){pk2(acc[tk][0], acc[tk][1]), pk2(acc[tk][2], acc[tk][3])}; }
                }
            }
            __syncthreads();
        } else {
            const int ch = (unit - 32) * 512 + tid, b = ch >> 11, gn = ch & 2047;
            const float l64r = LAM64[gn * 2], l64i = LAM64[gn * 2 + 1];
            const size_t cb = (size_t)b * NCH * 4096 + (gn >> 6) * 128 + (gn & 63);
            float xr = 0.f, xi = 0.f;
            for (int c0 = 0; c0 < NCH; c0 += 8) {
                float zr[8], zi[8];
#pragma unroll
                for (int u = 0; u < 8; ++u) { const int cc = c0 + u < NCH ? c0 + u : NCH - 1; zr[u] = ZB[cb + (size_t)cc * 4096]; zi[u] = ZB[cb + (size_t)cc * 4096 + 64]; }
#pragma unroll
                for (int u = 0; u < 8; ++u) if (c0 + u < NCH) {
                    X0B[cb + (size_t)(c0 + u) * 4096] = xr; X0B[cb + (size_t)(c0 + u) * 4096 + 64] = xi;
                    const float nxr = l64r * xr - l64i * xi + zr[u], nxi = l64r * xi + l64i * xr + zi[u]; xr = nxr; xi = nxi; }
            }
        }
    }
    grid.sync();
    {
        const float* mu = a.in[5]; const float* ln_g = a.in[14]; const float* ln_b = a.in[15];
        LAS unsigned char* SG = ldsl; float* Yf = (float*)(lds + 17408); float* Gf32 = Yf + 64 * 68;
        const int ty = wave >> 1, txb = 2 * (wave & 1), lj = lane & 15, lq = lane >> 4, y0 = 16 * ty, yy = y0 + lj;
        for (int unit = blockIdx.x; unit < NUNIT; unit += G) {
            const int c0 = unit % NCH, bh = unit / NCH, b = bh >> 3, h = bh & 7, row0 = b * TP + 64 * c0, tq = wave, c = lane, hc = h * 64 + c;
            float vs[8];
            {
                float vv[9], g0[9], g1[9];
#pragma unroll
                for (int i = 0; i < 9; ++i) {
                    const bool valid = (c0 > 0) || (8 * tq + i > 0);
                    const bf16* p = PROJ + (size_t)(row0 + 8 * tq + i - (valid ? 1 : 0)) * PROJW;
                    vv[i] = valid ? bf2f(p[C_V + hc]) : 0.f; g0[i] = valid ? bf2f(p[C_GD + c]) : 0.f; g1[i] = valid ? bf2f(p[C_GD + 64 + c]) : 0.f;
                }
                const float muv = mu[C_V + hc], mg0 = mu[C_GD + c], mg1 = mu[C_GD + 64 + c];
#pragma unroll
                for (int u = 0; u < 8; ++u) {
                    vs[u] = vv[u + 1] + (vv[u] - vv[u + 1]) * muv;
                    *(LAS bf16*)(SG + ((8 * tq + u) * 136 + c) * 2) = (bf16)f2bf(sigm(g0[u + 1] + (g0[u] - g0[u + 1]) * mg0));
                    *(LAS bf16*)(SG + ((8 * tq + u) * 136 + 64 + c) * 2) = (bf16)f2bf(sigm(g1[u + 1] + (g1[u] - g1[u + 1]) * mg1));
                }
            }
#pragma unroll
            for (int e = 0; e < 2; ++e) {
                const int tx = txb + e, xs = 16 * tx + 4 * lq;
                f32x4 v = {0.f, 0.f, 0.f, 0.f};
                if (c0 > 0) {
                    const bf16* sp = HF + (size_t)(unit - 1) * 4096; const bf16* qp = QT + (size_t)unit * 4096;
#pragma unroll
                    for (int kq = 0; kq < 2; ++kq) {
                        const v2u s0 = *(const v2u*)(sp + ((tx * 4 + 2 * kq + (lq >> 1)) * 64 + 16 * (2 * (lq & 1)) + lj) * 4);
                        const v2u s1 = *(const v2u*)(sp + ((tx * 4 + 2 * kq + (lq >> 1)) * 64 + 16 * (2 * (lq & 1) + 1) + lj) * 4);
                        const v4u sw = {s0.x, s0.y, s1.x, s1.y};
                        const bf16x8 qf = *(const bf16x8*)(qp + yy * 64 + 32 * kq + 8 * lq);
                        v = __builtin_amdgcn_mfma_f32_16x16x32_bf16(__builtin_bit_cast(bf16x8, sw), qf, v, 0, 0, 0);
                    }
                }
                const v2u yl = *(const v2u*)(YR + (size_t)(row0 + yy) * RW + h * 64 + xs);
                v[0] += __uint_as_float(yl.x << 16); v[1] += __uint_as_float(yl.x & 0xffff0000u); v[2] += __uint_as_float(yl.y << 16); v[3] += __uint_as_float(yl.y & 0xffff0000u);
                *(f32x4*)(Yf + yy * 68 + xs) = v;
            }
            __syncthreads();
#pragma unroll
            for (int e = 0; e < 2; ++e) {
                const int x0 = 16 * (txb + e), xs = x0 + 4 * lq;
                f32x4 v = {0.f, 0.f, 0.f, 0.f};
#pragma unroll
                for (int kq = 0; kq < 4; ++kq) {
                    const bf16x8 fg = *(const bf16x8*)(GUPT + (size_t)(h * 64 + x0 + lj) * 128 + 32 * kq + 8 * lq);
                    const bf16x8 fs = *(const LAS bf16x8*)(SG + ((y0 + lj) * 136 + 32 * kq + 8 * lq) * 2);
                    v = __builtin_amdgcn_mfma_f32_16x16x32_bf16(fg, fs, v, 0, 0, 0);
                }
                *(f32x4*)(Gf32 + yy * 68 + xs) = v;
            }
            __syncthreads();
            {
                const float lg = ln_g[hc], lb = ln_b[hc];
#pragma unroll
                for (int u = 0; u < 8; ++u) {
                    const int t = 8 * tq + u;
                    const float y = Yf[t * 68 + c]; const float mean = wave_sum(y) * (1.f / 64.f); const float dv = y - mean; const float var = wave_sum(dv * dv) * (1.f / 64.f);
                    const float yn = dv * rsqrtf(var + 64e-5f) * lg + lb;
                    const float bonus = BON[(size_t)(row0 + t) * 8 + h] * vs[u];
                    YR[(size_t)(row0 + t) * RW + hc] = (bf16)f2bf((yn + bonus) * Gf32[t * 68 + c]);
                }
            }
            __syncthreads();
        }
        for (int wu = gw; wu < S5UNITS; wu += NGW) s5_unit<true>(wu, PROJ, BRT, CRT, LAM, a.in[24], ZB, X0B, ldsl + wave * 14592, lane);
    }
    grid.sync();
    { pg8::Gemm g{PROJ + C_U, WGLU_T, MP, 2 * D, RW, PROJW, RW}; pg8::StaticOrder S; S.init(MP, 2 * D, G, (int)blockIdx.x);
      pg8::EpiF<FGlu> E{{YB}};
      pg8::gemm_phase<pg8::EpiF<FGlu>, pg8::StaticOrder, true, true>(ldsl, g, S, E); }
    grid.sync();
    { pg8::Gemm g{YR, WBR_T, MP, D, RW, RW, RW}; pg8::StaticOrder S; S.init(MP, D, G, (int)blockIdx.x);
      pg8::EpiF<FMixin> E{{PROJ, YB, MIXIN}};
      pg8::gemm_phase<pg8::EpiF<FMixin>, pg8::StaticOrder, true, true>(ldsl, g, S, E); }
    grid.sync();
    { pg8::Gemm g{MIXIN, WOUT_T, MP, D, D, D, D}; pg8::StaticOrder S; S.init(MP, D, G, (int)blockIdx.x);
      pg8::EpiF<FStoreF32> E{{MIX, D}};
      pg8::gemm_phase<pg8::EpiF<FStoreF32>, pg8::StaticOrder, true, true>(ldsl, g, S, E); }
    grid.sync();
    {
        const float* gp = a.in[3]; const float* gf = a.in[27];
        for (int row = gw; row < MP; row += NGW) {
            const int b = row / TP, j = row - b * TP;
            v2u* o = (v2u*)(HN2 + (size_t)row * D) + lane;
            if (j < PADR) {
#pragma unroll
                for (int jj = 0; jj < 4; ++jj) o[64 * jj] = (v2u){0u, 0u};
                continue; }
            const float* src = j < 64 ? meta + (size_t)(j - PADR) * D : x + ((size_t)b * SEQ + (j - 64)) * D;
            const f32x4* mr = (const f32x4*)(MIX + (size_t)row * D);
            f32x4 m[4], hv[4]; float ss = 0.f;
#pragma unroll
            for (int jj = 0; jj < 4; ++jj) { m[jj] = mr[lane + 64 * jj]; hv[jj] = ((const f32x4*)src)[lane + 64 * jj]; ss += (m[jj].x * m[jj].x + m[jj].y * m[jj].y) + (m[jj].z * m[jj].z + m[jj].w * m[jj].w); }
            const float rstd = rsqrtf(wave_sum(ss) * (1.f / D) + 1e-6f); float s2 = 0.f;
#pragma unroll
            for (int jj = 0; jj < 4; ++jj) { const f32x4 g4 = ((const f32x4*)gp)[lane + 64 * jj]; hv[jj] = hv[jj] + m[jj] * rstd * g4;
                s2 += (hv[jj].x * hv[jj].x + hv[jj].y * hv[jj].y) + (hv[jj].z * hv[jj].z + hv[jj].w * hv[jj].w); }
            const float rstd2 = rsqrtf(wave_sum(s2) * (1.f / D) + 1e-6f);
            if (j >= 64) { f32x4* od = (f32x4*)(a.out + ((size_t)b * SEQ + (j - 64)) * D);
#pragma unroll
                for (int jj = 0; jj < 4; ++jj) od[lane + 64 * jj] = hv[jj]; }
#pragma unroll
            for (int jj = 0; jj < 4; ++jj) { const f32x4 g4 = ((const f32x4*)gf)[lane + 64 * jj];
                o[64 * jj] = (v2u){pk2(hv[jj].x * rstd2 * g4.x, hv[jj].y * rstd2 * g4.y), pk2(hv[jj].z * rstd2 * g4.z, hv[jj].w * rstd2 * g4.w)}; }
        }
    }
    grid.sync();
    { pg8::Gemm g{HN2, WUP_T, MP, UPW, D, D, D}; pg8::StaticOrder S; S.init(MP, UPW, G, (int)blockIdx.x);
      pg8::EpiF<FStoreBf16> E{{UP, UPW}};
      pg8::gemm_phase<pg8::EpiF<FStoreBf16>, pg8::StaticOrder, true, true>(ldsl, g, S, E); }
    grid.sync();
    {
        const float* cw = a.in[30]; const float* cb = a.in[31];
        const size_t total = (size_t)MP * (DFF / 8);
        for (size_t idx = (size_t)blockIdx.x * 512 + tid; idx < total; idx += (size_t)G * 512) {
            const int row = (int)(idx / (DFF / 8)), c = (int)(idx % (DFF / 8)) * 8, j = row % TP;
            const bf16* p = UP + (size_t)row * UPW + c;
            float a0[8], a1[8], a2[8], gt[8], o[8];
            unpack8(*(const v4u*)p, a0); unpack8(*(const v4u*)(p + DFF), gt);
            if (j >= 1) unpack8(*(const v4u*)(p - UPW), a1); else {
#pragma unroll
                for (int e = 0; e < 8; ++e) a1[e] = 0.f; }
            if (j >= 2) unpack8(*(const v4u*)(p - 2 * UPW), a2); else {
#pragma unroll
                for (int e = 0; e < 8; ++e) a2[e] = 0.f; }
#pragma unroll
            for (int e = 0; e < 8; ++e) { const float cv = cw[c + e] * a2[e] + cw[DFF + c + e] * a1[e] + cw[2 * DFF + c + e] * a0[e] + cb[c + e]; o[e] = gelu_t(cv) * gt[e]; }
            *(v4u*)(UP + (size_t)row * UPW + DFF + c) = pack8(o);
        }
    }
    grid.sync();
    { pg8::Gemm g{UP + DFF, WDN_T, MP, D, DFF, UPW, DFF}; pg8::StaticOrder S; S.init(MP, D, G, (int)blockIdx.x);
      pg8::EpiF<FStoreBf16> E{{FB, D}};
      pg8::gemm_phase<pg8::EpiF<FStoreBf16>, pg8::StaticOrder, true, true>(ldsl, g, S, E); }
    grid.sync();
    {
        const float* gq = a.in[28];
        for (int r = gw; r < NB * SEQ; r += NGW) {
            const int b = r / SEQ, t = r - b * SEQ; const int row = b * TP + 64 + t;
            const v2u* fr = (const v2u*)(FB + (size_t)row * D);
            f32x4 fv[4]; float ss = 0.f;
#pragma unroll
            for (int jj = 0; jj < 4; ++jj) { const v2u q = fr[lane + 64 * jj]; fv[jj] = (f32x4){__uint_as_float(q.x << 16), __uint_as_float(q.x & 0xffff0000u), __uint_as_float(q.y << 16), __uint_as_float(q.y & 0xffff0000u)};
                ss += (fv[jj].x * fv[jj].x + fv[jj].y * fv[jj].y) + (fv[jj].z * fv[jj].z + fv[jj].w * fv[jj].w); }
            const float rstd = rsqrtf(wave_sum(ss) * (1.f / D) + 1e-6f);
            f32x4* od = (f32x4*)(a.out + (size_t)r * D);
#pragma unroll
            for (int jj = 0; jj < 4; ++jj) { const f32x4 g4 = ((const f32x4*)gq)[lane + 64 * jj]; od[lane + 64 * jj] = od[lane + 64 * jj] + fv[jj] * rstd * g4; }
        }
    }
}

extern "C" void kernel_launch(void* const* d_in, const int* in_sizes, int n_in, void* d_out, int out_size, void* d_ws, size_t ws_size, hipStream_t stream) {
    static int grid = 0;
    if (grid == 0) {
        if (n_in != 33 || ws_size < WS_END) { fprintf(stderr, "kernel_launch: unexpected n_in %d / ws_size %zu\n", n_in, ws_size); grid = -1; return; }
        int dev = 0, cus = 0, per_cu = 0;
        (void)hipGetDevice(&dev); (void)hipDeviceGetAttribute(&cus, hipDeviceAttributeMultiprocessorCount, dev);
        (void)hipFuncSetAttribute((const void*)mega, hipFuncAttributeMaxDynamicSharedMemorySize, LDS_BYTES);
        (void)hipOccupancyMaxActiveBlocksPerMultiprocessor(&per_cu, (const void*)mega, 512, LDS_BYTES);
        if (per_cu < 1) { fprintf(stderr, "kernel_launch: occupancy query says %d blocks/CU\n", per_cu); per_cu = 1; }
        (void)hipGetLastError();
        grid = cus * per_cu;
    }
    if (grid < 0) return;
    Args a{};
    for (int i = 0; i < 33; ++i) a.in[i] = (const float*)d_in[i];
    a.out = (float*)d_out; a.ws = (unsigned char*)d_ws;
    void* args[] = {&a};
    hipError_t e = hipLaunchCooperativeKernel((const void*)mega, dim3(grid), dim3(512), args, LDS_BYTES, stream);
    if (e != hipSuccess) fprintf(stderr, "cooperative launch failed: %s (grid %d)\n", hipGetErrorString(e), grid);
}
```

```cpp
#include <hip/hip_runtime.h>
#include <hip/hip_cooperative_groups.h>
#include <cstdio>
#include <cstdint>
namespace cg = cooperative_groups;
#ifndef REPG
#define REPG 1
#endif
namespace pg8 {
#define PG8_LAS __attribute__((address_space(3)))
typedef unsigned short bf16_t;
typedef short bf16x8 __attribute__((ext_vector_type(8)));
typedef float f32x4 __attribute__((ext_vector_type(4)));
typedef unsigned u32x4 __attribute__((ext_vector_type(4)));
constexpr int BM = 256, BK = 64, HALF = 128, HTB = HALF * BK * 2  , STAGE_BYTES = 8 * HTB, NXCD = 8, WGM = 8;

__host__ __device__ __forceinline__ int lds_byte(int r, int c) { const int st = (r >> 4) * 2 + (c >> 5), rr = r & 15, cc = c & 31, ob = rr * 64 + cc * 2; return st * 1024 + (ob ^ (((ob >> 9) & 1) << 5)); }
__host__ __device__ __forceinline__ void stage_rc(int b, int& R, int& C) { const int st = b / 1024, sb = b % 1024, swz = sb ^ (((sb >> 9) & 1) << 5); R = (st >> 1) * 16 + swz / 64; C = (st & 1) * 32 + (swz % 64) / 2; }
__host__ __device__ __forceinline__ int perm32(int rho) { const int n = rho >> 4, i = rho & 15; return 8 * (i >> 2) + 4 * n + (i & 3); }

struct Unit { int pm, pn; };
struct Gemm { const bf16_t* A; const bf16_t* Bt; int M, N, K, lda, ldb; };

struct StaticOrder {
    int nM, nN, nwg, G, c;
    __host__ __device__ void init(int M, int N, int G_, int c_) { nM = M / BM; nN = N / BM; nwg = nM * nN; G = G_; c = c_; }
    __host__ __device__ bool next(int i, Unit& u) const {
        const long L = (long)i * G + c; if (L >= (long)nwg * REPG) return false;
        int wgid = (int)(L % nwg); { const int q = nwg / NXCD, r = nwg % NXCD, xcd = wgid % NXCD, off = wgid / NXCD; wgid = (xcd < r ? xcd * (q + 1) : r * (q + 1) + (xcd - r) * q) + off; }
        const int nig = WGM * nN, gid = wgid / nig, fm = gid * WGM, gsz = (nM - fm) < WGM ? (nM - fm) : WGM;
        u.pm = fm + ((wgid % nig) % gsz); u.pn = (wgid % nig) / gsz; return true;
    }
    __device__ __forceinline__ void a_ready(const Unit&) const {}
    __device__ __forceinline__ void done(const Unit&) const {}
};


template <class F> struct EpiF {
    static constexpr bool PERM = true, AFTER_DRAIN = false; F f;
    __device__ __forceinline__ void operator()(const f32x4 (&acc)[2][2][4][2], const Unit& u, int wr, int wc, int fr, int fq) const {
        const int cw = wc * 32 + 8 * fq;
#pragma unroll
        for (int ai = 0; ai < 2; ++ai)
#pragma unroll
            for (int m = 0; m < 4; ++m) {
                const int row = u.pm * BM + ai * HALF + wr * 64 + m * 16 + fr;
                f(row, u.pn, cw, acc[ai][0][m][0], acc[ai][0][m][1], acc[ai][1][m][0], acc[ai][1][m][1]);
            }
    }
};
template <class Epi, class Sched, bool ALIGN_EPI = false, bool SP2 = false>
__device__ __forceinline__ void gemm_phase(PG8_LAS unsigned char* lds, const Gemm g, const Sched& S, const Epi& E) {
    const int tid = threadIdx.x, wid = __builtin_amdgcn_readfirstlane(tid >> 6), lane = tid & 63, wr = wid >> 2, wc = wid & 3, fr = lane & 15, fq = lane >> 4;
    const int K = g.K, nt = K / BK;
    unsigned voffA[2], voffB[2];
#pragma unroll
    for (int i = 0; i < 2; ++i) { int R, C; stage_rc(tid * 16 + i * 8192, R, C); const int Rb = Epi::PERM ? ((R & ~31) + perm32(R & 31)) : R;
        voffA[i] = (unsigned)(R * g.lda + C) * 2u; voffB[i] = (unsigned)(Rb * g.ldb + C) * 2u; }
    const size_t kstep = (size_t)(BK * 2);
    const size_t hstepA = (size_t)HALF * g.lda * 2, hstepB = (size_t)HALF * g.ldb * 2;
    const size_t tstepA = 2 * hstepA, tstepB = 2 * hstepB;
    const unsigned ldsw = (unsigned)wid * 1024u;
    const int aoff = lds_byte(wr * 64 + fr, fq * 8), boff = lds_byte(wc * 32 + fr, fq * 8);
#define PG8_SA(b, h) (((b) * 2 + (h)) * HTB)
#define PG8_SB(b, h) ((4 + (b) * 2 + (h)) * HTB)
#define PG8_STAGE(bufoff, gbase, voff) do { _Pragma("unroll") for (int _i = 0; _i < 2; ++_i) \
        __builtin_amdgcn_global_load_lds((const unsigned*)((const char*)(gbase) + (voff)[_i]), (PG8_LAS unsigned*)(lds + (bufoff) + ldsw + _i * 8192), 16, 0, 0); } while (0)
#define PG8_LDA(dst, b, h) do { _Pragma("unroll") for (int m = 0; m < 4; ++m) _Pragma("unroll") for (int k = 0; k < 2; ++k) dst[m][k] = *(const PG8_LAS bf16x8*)(lds + PG8_SA(b, h) + aoff + m * 2048 + k * 1024); } while (0)
#define PG8_LDB(dst, b, h) do { _Pragma("unroll") for (int n = 0; n < 2; ++n) _Pragma("unroll") for (int k = 0; k < 2; ++k) dst[n][k] = *(const PG8_LAS bf16x8*)(lds + PG8_SB(b, h) + boff + n * 2048 + k * 1024); } while (0)
#define PG8_MMA(ai, bj, At, Bt) do { __builtin_amdgcn_s_setprio(1); _Pragma("unroll") for (int m = 0; m < 4; ++m) _Pragma("unroll") for (int n = 0; n < 2; ++n) _Pragma("unroll") for (int k = 0; k < 2; ++k) \
        acc[ai][bj][m][n] = __builtin_amdgcn_mfma_f32_16x16x32_bf16(Bt[n][k], At[m][k], acc[ai][bj][m][n], 0, 0, 0); __builtin_amdgcn_s_setprio(0); } while (0)
#define PG8_WAIT_V(n) asm volatile("s_waitcnt vmcnt(" #n ")" ::: "memory")
#define PG8_WAIT_L(n) asm volatile("s_waitcnt lgkmcnt(" #n ")" ::: "memory")
#define PG8_BAR __builtin_amdgcn_s_barrier()
#define PG8_SCHED __builtin_amdgcn_sched_barrier(0)
    Unit cur, nxt; int ui = 0;
    if (!S.next(0, cur)) return;
    f32x4 acc[2][2][4][2];
#pragma unroll
    for (int a = 0; a < 2; ++a)
#pragma unroll
        for (int b = 0; b < 2; ++b)
#pragma unroll
            for (int m = 0; m < 4; ++m)
#pragma unroll
                for (int n = 0; n < 2; ++n) acc[a][b][m][n] = (f32x4){0.f, 0.f, 0.f, 0.f};
    bf16x8 At[4][2], B0[2][2], B1[2][2];
    const char* cA = (const char*)g.A + (size_t)cur.pm * tstepA; const char* cB = (const char*)g.Bt + (size_t)cur.pn * tstepB;
    S.a_ready(cur);
    if constexpr (SP2) {
        PG8_STAGE(PG8_SB(0, 0), cB, voffB); PG8_STAGE(PG8_SB(0, 1), cB + hstepB, voffB); PG8_STAGE(PG8_SA(0, 0), cA, voffA); PG8_STAGE(PG8_SA(0, 1), cA + hstepA, voffA);
        if (wr == 1) PG8_BAR;
        PG8_WAIT_V(2); PG8_BAR;
        PG8_STAGE(PG8_SB(1, 0), cB + kstep, voffB); PG8_STAGE(PG8_SA(1, 0), cA + kstep, voffA); PG8_STAGE(PG8_SB(1, 1), cB + hstepB + kstep, voffB);
        PG8_WAIT_V(6); PG8_BAR;
    } else {
        PG8_STAGE(PG8_SB(0, 0), cB, voffB); PG8_STAGE(PG8_SA(0, 0), cA, voffA); PG8_STAGE(PG8_SB(0, 1), cB + hstepB, voffB); PG8_STAGE(PG8_SA(0, 1), cA + hstepA, voffA);
        if (wr == 1) PG8_BAR;
        PG8_WAIT_V(4); PG8_BAR;
        PG8_STAGE(PG8_SB(1, 0), cB + kstep, voffB); PG8_STAGE(PG8_SA(1, 0), cA + kstep, voffA); PG8_STAGE(PG8_SB(1, 1), cB + hstepB + kstep, voffB);
        PG8_WAIT_V(6); PG8_BAR;
    }
    for (;;) {
        const bool has_next = S.next(ui + 1, nxt);
        const char* nA = has_next ? (const char*)g.A + (size_t)nxt.pm * tstepA : cA; const char* nB = has_next ? (const char*)g.Bt + (size_t)nxt.pn * tstepB : cB;
        for (int t = 0; t < nt; t += 2) {
            const bool last = (t == nt - 2);
            const char* a1 = cA + (size_t)(t + 1) * kstep;
            const char* a2 = last ? nA : cA + (size_t)(t + 2) * kstep; const char* b2 = last ? nB : cB + (size_t)(t + 2) * kstep;
            const char* a3 = a2 + kstep; const char* b3 = b2 + kstep;
            if (last && has_next) S.a_ready(nxt);
            if constexpr (SP2) {
            PG8_LDB(B0, 0, 0); PG8_LDB(B1, 0, 1); PG8_SCHED; PG8_LDA(At, 0, 0); PG8_STAGE(PG8_SA(1, 1), a1 + hstepA, voffA);
            PG8_WAIT_V(8); PG8_WAIT_L(0); PG8_BAR; PG8_MMA(0, 0, At, B0); PG8_MMA(0, 1, At, B1); PG8_BAR; PG8_SCHED;
            PG8_LDA(At, 0, 1); PG8_STAGE(PG8_SB(0, 0), b2, voffB); PG8_STAGE(PG8_SB(0, 1), b2 + hstepB, voffB); PG8_STAGE(PG8_SA(0, 0), a2, voffA);
            PG8_WAIT_V(8); PG8_WAIT_L(0); PG8_BAR; PG8_MMA(1, 0, At, B0); PG8_MMA(1, 1, At, B1); PG8_BAR; PG8_SCHED;
            PG8_LDB(B0, 1, 0); PG8_LDB(B1, 1, 1); PG8_SCHED; PG8_LDA(At, 1, 0); PG8_STAGE(PG8_SA(0, 1), a2 + hstepA, voffA);
            PG8_WAIT_V(8); PG8_WAIT_L(0); PG8_BAR; PG8_MMA(0, 0, At, B0); PG8_MMA(0, 1, At, B1); PG8_BAR; PG8_SCHED;
            PG8_LDA(At, 1, 1); PG8_STAGE(PG8_SB(1, 0), b3, voffB); PG8_STAGE(PG8_SB(1, 1), b3 + hstepB, voffB); PG8_STAGE(PG8_SA(1, 0), a3, voffA);
            PG8_WAIT_V(8); PG8_WAIT_L(0); PG8_BAR; PG8_MMA(1, 0, At, B0); PG8_MMA(1, 1, At, B1); PG8_BAR; PG8_SCHED;
            } else {
            PG8_LDB(B0, 0, 0); PG8_SCHED; PG8_LDA(At, 0, 0); PG8_STAGE(PG8_SA(1, 1), a1 + hstepA, voffA);
            PG8_WAIT_L(8); PG8_BAR; PG8_WAIT_L(0); PG8_MMA(0, 0, At, B0); PG8_BAR; PG8_SCHED;
            PG8_LDB(B1, 0, 1); PG8_STAGE(PG8_SB(0, 0), b2, voffB);
            PG8_BAR; PG8_WAIT_L(0); PG8_MMA(0, 1, At, B1); PG8_BAR;
            PG8_LDA(At, 0, 1); PG8_STAGE(PG8_SA(0, 0), a2, voffA);
            PG8_BAR; PG8_WAIT_L(0); PG8_MMA(1, 0, At, B0); PG8_BAR; PG8_SCHED;
            PG8_STAGE(PG8_SB(0, 1), b2 + hstepB, voffB);
            PG8_WAIT_V(6); PG8_BAR; PG8_MMA(1, 1, At, B1); PG8_BAR;
            PG8_LDB(B0, 1, 0); PG8_SCHED; PG8_LDA(At, 1, 0); PG8_STAGE(PG8_SA(0, 1), a2 + hstepA, voffA);
            PG8_WAIT_L(8); PG8_BAR; PG8_WAIT_L(0); PG8_MMA(0, 0, At, B0); PG8_BAR; PG8_SCHED;
            PG8_LDB(B1, 1, 1); PG8_STAGE(PG8_SB(1, 0), b3, voffB);
            PG8_BAR; PG8_WAIT_L(0); PG8_MMA(0, 1, At, B1); PG8_BAR;
            PG8_LDA(At, 1, 1); PG8_STAGE(PG8_SA(1, 0), a3, voffA);
            PG8_BAR; PG8_WAIT_L(0); PG8_MMA(1, 0, At, B0); PG8_BAR; PG8_SCHED;
            PG8_STAGE(PG8_SB(1, 1), b3 + hstepB, voffB);
            PG8_WAIT_V(6); PG8_BAR; PG8_MMA(1, 1, At, B1); PG8_BAR;
            }
        }
        if constexpr (ALIGN_EPI) { if (wr == 0) PG8_BAR; }
        if constexpr (!Epi::AFTER_DRAIN) { E(acc, cur, wr, wc, fr, fq); S.done(cur); }
        if (!has_next) break;
#pragma unroll
        for (int a = 0; a < 2; ++a)
#pragma unroll
            for (int b = 0; b < 2; ++b)
#pragma unroll
                for (int m = 0; m < 4; ++m)
#pragma unroll
                    for (int n = 0; n < 2; ++n) acc[a][b][m][n] = (f32x4){0.f, 0.f, 0.f, 0.f};
        cur = nxt; cA = nA; cB = nB; ++ui;
        if constexpr (ALIGN_EPI) { if (wr == 1) PG8_BAR; }
    }
    PG8_WAIT_V(0);
    if constexpr (!ALIGN_EPI) { if (wr == 0) PG8_BAR; }
    PG8_BAR;
    if constexpr (Epi::AFTER_DRAIN) { E.fused(acc, cur, wr, wc, fr, fq, lds, wid, lane); S.done(cur); }
#undef PG8_SA
#undef PG8_SB
#undef PG8_STAGE
#undef PG8_LDA
#undef PG8_LDB
#undef PG8_MMA
#undef PG8_WAIT_V
#undef PG8_WAIT_L
#undef PG8_BAR
#undef PG8_SCHED
}
}

#ifndef REP0
#define REP0 1
#endif
#ifndef REP3
#define REP3 1
#endif
#ifndef REP8
#define REP8 1
#endif
#ifndef REP4
#define REP4 1
#endif
#ifndef REP4S
#define REP4S 1
#endif
#ifndef REP2
#define REP2 1
#endif
#ifndef REP2S
#define REP2S 1
#endif
#define LAS __attribute__((address_space(3)))
typedef unsigned short bf16;
typedef float f32x4 __attribute__((ext_vector_type(4)));
typedef unsigned v4u __attribute__((ext_vector_type(4)));
typedef unsigned v2u __attribute__((ext_vector_type(2)));

constexpr int NB = 4, SEQ = 8192, D = 1024, TP = 8256, PADR = 48, MP = NB * TP;
constexpr int RW = 512, PROJW = 4352, DFF = 2816, UPW = 2 * DFF;
constexpr int C_K = 512, C_V = 1024, C_WD = 1536, C_AD = 1600, C_GD = 1664, C_U = 1792, C_GA = 2304, C_GB = 3328;
constexpr size_t QB = (size_t)MP * 512 * 2;
constexpr size_t WO_WIN = 1u << 20, WO_WBR = WO_WIN + (size_t)PROJW * D * 2, WO_WGLU = WO_WBR + (size_t)D * RW * 2, WO_WOUT = WO_WGLU + (size_t)2 * D * RW * 2,
                 WO_WUP = WO_WOUT + (size_t)D * D * 2, WO_WDN = WO_WUP + (size_t)UPW * D * 2, WO_END = WO_WDN + (size_t)D * DFF * 2;
static_assert(WO_END <= QB, "weights fit in the first quantum");
constexpr size_t WO_WUPT = WO_END, WO_AUPT = WO_WUPT + 65536, WO_GUPT = WO_AUPT + 65536, WO_END2 = WO_GUPT + 131072;
static_assert(WO_END2 <= QB, "small tables fit in the first quantum");
constexpr size_t WS_HN = QB, WS_GF = QB, WS_HF = 2 * QB, WS_PROJ = 3 * QB, WS_YR = 11 * QB + QB / 2, WS_QT = WS_YR + QB, WS_YB = WS_QT + QB, WS_BON = WS_YB + 2 * QB, WS_END = WS_BON + (size_t)MP * 8 * 4;
constexpr size_t WS_MIXIN = QB, WS_MIX = WS_YR, WS_HN2 = QB, WS_UP = 3 * QB, WS_F = QB;
constexpr int NCH = 129, NUNIT = NB * 8 * NCH, S5UNITS = NB * 32 * NCH;
constexpr size_t WO_BRT = WO_END2, WO_CRT = WO_BRT + 131072, WO_LAM = WO_CRT + 131072, WO_LAM64 = WO_LAM + 16384, WO_END3 = WO_LAM64 + 16384;
static_assert(WO_END3 <= QB, "S5 tables fit in the first quantum");
constexpr size_t WS_Z = WS_YB, WS_X0 = WS_Z + (size_t)NB * NCH * 4096 * 4, WS_S0 = WS_X0 + (size_t)NB * NCH * 4096 * 4;
static_assert(WS_S0 + QB <= WS_YB + 2 * QB, "S0 fits in the YB region");
static_assert(WS_END <= 536870912ull, "workspace");
constexpr int OP = 72, OPB = 64 * OP * 2, MISC_OFF = 17 * OPB;
constexpr int LDS_BYTES = 159744, XB_LDS_OFF = 159488;
typedef short bf16x8 __attribute__((ext_vector_type(8)));

__device__ __forceinline__ float bf2f(unsigned h) { return __uint_as_float(h << 16); }
__device__ __forceinline__ unsigned f2bf(float f) { unsigned u = __float_as_uint(f); return (u + 0x7fffu + ((u >> 16) & 1u)) >> 16; }
__device__ __forceinline__ unsigned pk2(float lo, float hi) { return f2bf(lo) | (f2bf(hi) << 16); }
__device__ __forceinline__ void unpack8(const v4u q, float (&o)[8]) {
    o[0] = __uint_as_float(q.x << 16); o[1] = __uint_as_float(q.x & 0xffff0000u); o[2] = __uint_as_float(q.y << 16); o[3] = __uint_as_float(q.y & 0xffff0000u);
    o[4] = __uint_as_float(q.z << 16); o[5] = __uint_as_float(q.z & 0xffff0000u); o[6] = __uint_as_float(q.w << 16); o[7] = __uint_as_float(q.w & 0xffff0000u);
}
__device__ __forceinline__ v4u pack8(const float (&o)[8]) { v4u w; w.x = pk2(o[0], o[1]); w.y = pk2(o[2], o[3]); w.z = pk2(o[4], o[5]); w.w = pk2(o[6], o[7]); return w; }
__device__ __forceinline__ float wave_sum(float v) {
#pragma unroll
    for (int o = 1; o < 64; o <<= 1) v += __shfl_xor(v, o);
    return v;
}
__device__ __forceinline__ float sigm(float x) { return 1.f / (1.f + __expf(-x)); }
__device__ __forceinline__ float gelu_t(float x) { const float z = 0.7978845608f * (x + 0.044715f * x * x * x); const float t = 1.f - 2.f / (__expf(2.f * z) + 1.f); return 0.5f * x * (1.f + t); }

#define SLOT(i) (ldsl + (i) * OPB)
__device__ __forceinline__ bf16x8 ldfrag(const LAS unsigned char* buf, int r0, int ks, int lane) { return *(const LAS bf16x8*)(buf + ((r0 + (lane & 15)) * OP + 32 * ks + 8 * (lane >> 4)) * 2); }
__device__ __forceinline__ f32x4 tmm(const LAS unsigned char* X, int x0, const LAS unsigned char* Y, int y0, f32x4 acc, int lane) {
#pragma unroll
    for (int ks = 0; ks < 2; ++ks) acc = __builtin_amdgcn_mfma_f32_16x16x32_bf16(ldfrag(X, x0, ks, lane), ldfrag(Y, y0, ks, lane), acc, 0, 0, 0);
    return acc; }
__device__ __forceinline__ void st4(LAS unsigned char* buf, int y, int x, f32x4 v) { *(LAS v2u*)(buf + (y * OP + x) * 2) = (v2u){pk2(v[0], v[1]), pk2(v[2], v[3])}; }
struct FStoreBf16 { bf16* O; int ldc;
    __device__ __forceinline__ void operator()(int row, int pn, int cw, f32x4 a00, f32x4 a01, f32x4 a10, f32x4 a11) const {
        bf16* p = O + (size_t)row * ldc + pn * 256 + cw;
        v4u w; w.x = pk2(a00[0], a00[1]); w.y = pk2(a00[2], a00[3]); w.z = pk2(a01[0], a01[1]); w.w = pk2(a01[2], a01[3]); *(v4u*)p = w;
        w.x = pk2(a10[0], a10[1]); w.y = pk2(a10[2], a10[3]); w.z = pk2(a11[0], a11[1]); w.w = pk2(a11[2], a11[3]); *(v4u*)(p + 128) = w; } };
struct FStoreF32 { float* O; int ldc;
    __device__ __forceinline__ void operator()(int row, int pn, int cw, f32x4 a00, f32x4 a01, f32x4 a10, f32x4 a11) const {
        float* p = O + (size_t)row * ldc + pn * 256 + cw;
        *(f32x4*)p = a00; *(f32x4*)(p + 4) = a01; *(f32x4*)(p + 128) = a10; *(f32x4*)(p + 132) = a11; } };
struct FGlu { bf16* YB;
    __device__ __forceinline__ void operator()(int row, int pn, int cw, f32x4 a00, f32x4 a01, f32x4 a10, f32x4 a11) const {
        float y[8];
#pragma unroll
        for (int e = 0; e < 4; ++e) { y[e] = a00[e] * sigm(a10[e]); y[4 + e] = a01[e] * sigm(a11[e]); }
        *(v4u*)(YB + (size_t)row * D + pn * 128 + cw) = pack8(y); } };
struct FMixin { const bf16* PROJ; const bf16* YB; bf16* MIXIN;
    __device__ __forceinline__ void one(int row, int col, f32x4 a0, f32x4 a1) const {
        float ga[8], gb[8], yb[8], o[8];
        unpack8(*(const v4u*)(PROJ + (size_t)row * PROJW + C_GA + col), ga); unpack8(*(const v4u*)(PROJ + (size_t)row * PROJW + C_GB + col), gb);
        unpack8(*(const v4u*)(YB + (size_t)row * D + col), yb);
#pragma unroll
        for (int e = 0; e < 4; ++e) { o[e] = sigm(ga[e]) * a0[e] + sigm(gb[e]) * yb[e]; o[4 + e] = sigm(ga[4 + e]) * a1[e] + sigm(gb[4 + e]) * yb[4 + e]; }
        *(v4u*)(MIXIN + (size_t)row * D + col) = pack8(o); }
    __device__ __forceinline__ void operator()(int row, int pn, int cw, f32x4 a00, f32x4 a01, f32x4 a10, f32x4 a11) const {
        one(row, pn * 256 + cw, a00, a01); one(row, pn * 256 + 128 + cw, a10, a11); } };

template <bool OUT> __device__ __forceinline__ void s5_unit(int id, bf16* PROJ, const bf16* BRT, const bf16* CRT, const float* LAM, const float* dvec, float* Z, const float* X0, LAS unsigned char* wl, int lane) {
    const int b = id / (32 * NCH), rem = id % (32 * NCH), g = rem / NCH, c0 = rem % NCH, row0 = b * TP + 64 * c0, lj = lane & 15, lq = lane >> 4, n = lane;
    LAS float* BU = (LAS float*)wl; LAS unsigned char* Xs = wl + 10240;
    const bf16x8 zf = {0, 0, 0, 0, 0, 0, 0, 0};
    bf16x8 bfrag[8];
#pragma unroll
    for (int nt = 0; nt < 8; ++nt) bfrag[nt] = lq < 2 ? *(const bf16x8*)(BRT + ((size_t)(g * 128 + 16 * nt + lj) * 16 + 8 * lq)) : zf;
    bf16x8 cfrag[4]; float dd[4];
    if (OUT) {
#pragma unroll
        for (int ks = 0; ks < 4; ++ks) cfrag[ks] = *(const bf16x8*)(CRT + ((size_t)(g * 16 + lj) * 128 + 32 * ks + 8 * lq));
#pragma unroll
        for (int r = 0; r < 4; ++r) dd[r] = dvec[g * 16 + 4 * lq + r];
    }
    const float lr = LAM[(g * 64 + n) * 2], li = LAM[(g * 64 + n) * 2 + 1];
    const size_t zi = ((size_t)(b * NCH + c0)) * 4096 + g * 128 + n;
    float xr = 0.f, xi = 0.f;
    if (OUT) { xr = X0[zi]; xi = X0[zi + 64]; }
#pragma unroll 1
    for (int rd2 = 0; rd2 < 4 * REP4S; ++rd2) { const int rd = rd2 / REP4S; const bool lastrep = (rd2 % REP4S) == REP4S - 1; const float sxr = xr, sxi = xi;
        bf16* up = PROJ + (size_t)(row0 + 16 * rd + lj) * PROJW + C_U + g * 16;
        const bf16x8 ufrag = lq < 2 ? *(const bf16x8*)(up + 8 * lq) : zf;
        v2u u4 = {0u, 0u}; if (OUT) u4 = *(const v2u*)(up + 4 * lq);
#pragma unroll
        for (int nt = 0; nt < 8; ++nt) { const f32x4 d = __builtin_amdgcn_mfma_f32_16x16x32_bf16(ufrag, bfrag[nt], (f32x4){0.f, 0.f, 0.f, 0.f}, 0, 0, 0);
            *(LAS f32x4*)(BU + (16 * nt + lj) * 20 + 4 * lq) = d; }
        asm volatile("s_waitcnt lgkmcnt(0)" ::: "memory");
#pragma unroll
        for (int t4 = 0; t4 < 4; ++t4) {
            const f32x4 br = *(const LAS f32x4*)(BU + n * 20 + 4 * t4), bi = *(const LAS f32x4*)(BU + (64 + n) * 20 + 4 * t4);
#pragma unroll
            for (int r = 0; r < 4; ++r) {
                const float nxr = lr * xr - li * xi + br[r], nxi = lr * xi + li * xr + bi[r]; xr = nxr; xi = nxi;
                if (OUT) { *(LAS bf16*)(Xs + ((4 * t4 + r) * 136 + n) * 2) = (bf16)f2bf(xr); *(LAS bf16*)(Xs + ((4 * t4 + r) * 136 + 64 + n) * 2) = (bf16)f2bf(xi); }
            }
        }
        if (OUT) {
            asm volatile("s_waitcnt lgkmcnt(0)" ::: "memory");
            f32x4 y = {0.f, 0.f, 0.f, 0.f};
#pragma unroll
            for (int ks = 0; ks < 4; ++ks) y = __builtin_amdgcn_mfma_f32_16x16x32_bf16(cfrag[ks], *(const LAS bf16x8*)(Xs + (lj * 136 + 32 * ks + 8 * lq) * 2), y, 0, 0, 0);
            const float u0 = __uint_as_float(u4.x << 16), u1 = __uint_as_float(u4.x & 0xffff0000u), u2 = __uint_as_float(u4.y << 16), u3 = __uint_as_float(u4.y & 0xffff0000u);
            if (lastrep) *(v2u*)(up + 4 * lq) = (v2u){pk2(gelu_t(y[0] + dd[0] * u0), gelu_t(y[1] + dd[1] * u1)), pk2(gelu_t(y[2] + dd[2] * u2), gelu_t(y[3] + dd[3] * u3))};
        }
        asm volatile("s_waitcnt lgkmcnt(0)" ::: "memory");
        if (!lastrep) { xr = sxr; xi = sxi; }
    }
    if (!OUT) { Z[zi] = xr; Z[zi + 64] = xi; }
}

struct Args { const float* in[33]; float* out; unsigned char* ws; };

__device__ __forceinline__ void transpose_item(const float* W, int K, int N, bf16* WT, int glu, float* scr, int item, int lane) {
    const int nblk = N / 32, kb = item / nblk, nb = item % nblk, k0 = 64 * kb, n0 = 32 * nb;
#pragma unroll 8
    for (int i = 0; i < 32; ++i) { const int kk = 2 * i + (lane >> 5); scr[kk * 33 + (lane & 31)] = W[(size_t)(k0 + kk) * N + n0 + (lane & 31)]; }
    asm volatile("s_waitcnt lgkmcnt(0)" ::: "memory");
    int d0 = n0; if (glu) { const int bj = n0 / 1024, rem = n0 % 1024; d0 = 256 * (rem / 128) + 128 * bj + (rem % 128); }
    const int c = lane & 7;
#pragma unroll
    for (int j = 0; j < 4; ++j) { const int n = (lane >> 3) + 8 * j; const float* s = scr + (8 * c) * 33 + n;
        v4u o; o.x = pk2(s[0 * 33], s[1 * 33]); o.y = pk2(s[2 * 33], s[3 * 33]); o.z = pk2(s[4 * 33], s[5 * 33]); o.w = pk2(s[6 * 33], s[7 * 33]);
        *(v4u*)(WT + (size_t)(d0 + n) * K + k0 + 8 * c) = o; }
    asm volatile("s_waitcnt lgkmcnt(0)" ::: "memory");
}

__device__ __forceinline__ float shiftv(const bf16* PROJ, int row, int j, int col, float mu) {
    const float cur = bf2f(PROJ[(size_t)row * PROJW + col]); const float prev = j > 0 ? bf2f(PROJ[(size_t)(row - 1) * PROJW + col]) : 0.f;
    return cur + (prev - cur) * mu;
}

#define XB_TMO      128
#define XB_XCNT(j)  (256  + 64 * (j))
#define XB_XSUB(j)  (1280 + 64 * (j))
#define XB_XGEN(j)  (2304 + 64 * (j))
#define XB_TOP      3328
#define XB_TOPGEN   3392
#define XCD_BAR_WORDS 3456
#define XB_SPIN_CAP (1u << 18)

__device__ __forceinline__ unsigned xb_ld(unsigned* p)              { return __hip_atomic_load(p, __ATOMIC_RELAXED, __HIP_MEMORY_SCOPE_AGENT); }
__device__ __forceinline__ unsigned xb_add(unsigned* p, unsigned v) { return __hip_atomic_fetch_add(p, v, __ATOMIC_RELAXED, __HIP_MEMORY_SCOPE_AGENT); }
__device__ __forceinline__ unsigned xb_xcc_id() { return (unsigned)__builtin_amdgcn_s_getreg((3 << 11) | 20) & 0xFu; }
#define XB_SPIN(cond, bar) do { unsigned _sp = 0; while (cond) { __builtin_amdgcn_s_sleep(1); \
    if ((++_sp & 255u) == 0u) { if (xb_ld(&(bar)[XB_TMO])) break; if (_sp > XB_SPIN_CAP) { atomicAdd(&(bar)[XB_TMO], 1u); break; } } } } while (0)

struct XcdBarrier {
    unsigned* bar; unsigned x;
    volatile LAS unsigned* st;
};

__device__ __forceinline__ XcdBarrier xcd_barrier_post(unsigned* bar, volatile LAS unsigned* st) {
    XcdBarrier b; b.bar = bar; b.x = xb_xcc_id(); b.st = st;
    if (threadIdx.x == 0) (void)xb_add(&bar[XB_XCNT(b.x)], 1u);
    return b;
}
__device__ __forceinline__ void xcd_barrier_complete(unsigned* bar, unsigned x, unsigned& nloc, unsigned& nx) {
    const unsigned G = gridDim.x * gridDim.y * gridDim.z;
    unsigned sum, cnt, mine, sp = 0u;
    for (;;) {
        sum = 0u; cnt = 0u; mine = 0u;
#pragma unroll
        for (unsigned j = 0; j < 16; ++j) { const unsigned c = xb_ld(&bar[XB_XCNT(j)]); sum += c; cnt += (c > 0u) ? 1u : 0u; mine = (j == x) ? c : mine; }
        if (sum == G) break;
        __builtin_amdgcn_s_sleep(1);
        if ((++sp & 255u) == 0u) { if (xb_ld(&bar[XB_TMO])) break; if (sp > XB_SPIN_CAP) { atomicAdd(&bar[XB_TMO], 1u); break; } }
    }
    nloc = mine > 0u ? mine : 1u; nx = cnt > 0u ? cnt : 1u;
}

__device__ __forceinline__ void xcd_barrier(const XcdBarrier& b) {
    asm volatile("s_waitcnt vmcnt(0)" ::: "memory");
    __syncthreads();
    if (threadIdx.x == 0) {
        unsigned* bar = b.bar;
        __builtin_amdgcn_s_waitcnt(0);
        unsigned nloc = b.st[0], nx = b.st[1];
        if (nloc == 0u) { xcd_barrier_complete(bar, b.x, nloc, nx); b.st[0] = nloc; b.st[1] = nx; }
        const unsigned old = xb_add(&bar[XB_XSUB(b.x)], 1u);
        const unsigned gen = old / nloc;
        if (old + 1u == (gen + 1u) * nloc) {
            __builtin_amdgcn_fence(__ATOMIC_RELEASE, "agent");
            asm volatile("s_waitcnt vmcnt(0)" ::: "memory");
            const unsigned og = xb_add(&bar[XB_TOP], 1u);
            const unsigned tg = og / nx;
            if (og + 1u == (tg + 1u) * nx) xb_add(&bar[XB_TOPGEN], 1u);
            else XB_SPIN(xb_ld(&bar[XB_TOPGEN]) == tg, bar);
            __builtin_amdgcn_fence(__ATOMIC_ACQUIRE, "agent");
            xb_add(&bar[XB_XGEN(b.x)], 1u);
            asm volatile("s_waitcnt vmcnt(0)" ::: "memory");
        } else {
            XB_SPIN(xb_ld(&bar[XB_XGEN(b.x)]) == gen, bar);
            __builtin_amdgcn_fence(__ATOMIC_ACQUIRE, "agent");
            asm volatile("s_waitcnt vmcnt(0)" ::: "memory");
        }
    }
    __syncthreads();
}

typedef const __attribute__((address_space(4))) Args* KArgsP;
__device__ __forceinline__ KArgsP kargs() { KArgsP p = (KArgsP)__builtin_amdgcn_kernarg_segment_ptr(); asm volatile("" : "+s"(p)); return p; }
#define PHASE_PTRS KArgsP ka = kargs(); unsigned char* ws = ka->ws; \
    const float* x = ka->in[0]; const float* meta = ka->in[1]; \
    bf16* WIN_T = (bf16*)(ws + WO_WIN); bf16* WBR_T = (bf16*)(ws + WO_WBR); bf16* WGLU_T = (bf16*)(ws + WO_WGLU); bf16* WOUT_T = (bf16*)(ws + WO_WOUT); \
    bf16* WUP_T = (bf16*)(ws + WO_WUP); bf16* WDN_T = (bf16*)(ws + WO_WDN); \
    bf16* HN = (bf16*)(ws + WS_HN); bf16* PROJ = (bf16*)(ws + WS_PROJ); \
    bf16* GF = (bf16*)(ws + WS_GF); bf16* HF = (bf16*)(ws + WS_HF); bf16* YR = (bf16*)(ws + WS_YR); bf16* QT = (bf16*)(ws + WS_QT); float* BON = (float*)(ws + WS_BON); \
    bf16* BRT = (bf16*)(ws + WO_BRT); bf16* CRT = (bf16*)(ws + WO_CRT); float* LAM = (float*)(ws + WO_LAM); float* LAM64 = (float*)(ws + WO_LAM64); float* ZB = (float*)(ws + WS_Z); float* X0B = (float*)(ws + WS_X0); bf16* S0B = (bf16*)(ws + WS_S0); \
    bf16* WUPT = (bf16*)(ws + WO_WUPT); bf16* AUPT = (bf16*)(ws + WO_AUPT); bf16* GUPT = (bf16*)(ws + WO_GUPT); \
    bf16* YB = (bf16*)(ws + WS_YB); bf16* MIXIN = (bf16*)(ws + WS_MIXIN); float* MIX = (float*)(ws + WS_MIX); bf16* HN2 = (bf16*)(ws + WS_HN2); bf16* UP = (bf16*)(ws + WS_UP); bf16* FB = (bf16*)(ws + WS_F);
__global__ void __launch_bounds__(512, 2) mega(Args a_unused) {
    extern __shared__ __attribute__((aligned(16))) unsigned char lds[];
    cg::grid_group grid = cg::this_grid();
    const int tid = threadIdx.x, lane = tid & 63, wave = __builtin_amdgcn_readfirstlane(tid >> 6);
    const int G = gridDim.x, gw = blockIdx.x * 8 + wave, NGW = G * 8;
    LAS unsigned char* ldsl = (LAS unsigned char*)lds;
    if (tid < 2) *(volatile LAS unsigned*)(ldsl + XB_LDS_OFF + 4 * tid) = 0u;
    if (blockIdx.x == 0) { unsigned* bw = (unsigned*)kargs()->ws; for (int i = tid; i < XCD_BAR_WORDS; i += 512) bw[i] = 0u; }

    { PHASE_PTRS
    {
        float* scr = (float*)(lds + wave * 16384);
        constexpr int I0 = 16 * 136, I1 = 8 * 32, I2 = 8 * 64, I3 = 16 * 32, I4 = 16 * 176, I5 = 44 * 32, I6 = 16, I7 = 16, I8 = 32;
        for (int rep_ = 0; rep_ < REP0; ++rep_)
        for (int it = gw; it < I0 + I1 + I2 + I3 + I4 + I5 + I6 + I7 + I8; it += NGW) {
            int r = it;
            if (r < I0) { transpose_item(ka->in[4], D, PROJW, WIN_T, 0, scr, r, lane); continue; } r -= I0;
            if (r < I1) { transpose_item(ka->in[16], RW, D, WBR_T, 0, scr, r, lane); continue; } r -= I1;
            if (r < I2) { transpose_item(ka->in[25], RW, 2 * D, WGLU_T, 1, scr, r, lane); continue; } r -= I2;
            if (r < I3) { transpose_item(ka->in[26], D, D, WOUT_T, 0, scr, r, lane); continue; } r -= I3;
            if (r < I4) { transpose_item(ka->in[29], D, UPW, WUP_T, 0, scr, r, lane); continue; } r -= I4;
            if (r < I5) { transpose_item(ka->in[32], DFF, D, WDN_T, 0, scr, r, lane); continue; } r -= I5;
            if (r < I6) { transpose_item(ka->in[7], 64, RW, WUPT, 0, scr, r, lane); continue; } r -= I6;
            if (r < I7) { transpose_item(ka->in[9], 64, RW, AUPT, 0, scr, r, lane); continue; } r -= I7;
            transpose_item(ka->in[10], 128, RW, GUPT, 0, scr, r, lane);
        }
        {
            const int gt = blockIdx.x * 512 + tid;
            if (gt < 2048) {
                const int g = gt >> 6, n = gt & 63;
                const float lre = fminf(ka->in[17][gt], -1e-4f), lim = ka->in[18][gt], dt = __expf(ka->in[19][g]);
                const float mag = __expf(lre * dt); float sn, cs; sincosf(lim * dt, &sn, &cs);
                const float lbr = mag * cs, lbi = mag * sn;
                LAM[gt * 2] = lbr; LAM[gt * 2 + 1] = lbi;
                const float m64 = __expf(64.f * lre * dt); float s64, c64; sincosf(64.f * lim * dt, &s64, &c64);
                LAM64[gt * 2] = m64 * c64; LAM64[gt * 2 + 1] = m64 * s64;
                const float den = lre * lre + lim * lim, nr = lbr - 1.f, ni = lbi;
                const float cr = (nr * lre + ni * lim) / den, ci = (ni * lre - nr * lim) / den;
                for (int i = 0; i < 16; ++i) { const float br = ka->in[20][gt * 16 + i], bi = ka->in[21][gt * 16 + i];
                    BRT[(size_t)(g * 128 + n) * 16 + i] = (bf16)f2bf(cr * br - ci * bi); BRT[(size_t)(g * 128 + 64 + n) * 16 + i] = (bf16)f2bf(cr * bi + ci * br); }
            }
            for (int idx = gt; idx < 32 * 16 * 128; idx += G * 512) { const int n2 = idx & 127, gh = idx >> 7;
                CRT[idx] = (bf16)f2bf(n2 < 64 ? ka->in[22][gh * 64 + n2] : -ka->in[23][gh * 64 + n2 - 64]); }
        }
        const float* g = ka->in[2];
        for (int rep_ = 0; rep_ < REP0; ++rep_)
        for (int row = gw; row < MP; row += NGW) {
            const int b = row / TP, j = row - b * TP;
            v2u* o = (v2u*)(HN + (size_t)row * D) + lane;
            if (j < PADR) {
#pragma unroll
                for (int jj = 0; jj < 4; ++jj) o[64 * jj] = (v2u){0u, 0u};
                continue; }
            const float* src = j < 64 ? meta + (size_t)(j - PADR) * D : x + ((size_t)b * SEQ + (j - 64)) * D;
            f32x4 v[4]; float ss = 0.f;
#pragma unroll
            for (int jj = 0; jj < 4; ++jj) { v[jj] = ((const f32x4*)src)[lane + 64 * jj]; ss += (v[jj].x * v[jj].x + v[jj].y * v[jj].y) + (v[jj].z * v[jj].z + v[jj].w * v[jj].w); }
            const float rstd = rsqrtf(wave_sum(ss) * (1.f / D) + 1e-6f);
#pragma unroll
            for (int jj = 0; jj < 4; ++jj) { const f32x4 g4 = ((const f32x4*)g)[lane + 64 * jj];
                o[64 * jj] = (v2u){pk2(v[jj].x * rstd * g4.x, v[jj].y * rstd * g4.y), pk2(v[jj].z * rstd * g4.z, v[jj].w * rstd * g4.w)}; }
        }
    }
    }
    grid.sync();
    const XcdBarrier xb = xcd_barrier_post((unsigned*)kargs()->ws, (volatile LAS unsigned*)(ldsl + XB_LDS_OFF));
    { PHASE_PTRS
    { pg8::Gemm g{HN, WIN_T, MP, PROJW, D, D, D}; pg8::StaticOrder S; S.init(MP, PROJW, G, (int)blockIdx.x);
      pg8::EpiF<FStoreBf16> E{{PROJ, PROJW}};
      pg8::gemm_phase<pg8::EpiF<FStoreBf16>, pg8::StaticOrder, true, true>(ldsl, g, S, E); }
    }
    xcd_barrier(xb);
    { PHASE_PTRS
    {
        const float* mu = ka->in[5]; const float* w0 = ka->in[6]; const float* a0 = ka->in[8]; const float* k_k = ka->in[11]; const float* k_a = ka->in[12]; const float* r_k = ka->in[13];
        float* tot = (float*)(lds + MISC_OFF); float* WCs = tot + 512;
        float* WLf = (float*)(lds + 13 * OPB); float* ALf = WLf + 64 * 68;
        const int ty = wave >> 1, txb = 2 * (wave & 1), lj = lane & 15, lq = lane >> 4, y0 = 16 * ty, yy = y0 + lj;
        for (int rep_ = 0; rep_ < REP2; ++rep_)
        for (int unit = blockIdx.x; unit < NUNIT; unit += G) {
            const int c0 = unit % NCH, bh = unit / NCH, b = bh >> 3, h = bh & 7, row0 = b * TP + 64 * c0, tq = wave, c = lane, hc = h * 64 + c;
            float rs[8], ks[8], vs[8];
            {
                float rv[9], kv[9], vv[9], wdv[9], adv[9];
#pragma unroll
                for (int i = 0; i < 9; ++i) {
                    const bool valid = (c0 > 0) || (8 * tq + i > 0);
                    const bf16* p = PROJ + (size_t)(row0 + 8 * tq + i - (valid ? 1 : 0)) * PROJW;
                    rv[i] = valid ? bf2f(p[hc]) : 0.f; kv[i] = valid ? bf2f(p[C_K + hc]) : 0.f; vv[i] = valid ? bf2f(p[C_V + hc]) : 0.f;
                    wdv[i] = valid ? bf2f(p[C_WD + c]) : 0.f; adv[i] = valid ? bf2f(p[C_AD + c]) : 0.f;
                }
                const float mur = mu[hc], muk = mu[C_K + hc], muv = mu[C_V + hc], muw = mu[C_WD + c], mua = mu[C_AD + c];
#pragma unroll
                for (int u = 0; u < 8; ++u) {
                    rs[u] = rv[u + 1] + (rv[u] - rv[u + 1]) * mur; ks[u] = kv[u + 1] + (kv[u] - kv[u + 1]) * muk; vs[u] = vv[u + 1] + (vv[u] - vv[u + 1]) * muv;
                    const float wd = wdv[u + 1] + (wdv[u] - wdv[u + 1]) * muw, ad = adv[u + 1] + (adv[u] - adv[u + 1]) * mua;
                    *(LAS bf16*)(SLOT(11) + ((8 * tq + u) * OP + c) * 2) = (bf16)f2bf(tanhf(wd));
                    *(LAS bf16*)(SLOT(12) + ((8 * tq + u) * OP + c) * 2) = (bf16)f2bf(ad);
                }
            }
            __syncthreads();
#pragma unroll
            for (int e = 0; e < 2; ++e) {
                const int x0 = 16 * (txb + e), xs = x0 + 4 * lq;
                f32x4 aw = {0.f, 0.f, 0.f, 0.f}, aa = {0.f, 0.f, 0.f, 0.f};
#pragma unroll
                for (int kq = 0; kq < 2; ++kq) {
                    const bf16x8 fw = *(const bf16x8*)(WUPT + (size_t)(h * 64 + x0 + lj) * 64 + 32 * kq + 8 * lq);
                    const bf16x8 fa = *(const bf16x8*)(AUPT + (size_t)(h * 64 + x0 + lj) * 64 + 32 * kq + 8 * lq);
                    aw = __builtin_amdgcn_mfma_f32_16x16x32_bf16(fw, ldfrag(SLOT(11), y0, kq, lane), aw, 0, 0, 0);
                    aa = __builtin_amdgcn_mfma_f32_16x16x32_bf16(fa, ldfrag(SLOT(12), y0, kq, lane), aa, 0, 0, 0);
                }
                *(f32x4*)(WLf + yy * 68 + xs) = aw; *(f32x4*)(ALf + yy * 68 + xs) = aa;
            }
            __syncthreads();
            {
                float lw[8], av[8], cum[8];
                const float w0c = w0[hc], a0c = a0[hc], kkc = k_k[hc], kac = k_a[hc], rkc = r_k[hc];
#pragma unroll
                for (int u = 0; u < 8; ++u) { const int t = 8 * tq + u; lw[u] = -0.60653066f * sigm(w0c + WLf[t * 68 + c]); av[u] = sigm(a0c + ALf[t * 68 + c]); }
                cum[0] = lw[0];
#pragma unroll
                for (int u = 1; u < 8; ++u) cum[u] = cum[u - 1] + lw[u];
                tot[tq * 64 + c] = cum[7];
                __syncthreads();
                float off = 0.f, all = 0.f;
#pragma unroll
                for (int w = 0; w < 8; ++w) { const float tv = tot[w * 64 + c]; all += tv; off += (w < tq) ? tv : 0.f; }
                float kkdT[8], bdT[8], kdT[8];
#pragma unroll
                for (int u = 0; u < 8; ++u) {
                    const int t = 8 * tq + u; const float ci = off + cum[u], cx = ci - lw[u];
                    const float kkv = ks[u] * kkc; const float n2 = wave_sum(kkv * kkv); const float kk = kkv / fmaxf(sqrtf(n2), 1e-12f);
                    const float k2 = ks[u] * (1.f + (av[u] - 1.f) * kac), bb = kk * av[u];
                    const float em = __expf(-ci), ed = __expf(all - ci);
                    kkdT[u] = kk * __expf(cx); bdT[u] = bb * ed; kdT[u] = k2 * ed;
                    *(LAS bf16*)(SLOT(0) + (t * OP + c) * 2) = (bf16)f2bf(kkdT[u]);
                    *(LAS bf16*)(SLOT(1) + (t * OP + c) * 2) = (bf16)f2bf(bb * em);
                    *(LAS bf16*)(SLOT(2) + (t * OP + c) * 2) = (bf16)f2bf(k2 * em);
                    *(LAS bf16*)(SLOT(3) + (t * OP + c) * 2) = (bf16)f2bf(rs[u] * __expf(ci));
                    const float rk = wave_sum(rs[u] * k2 * rkc);
                    if (lane == 0) BON[(size_t)(row0 + t) * 8 + h] = rk;
                }
                *(LAS v4u*)(SLOT(4) + (c * OP + 8 * tq) * 2) = pack8(kkdT);
                *(LAS v4u*)(SLOT(5) + (c * OP + 8 * tq) * 2) = pack8(bdT);
                *(LAS v4u*)(SLOT(6) + (c * OP + 8 * tq) * 2) = pack8(kdT);
                *(LAS v4u*)(SLOT(7) + (c * OP + 8 * tq) * 2) = pack8(vs);
                if (tq == 0) WCs[c] = __expf(all);
            }
            __syncthreads();
            f32x4 Pacc[2];
#pragma unroll
            for (int e = 0; e < 2; ++e) {
                const int x0 = 16 * (txb + e), xs = x0 + 4 * lq; const f32x4 z = {0.f, 0.f, 0.f, 0.f};
                f32x4 v = tmm(SLOT(1), x0, SLOT(0), y0, z, lane);
#pragma unroll
                for (int r = 0; r < 4; ++r) { v[r] = (xs + r < yy) ? v[r] : 0.f; Pacc[e][r] = ((xs + r == yy) ? 1.f : 0.f) - v[r]; }
                st4(SLOT(11), yy, xs, v); st4(SLOT(15), yy, xs, Pacc[e]);
                v = tmm(SLOT(0), x0, SLOT(1), y0, z, lane);
#pragma unroll
                for (int r = 0; r < 4; ++r) v[r] = (yy < xs + r) ? v[r] : 0.f;
                st4(SLOT(12), yy, xs, v);
                v = tmm(SLOT(2), x0, SLOT(0), y0, z, lane);
#pragma unroll
                for (int r = 0; r < 4; ++r) v[r] = (xs + r < yy) ? v[r] : 0.f;
                st4(SLOT(8), yy, xs, v);
                v = tmm(SLOT(1), x0, SLOT(3), y0, z, lane);
#pragma unroll
                for (int r = 0; r < 4; ++r) v[r] = (xs + r <= yy) ? v[r] : 0.f;
                st4(SLOT(9), yy, xs, v);
                v = tmm(SLOT(2), x0, SLOT(3), y0, z, lane);
#pragma unroll
                for (int r = 0; r < 4; ++r) v[r] = (xs + r <= yy) ? v[r] : 0.f;
                st4(SLOT(10), yy, xs, v);
            }
            __syncthreads();
#pragma unroll
            for (int e = 0; e < 2; ++e) {
                const int x0 = 16 * (txb + e), xs = x0 + 4 * lq; const f32x4 z = {0.f, 0.f, 0.f, 0.f};
                st4(SLOT(13), yy, xs, tmm(SLOT(12), x0, SLOT(11), y0, z, lane));
                st4(SLOT(14), yy, xs, tmm(SLOT(11), x0, SLOT(12), y0, z, lane));
                st4(SLOT(1), yy, xs, tmm(SLOT(8), x0, SLOT(7), y0, z, lane));
            }
            __syncthreads();
#define NEUMANN_STAGE(LT_cur, L_cur, P_cur, P_nxt, L_nxt, LT_nxt, DO_SQ, DO_SQ_L) \
            _Pragma("unroll") for (int e = 0; e < 2; ++e) { \
                const int x0 = 16 * (txb + e), xs = x0 + 4 * lq; const f32x4 z = {0.f, 0.f, 0.f, 0.f}; \
                Pacc[e] = tmm(SLOT(LT_cur), x0, SLOT(P_cur), y0, Pacc[e], lane); st4(SLOT(P_nxt), yy, xs, Pacc[e]); \
                if (DO_SQ_L) st4(SLOT(L_nxt), yy, xs, tmm(SLOT(LT_cur), x0, SLOT(L_cur), y0, z, lane)); \
                if (DO_SQ) st4(SLOT(LT_nxt), yy, xs, tmm(SLOT(L_cur), x0, SLOT(LT_cur), y0, z, lane)); \
            } __syncthreads();
            NEUMANN_STAGE(14, 13, 15, 16, 11, 12, true, true)
            NEUMANN_STAGE(12, 11, 16, 15, 13, 14, true, true)
            NEUMANN_STAGE(14, 13, 15, 16, 11, 12, true, true)
            NEUMANN_STAGE(12, 11, 16, 15, 13, 14, true, false)
            NEUMANN_STAGE(14, 13, 15, 16, 11, 12, false, false)
#pragma unroll
            for (int e = 0; e < 2; ++e) {
                const int x0 = 16 * (txb + e), xs = x0 + 4 * lq; const f32x4 z = {0.f, 0.f, 0.f, 0.f};
                st4(SLOT(0), yy, xs, tmm(SLOT(16), x0, SLOT(4), y0, z, lane));
                f32x4 v = tmm(SLOT(16), x0, SLOT(1), y0, z, lane);
                st4(SLOT(2), yy, xs, -v);
            }
            __syncthreads();
#pragma unroll
            for (int e = 0; e < 2; ++e) {
                const int tx = txb + e, x0 = 16 * tx, xs = x0 + 4 * lq; const f32x4 z = {0.f, 0.f, 0.f, 0.f};
                f32x4 v = tmm(SLOT(0), x0, SLOT(5), y0, z, lane);
                const float wc = WCs[yy];
#pragma unroll
                for (int r = 0; r < 4; ++r) v[r] = ((xs + r == yy) ? wc : 0.f) - v[r];
                *(v2u*)(GF + (size_t)unit * 4096 + ((ty * 2 + (tx >> 1)) * 64 + lane) * 8 + 4 * (tx & 1)) = (v2u){pk2(v[0], v[1]), pk2(v[2], v[3])};
                v = tmm(SLOT(5), x0, SLOT(2), y0, z, lane); v = tmm(SLOT(6), x0, SLOT(7), y0, v, lane);
                *(v2u*)(HF + (size_t)unit * 4096 + ((ty * 4 + tx) * 64 + lane) * 4) = (v2u){pk2(v[0], v[1]), pk2(v[2], v[3])};
                v = tmm(SLOT(0), x0, SLOT(9), y0, z, lane);
                { const v2u rd = *(const LAS v2u*)(SLOT(3) + (yy * OP + xs) * 2);
                  v[0] = __uint_as_float(rd.x << 16) - v[0]; v[1] = __uint_as_float(rd.x & 0xffff0000u) - v[1]; v[2] = __uint_as_float(rd.y << 16) - v[2]; v[3] = __uint_as_float(rd.y & 0xffff0000u) - v[3]; }
                *(v2u*)(QT + (size_t)unit * 4096 + yy * 64 + xs) = (v2u){pk2(v[0], v[1]), pk2(v[2], v[3])};
                v = tmm(SLOT(2), x0, SLOT(9), y0, z, lane); v = tmm(SLOT(7), x0, SLOT(10), y0, v, lane);
                *(v2u*)(YR + (size_t)(row0 + yy) * RW + h * 64 + xs) = (v2u){pk2(v[0], v[1]), pk2(v[2], v[3])};
            }
            __syncthreads();
        }
        for (int rep_ = 0; rep_ < REP2S; ++rep_)
        for (int wu = gw; wu < S5UNITS; wu += NGW) s5_unit<false>(wu, PROJ, BRT, CRT, LAM, ka->in[24], ZB, X0B, ldsl + wave * 14592, lane);
    }
    }
    xcd_barrier(xb);
    { PHASE_PTRS
    for (int rep_ = 0; rep_ < REP3; ++rep_)
    for (int unit = blockIdx.x; unit < 48; unit += G) {
        if (unit < 32) {
            const int bh = unit;
            const bf16* gsrc = GF + (size_t)bh * NCH * 4096; const bf16* hsrc = HF + (size_t)bh * NCH * 4096;
            constexpr int DEPTH = 7;
            if (wave >= 4) {
                const int lt = tid - 256;
#define CH_ISSUE(step) do { const int st_ = (step) < NCH ? (step) : NCH - 1; const unsigned so_ = (unsigned)((step) & 7) * 16384u + (unsigned)(wave - 4) * 1024u; \
                    __builtin_amdgcn_global_load_lds((const unsigned*)(gsrc + (size_t)st_ * 4096 + lt * 8), (LAS unsigned*)(ldsl + so_), 16, 0, 0); \
                    __builtin_amdgcn_global_load_lds((const unsigned*)(gsrc + (size_t)st_ * 4096 + 2048 + lt * 8), (LAS unsigned*)(ldsl + so_ + 4096), 16, 0, 0); \
                    __builtin_amdgcn_global_load_lds((const unsigned*)(hsrc + (size_t)st_ * 4096 + lt * 8), (LAS unsigned*)(ldsl + so_ + 8192), 16, 0, 0); \
                    __builtin_amdgcn_global_load_lds((const unsigned*)(hsrc + (size_t)st_ * 4096 + 2048 + lt * 8), (LAS unsigned*)(ldsl + so_ + 12288), 16, 0, 0); } while (0)
                for (int s = 0; s < DEPTH; ++s) CH_ISSUE(s);
                for (int cidx = 0; cidx < NCH; ++cidx) {
                    asm volatile("s_waitcnt vmcnt(24)" ::: "memory");
                    __builtin_amdgcn_s_barrier();
                    CH_ISSUE(cidx + DEPTH);
                }
                asm volatile("s_waitcnt vmcnt(0)" ::: "memory");
            } else {
                const int vq = wave;
                f32x4 acc[4];
#pragma unroll
                for (int i = 0; i < 4; ++i) acc[i] = (f32x4){0.f, 0.f, 0.f, 0.f};
                for (int cidx = 0; cidx < NCH; ++cidx) {
                    __builtin_amdgcn_s_barrier();
                    const LAS unsigned char* base = ldsl + (cidx & 7) * 16384;
                    bf16x8 bfr[2];
#pragma unroll
                    for (int s = 0; s < 2; ++s) { v4u w; w.x = pk2(acc[2 * s][0], acc[2 * s][1]); w.y = pk2(acc[2 * s][2], acc[2 * s][3]); w.z = pk2(acc[2 * s + 1][0], acc[2 * s + 1][1]); w.w = pk2(acc[2 * s + 1][2], acc[2 * s + 1][3]);
                        bfr[s] = __builtin_bit_cast(bf16x8, w); }
                    f32x4 nacc[4];
#pragma unroll
                    for (int tk = 0; tk < 4; ++tk) {
                        const v2u hv = *(const LAS v2u*)(base + 8192 + ((vq * 4 + tk) * 64 + lane) * 8);
                        nacc[tk] = (f32x4){__uint_as_float(hv.x << 16), __uint_as_float(hv.x & 0xffff0000u), __uint_as_float(hv.y << 16), __uint_as_float(hv.y & 0xffff0000u)};
#pragma unroll
                        for (int s = 0; s < 2; ++s) nacc[tk] = __builtin_amdgcn_mfma_f32_16x16x32_bf16(*(const LAS bf16x8*)(base + ((tk * 2 + s) * 64 + lane) * 16), bfr[s], nacc[tk], 0, 0, 0);
                    }
#pragma unroll
                    for (int tk = 0; tk < 4; ++tk) { acc[tk] = nacc[tk];
                        *(v2u*)(S0B + ((size_t)bh * NCH + cidx) * 4096 + ((vq * 4 + tk) * 64 + lane) * 4) = (v2u){pk2(acc[tk][0], acc[tk][1]), pk2(acc[tk][2], acc[tk][3])}; }
                }
            }
            __syncthreads();
        } else {
            const int ch = (unit - 32) * 512 + tid, b = ch >> 11, gn = ch & 2047;
            const float l64r = LAM64[gn * 2], l64i = LAM64[gn * 2 + 1];
            const size_t cb = (size_t)b * NCH * 4096 + (gn >> 6) * 128 + (gn & 63);
            float xr = 0.f, xi = 0.f;
            for (int c0 = 0; c0 < NCH; c0 += 8) {
                float zr[8], zi[8];
#pragma unroll
                for (int u = 0; u < 8; ++u) { const int cc = c0 + u < NCH ? c0 + u : NCH - 1; zr[u] = ZB[cb + (size_t)cc * 4096]; zi[u] = ZB[cb + (size_t)cc * 4096 + 64]; }
#pragma unroll
                for (int u = 0; u < 8; ++u) if (c0 + u < NCH) {
                    X0B[cb + (size_t)(c0 + u) * 4096] = xr; X0B[cb + (size_t)(c0 + u) * 4096 + 64] = xi;
                    const float nxr = l64r * xr - l64i * xi + zr[u], nxi = l64r * xi + l64i * xr + zi[u]; xr = nxr; xi = nxi; }
            }
        }
    }
    }
    xcd_barrier(xb);
    { PHASE_PTRS
    {
        const float* mu = ka->in[5]; const float* ln_g = ka->in[14]; const float* ln_b = ka->in[15];
        LAS unsigned char* SG = ldsl; float* Yf = (float*)(lds + 17408); float* Gf32 = Yf + 64 * 68;
        const int ty = wave >> 1, txb = 2 * (wave & 1), lj = lane & 15, lq = lane >> 4, y0 = 16 * ty, yy = y0 + lj;
        for (int unit = blockIdx.x; unit < NUNIT; unit += G) for (int rep_ = 0; rep_ < REP4; ++rep_) {
            const int c0 = unit % NCH, bh = unit / NCH, b = bh >> 3, h = bh & 7, row0 = b * TP + 64 * c0, tq = wave, c = lane, hc = h * 64 + c;
            float vs[8];
            {
                float vv[9], g0[9], g1[9];
#pragma unroll
                for (int i = 0; i < 9; ++i) {
                    const bool valid = (c0 > 0) || (8 * tq + i > 0);
                    const bf16* p = PROJ + (size_t)(row0 + 8 * tq + i - (valid ? 1 : 0)) * PROJW;
                    vv[i] = valid ? bf2f(p[C_V + hc]) : 0.f; g0[i] = valid ? bf2f(p[C_GD + c]) : 0.f; g1[i] = valid ? bf2f(p[C_GD + 64 + c]) : 0.f;
                }
                const float muv = mu[C_V + hc], mg0 = mu[C_GD + c], mg1 = mu[C_GD + 64 + c];
#pragma unroll
                for (int u = 0; u < 8; ++u) {
                    vs[u] = vv[u + 1] + (vv[u] - vv[u + 1]) * muv;
                    *(LAS bf16*)(SG + ((8 * tq + u) * 136 + c) * 2) = (bf16)f2bf(sigm(g0[u + 1] + (g0[u] - g0[u + 1]) * mg0));
                    *(LAS bf16*)(SG + ((8 * tq + u) * 136 + 64 + c) * 2) = (bf16)f2bf(sigm(g1[u + 1] + (g1[u] - g1[u + 1]) * mg1));
                }
            }
#pragma unroll
            for (int e = 0; e < 2; ++e) {
                const int tx = txb + e, xs = 16 * tx + 4 * lq;
                f32x4 v = {0.f, 0.f, 0.f, 0.f};
                if (c0 > 0) {
                    const bf16* sp = S0B + (size_t)(unit - 1) * 4096; const bf16* qp = QT + (size_t)unit * 4096;
#pragma unroll
                    for (int kq = 0; kq < 2; ++kq) {
                        const v2u s0 = *(const v2u*)(sp + ((tx * 4 + 2 * kq + (lq >> 1)) * 64 + 16 * (2 * (lq & 1)) + lj) * 4);
                        const v2u s1 = *(const v2u*)(sp + ((tx * 4 + 2 * kq + (lq >> 1)) * 64 + 16 * (2 * (lq & 1) + 1) + lj) * 4);
                        const v4u sw = {s0.x, s0.y, s1.x, s1.y};
                        const bf16x8 qf = *(const bf16x8*)(qp + yy * 64 + 32 * kq + 8 * lq);
                        v = __builtin_amdgcn_mfma_f32_16x16x32_bf16(__builtin_bit_cast(bf16x8, sw), qf, v, 0, 0, 0);
                    }
                }
                const v2u yl = *(const v2u*)(YR + (size_t)(row0 + yy) * RW + h * 64 + xs);
                v[0] += __uint_as_float(yl.x << 16); v[1] += __uint_as_float(yl.x & 0xffff0000u); v[2] += __uint_as_float(yl.y << 16); v[3] += __uint_as_float(yl.y & 0xffff0000u);
                *(f32x4*)(Yf + yy * 68 + xs) = v;
            }
            __syncthreads();
#pragma unroll
            for (int e = 0; e < 2; ++e) {
                const int x0 = 16 * (txb + e), xs = x0 + 4 * lq;
                f32x4 v = {0.f, 0.f, 0.f, 0.f};
#pragma unroll
                for (int kq = 0; kq < 4; ++kq) {
                    const bf16x8 fg = *(const bf16x8*)(GUPT + (size_t)(h * 64 + x0 + lj) * 128 + 32 * kq + 8 * lq);
                    const bf16x8 fs = *(const LAS bf16x8*)(SG + ((y0 + lj) * 136 + 32 * kq + 8 * lq) * 2);
                    v = __builtin_amdgcn_mfma_f32_16x16x32_bf16(fg, fs, v, 0, 0, 0);
                }
                *(f32x4*)(Gf32 + yy * 68 + xs) = v;
            }
            __syncthreads();
            {
                const float lg = ln_g[hc], lb = ln_b[hc];
#pragma unroll
                for (int u = 0; u < 8; ++u) {
                    const int t = 8 * tq + u;
                    const float y = Yf[t * 68 + c]; const float mean = wave_sum(y) * (1.f / 64.f); const float dv = y - mean; const float var = wave_sum(dv * dv) * (1.f / 64.f);
                    const float yn = dv * rsqrtf(var + 64e-5f) * lg + lb;
                    const float bonus = BON[(size_t)(row0 + t) * 8 + h] * vs[u];
                    if (rep_ == REP4 - 1) YR[(size_t)(row0 + t) * RW + hc] = (bf16)f2bf((yn + bonus) * Gf32[t * 68 + c]);
                }
            }
            __syncthreads();
        }
        for (int wu = gw; wu < S5UNITS; wu += NGW) s5_unit<true>(wu, PROJ, BRT, CRT, LAM, ka->in[24], ZB, X0B, ldsl + wave * 14592, lane);
    }
    }
    xcd_barrier(xb);
    { PHASE_PTRS
    { pg8::Gemm g{PROJ + C_U, WGLU_T, MP, 2 * D, RW, PROJW, RW}; pg8::StaticOrder S; S.init(MP, 2 * D, G, (int)blockIdx.x);
      pg8::EpiF<FGlu> E{{YB}};
      pg8::gemm_phase<pg8::EpiF<FGlu>, pg8::StaticOrder, true, true>(ldsl, g, S, E); }
    }
    xcd_barrier(xb);
    { PHASE_PTRS
    { pg8::Gemm g{YR, WBR_T, MP, D, RW, RW, RW}; pg8::StaticOrder S; S.init(MP, D, G, (int)blockIdx.x);
      pg8::EpiF<FMixin> E{{PROJ, YB, MIXIN}};
      pg8::gemm_phase<pg8::EpiF<FMixin>, pg8::StaticOrder, true, true>(ldsl, g, S, E); }
    }
    xcd_barrier(xb);
    { PHASE_PTRS
    { pg8::Gemm g{MIXIN, WOUT_T, MP, D, D, D, D}; pg8::StaticOrder S; S.init(MP, D, G, (int)blockIdx.x);
      pg8::EpiF<FStoreF32> E{{MIX, D}};
      pg8::gemm_phase<pg8::EpiF<FStoreF32>, pg8::StaticOrder, true, true>(ldsl, g, S, E); }
    }
    xcd_barrier(xb);
    { PHASE_PTRS
    {
        const float* gp = ka->in[3]; const float* gf = ka->in[27];
        for (int rep_ = 0; rep_ < REP8; ++rep_)
        for (int row = gw; row < MP; row += NGW) {
            const int b = row / TP, j = row - b * TP;
            v2u* o = (v2u*)(HN2 + (size_t)row * D) + lane;
            if (j < PADR) {
#pragma unroll
                for (int jj = 0; jj < 4; ++jj) o[64 * jj] = (v2u){0u, 0u};
                continue; }
            const float* src = j < 64 ? meta + (size_t)(j - PADR) * D : x + ((size_t)b * SEQ + (j - 64)) * D;
            const f32x4* mr = (const f32x4*)(MIX + (size_t)row * D);
            f32x4 m[4], hv[4]; float ss = 0.f;
#pragma unroll
            for (int jj = 0; jj < 4; ++jj) { m[jj] = mr[lane + 64 * jj]; hv[jj] = ((const f32x4*)src)[lane + 64 * jj]; ss += (m[jj].x * m[jj].x + m[jj].y * m[jj].y) + (m[jj].z * m[jj].z + m[jj].w * m[jj].w); }
            const float rstd = rsqrtf(wave_sum(ss) * (1.f / D) + 1e-6f); float s2 = 0.f;
#pragma unroll
            for (int jj = 0; jj < 4; ++jj) { const f32x4 g4 = ((const f32x4*)gp)[lane + 64 * jj]; hv[jj] = hv[jj] + m[jj] * rstd * g4;
                s2 += (hv[jj].x * hv[jj].x + hv[jj].y * hv[jj].y) + (hv[jj].z * hv[jj].z + hv[jj].w * hv[jj].w); }
            const float rstd2 = rsqrtf(wave_sum(s2) * (1.f / D) + 1e-6f);
            if (j >= 64) { f32x4* od = (f32x4*)(ka->out + ((size_t)b * SEQ + (j - 64)) * D);
#pragma unroll
                for (int jj = 0; jj < 4; ++jj) od[lane + 64 * jj] = hv[jj]; }
#pragma unroll
            for (int jj = 0; jj < 4; ++jj) { const f32x4 g4 = ((const f32x4*)gf)[lane + 64 * jj];
                o[64 * jj] = (v2u){pk2(hv[jj].x * rstd2 * g4.x, hv[jj].y * rstd2 * g4.y), pk2(hv[jj].z * rstd2 * g4.z, hv[jj].w * rstd2 * g4.w)}; }
        }
    }
    }
    xcd_barrier(xb);
    { PHASE_PTRS
    { pg8::Gemm g{HN2, WUP_T, MP, UPW, D, D, D}; pg8::StaticOrder S; S.init(MP, UPW, G, (int)blockIdx.x);
      pg8::EpiF<FStoreBf16> E{{UP, UPW}};
      pg8::gemm_phase<pg8::EpiF<FStoreBf16>, pg8::StaticOrder, true, true>(ldsl, g, S, E); }
    }
    xcd_barrier(xb);
    { PHASE_PTRS
    {
        const float* cw = ka->in[30]; const float* cb = ka->in[31];
        const size_t total = (size_t)MP * (DFF / 8);
        for (size_t idx = (size_t)blockIdx.x * 512 + tid; idx < total; idx += (size_t)G * 512) {
            const int row = (int)(idx / (DFF / 8)), c = (int)(idx % (DFF / 8)) * 8, j = row % TP;
            const bf16* p = UP + (size_t)row * UPW + c;
            float a0[8], a1[8], a2[8], gt[8], o[8];
            unpack8(*(const v4u*)p, a0); unpack8(*(const v4u*)(p + DFF), gt);
            if (j >= 1) unpack8(*(const v4u*)(p - UPW), a1); else {
#pragma unroll
                for (int e = 0; e < 8; ++e) a1[e] = 0.f; }
            if (j >= 2) unpack8(*(const v4u*)(p - 2 * UPW), a2); else {
#pragma unroll
                for (int e = 0; e < 8; ++e) a2[e] = 0.f; }
#pragma unroll
            for (int e = 0; e < 8; ++e) { const float cv = cw[c + e] * a2[e] + cw[DFF + c + e] * a1[e] + cw[2 * DFF + c + e] * a0[e] + cb[c + e]; o[e] = gelu_t(cv) * gt[e]; }
            *(v4u*)(UP + (size_t)row * UPW + DFF + c) = pack8(o);
        }
    }
    }
    xcd_barrier(xb);
    { PHASE_PTRS
    { pg8::Gemm g{UP + DFF, WDN_T, MP, D, DFF, UPW, DFF}; pg8::StaticOrder S; S.init(MP, D, G, (int)blockIdx.x);
      pg8::EpiF<FStoreBf16> E{{FB, D}};
      pg8::gemm_phase<pg8::EpiF<FStoreBf16>, pg8::StaticOrder, true, true>(ldsl, g, S, E); }
    }
    xcd_barrier(xb);
    { PHASE_PTRS
    {
        const float* gq = ka->in[28];
        for (int r = gw; r < NB * SEQ; r += NGW) {
            const int b = r / SEQ, t = r - b * SEQ; const int row = b * TP + 64 + t;
            const v2u* fr = (const v2u*)(FB + (size_t)row * D);
            f32x4 fv[4]; float ss = 0.f;
#pragma unroll
            for (int jj = 0; jj < 4; ++jj) { const v2u q = fr[lane + 64 * jj]; fv[jj] = (f32x4){__uint_as_float(q.x << 16), __uint_as_float(q.x & 0xffff0000u), __uint_as_float(q.y << 16), __uint_as_float(q.y & 0xffff0000u)};
                ss += (fv[jj].x * fv[jj].x + fv[jj].y * fv[jj].y) + (fv[jj].z * fv[jj].z + fv[jj].w * fv[jj].w); }
            const float rstd = rsqrtf(wave_sum(ss) * (1.f / D) + 1e-6f);
            f32x4* od = (f32x4*)(ka->out + (size_t)r * D);
#pragma unroll
            for (int jj = 0; jj < 4; ++jj) { const f32x4 g4 = ((const f32x4*)gq)[lane + 64 * jj]; od[lane + 64 * jj] = od[lane + 64 * jj] + fv[jj] * rstd * g4; }
        }
    }
    }
}

extern "C" void kernel_launch(void* const* d_in, const int* in_sizes, int n_in, void* d_out, int out_size, void* d_ws, size_t ws_size, hipStream_t stream) {
    static int grid = 0;
    if (grid == 0) {
        if (n_in != 33 || ws_size < WS_END) { fprintf(stderr, "kernel_launch: unexpected n_in %d / ws_size %zu\n", n_in, ws_size); grid = -1; return; }
        int dev = 0, cus = 0, per_cu = 0;
        (void)hipGetDevice(&dev); (void)hipDeviceGetAttribute(&cus, hipDeviceAttributeMultiprocessorCount, dev);
        (void)hipFuncSetAttribute((const void*)mega, hipFuncAttributeMaxDynamicSharedMemorySize, LDS_BYTES);
        (void)hipOccupancyMaxActiveBlocksPerMultiprocessor(&per_cu, (const void*)mega, 512, LDS_BYTES);
        if (per_cu < 1) { fprintf(stderr, "kernel_launch: occupancy query says %d blocks/CU\n", per_cu); per_cu = 1; }
        (void)hipGetLastError();
        grid = cus * per_cu;
    }
    if (grid < 0) return;
    Args a{};
    for (int i = 0; i < 33; ++i) a.in[i] = (const float*)d_in[i];
    a.out = (float*)d_out; a.ws = (unsigned char*)d_ws;
    void* args[] = {&a};
    hipError_t e = hipLaunchCooperativeKernel((const void*)mega, dim3(grid), dim3(512), args, LDS_BYTES, stream);
    if (e != hipSuccess) fprintf(stderr, "cooperative launch failed: %s (grid %d)\n", hipGetErrorString(e), grid);
}
```

```cpp
#include <hip/hip_runtime.h>
#include <hip/hip_cooperative_groups.h>
#include <cstdio>
#include <cstdint>
namespace cg = cooperative_groups;
#ifndef REPG
#define REPG 1
#endif
namespace pg8 {
#define PG8_LAS __attribute__((address_space(3)))
typedef unsigned short bf16_t;
typedef short bf16x8 __attribute__((ext_vector_type(8)));
typedef float f32x4 __attribute__((ext_vector_type(4)));
typedef unsigned u32x4 __attribute__((ext_vector_type(4)));
constexpr int BM = 256, BK = 64, HALF = 128, HTB = HALF * BK * 2  , STAGE_BYTES = 8 * HTB, NXCD = 8, WGM = 8;

__host__ __device__ __forceinline__ int lds_byte(int r, int c) { const int st = (r >> 4) * 2 + (c >> 5), rr = r & 15, cc = c & 31, ob = rr * 64 + cc * 2; return st * 1024 + (ob ^ (((ob >> 9) & 1) << 5)); }
__host__ __device__ __forceinline__ void stage_rc(int b, int& R, int& C) { const int st = b / 1024, sb = b % 1024, swz = sb ^ (((sb >> 9) & 1) << 5); R = (st >> 1) * 16 + swz / 64; C = (st & 1) * 32 + (swz % 64) / 2; }
__host__ __device__ __forceinline__ int perm32(int rho) { const int n = rho >> 4, i = rho & 15; return 8 * (i >> 2) + 4 * n + (i & 3); }

struct Unit { int pm, pn; };
struct Gemm { const bf16_t* A; const bf16_t* Bt; int M, N, K, lda, ldb; };

struct StaticOrder {
    int nM, nN, nwg, G, c;
    __host__ __device__ void init(int M, int N, int G_, int c_) { nM = M / BM; nN = N / BM; nwg = nM * nN; G = G_; c = c_; }
    __host__ __device__ bool next(int i, Unit& u) const {
        const long L = (long)i * G + c; if (L >= (long)nwg * REPG) return false;
        int wgid = (int)(L % nwg); { const int q = nwg / NXCD, r = nwg % NXCD, xcd = wgid % NXCD, off = wgid / NXCD; wgid = (xcd < r ? xcd * (q + 1) : r * (q + 1) + (xcd - r) * q) + off; }
        const int nig = WGM * nN, gid = wgid / nig, fm = gid * WGM, gsz = (nM - fm) < WGM ? (nM - fm) : WGM;
        u.pm = fm + ((wgid % nig) % gsz); u.pn = (wgid % nig) / gsz; return true;
    }
    __device__ __forceinline__ void a_ready(const Unit&) const {}
    __device__ __forceinline__ void done(const Unit&) const {}
};


template <class F> struct EpiF {
    static constexpr bool PERM = true, AFTER_DRAIN = false; F f;
    __device__ __forceinline__ void operator()(const f32x4 (&acc)[2][2][4][2], const Unit& u, int wr, int wc, int fr, int fq) const {
        const int cw = wc * 32 + 8 * fq;
#pragma unroll
        for (int ai = 0; ai < 2; ++ai)
#pragma unroll
            for (int m = 0; m < 4; ++m) {
                const int row = u.pm * BM + ai * HALF + wr * 64 + m * 16 + fr;
                f(row, u.pn, cw, acc[ai][0][m][0], acc[ai][0][m][1], acc[ai][1][m][0], acc[ai][1][m][1]);
            }
    }
};
template <class Epi, class Sched, bool ALIGN_EPI = false, bool SP2 = false>
__device__ __forceinline__ void gemm_phase(PG8_LAS unsigned char* lds, const Gemm g, const Sched& S, const Epi& E) {
    const int tid = threadIdx.x, wid = __builtin_amdgcn_readfirstlane(tid >> 6), lane = tid & 63, wr = wid >> 2, wc = wid & 3, fr = lane & 15, fq = lane >> 4;
    const int K = g.K, nt = K / BK;
    unsigned voffA[2], voffB[2];
#pragma unroll
    for (int i = 0; i < 2; ++i) { int R, C; stage_rc(tid * 16 + i * 8192, R, C); const int Rb = Epi::PERM ? ((R & ~31) + perm32(R & 31)) : R;
        voffA[i] = (unsigned)(R * g.lda + C) * 2u; voffB[i] = (unsigned)(Rb * g.ldb + C) * 2u; }
    const size_t kstep = (size_t)(BK * 2);
    const size_t hstepA = (size_t)HALF * g.lda * 2, hstepB = (size_t)HALF * g.ldb * 2;
    const size_t tstepA = 2 * hstepA, tstepB = 2 * hstepB;
    const unsigned ldsw = (unsigned)wid * 1024u;
    const int aoff = lds_byte(wr * 64 + fr, fq * 8), boff = lds_byte(wc * 32 + fr, fq * 8);
#define PG8_SA(b, h) (((b) * 2 + (h)) * HTB)
#define PG8_SB(b, h) ((4 + (b) * 2 + (h)) * HTB)
#define PG8_STAGE(bufoff, gbase, voff) do { _Pragma("unroll") for (int _i = 0; _i < 2; ++_i) \
        __builtin_amdgcn_global_load_lds((const unsigned*)((const char*)(gbase) + (voff)[_i]), (PG8_LAS unsigned*)(lds + (bufoff) + ldsw + _i * 8192), 16, 0, 0); } while (0)
#define PG8_LDA(dst, b, h) do { _Pragma("unroll") for (int m = 0; m < 4; ++m) _Pragma("unroll") for (int k = 0; k < 2; ++k) dst[m][k] = *(const PG8_LAS bf16x8*)(lds + PG8_SA(b, h) + aoff + m * 2048 + k * 1024); } while (0)
#define PG8_LDB(dst, b, h) do { _Pragma("unroll") for (int n = 0; n < 2; ++n) _Pragma("unroll") for (int k = 0; k < 2; ++k) dst[n][k] = *(const PG8_LAS bf16x8*)(lds + PG8_SB(b, h) + boff + n * 2048 + k * 1024); } while (0)
#define PG8_MMA(ai, bj, At, Bt) do { __builtin_amdgcn_s_setprio(1); _Pragma("unroll") for (int m = 0; m < 4; ++m) _Pragma("unroll") for (int n = 0; n < 2; ++n) _Pragma("unroll") for (int k = 0; k < 2; ++k) \
        acc[ai][bj][m][n] = __builtin_amdgcn_mfma_f32_16x16x32_bf16(Bt[n][k], At[m][k], acc[ai][bj][m][n], 0, 0, 0); __builtin_amdgcn_s_setprio(0); } while (0)
#define PG8_WAIT_V(n) asm volatile("s_waitcnt vmcnt(" #n ")" ::: "memory")
#define PG8_WAIT_L(n) asm volatile("s_waitcnt lgkmcnt(" #n ")" ::: "memory")
#define PG8_BAR __builtin_amdgcn_s_barrier()
#define PG8_SCHED __builtin_amdgcn_sched_barrier(0)
    Unit cur, nxt; int ui = 0;
    if (!S.next(0, cur)) return;
    f32x4 acc[2][2][4][2];
#pragma unroll
    for (int a = 0; a < 2; ++a)
#pragma unroll
        for (int b = 0; b < 2; ++b)
#pragma unroll
            for (int m = 0; m < 4; ++m)
#pragma unroll
                for (int n = 0; n < 2; ++n) acc[a][b][m][n] = (f32x4){0.f, 0.f, 0.f, 0.f};
    bf16x8 At[4][2], B0[2][2], B1[2][2];
    const char* cA = (const char*)g.A + (size_t)cur.pm * tstepA; const char* cB = (const char*)g.Bt + (size_t)cur.pn * tstepB;
    S.a_ready(cur);
    if constexpr (SP2) {
        PG8_STAGE(PG8_SB(0, 0), cB, voffB); PG8_STAGE(PG8_SB(0, 1), cB + hstepB, voffB); PG8_STAGE(PG8_SA(0, 0), cA, voffA); PG8_STAGE(PG8_SA(0, 1), cA + hstepA, voffA);
        if (wr == 1) PG8_BAR;
        PG8_WAIT_V(2); PG8_BAR;
        PG8_STAGE(PG8_SB(1, 0), cB + kstep, voffB); PG8_STAGE(PG8_SA(1, 0), cA + kstep, voffA); PG8_STAGE(PG8_SB(1, 1), cB + hstepB + kstep, voffB);
        PG8_WAIT_V(6); PG8_BAR;
    } else {
        PG8_STAGE(PG8_SB(0, 0), cB, voffB); PG8_STAGE(PG8_SA(0, 0), cA, voffA); PG8_STAGE(PG8_SB(0, 1), cB + hstepB, voffB); PG8_STAGE(PG8_SA(0, 1), cA + hstepA, voffA);
        if (wr == 1) PG8_BAR;
        PG8_WAIT_V(4); PG8_BAR;
        PG8_STAGE(PG8_SB(1, 0), cB + kstep, voffB); PG8_STAGE(PG8_SA(1, 0), cA + kstep, voffA); PG8_STAGE(PG8_SB(1, 1), cB + hstepB + kstep, voffB);
        PG8_WAIT_V(6); PG8_BAR;
    }
    for (;;) {
        const bool has_next = S.next(ui + 1, nxt);
        const char* nA = has_next ? (const char*)g.A + (size_t)nxt.pm * tstepA : cA; const char* nB = has_next ? (const char*)g.Bt + (size_t)nxt.pn * tstepB : cB;
        for (int t = 0; t < nt; t += 2) {
            const bool last = (t == nt - 2);
            const char* a1 = cA + (size_t)(t + 1) * kstep;
            const char* a2 = last ? nA : cA + (size_t)(t + 2) * kstep; const char* b2 = last ? nB : cB + (size_t)(t + 2) * kstep;
            const char* a3 = a2 + kstep; const char* b3 = b2 + kstep;
            if (last && has_next) S.a_ready(nxt);
            if constexpr (SP2) {
            PG8_LDB(B0, 0, 0); PG8_LDB(B1, 0, 1); PG8_SCHED; PG8_LDA(At, 0, 0); PG8_STAGE(PG8_SA(1, 1), a1 + hstepA, voffA);
            PG8_WAIT_V(8); PG8_WAIT_L(0); PG8_BAR; PG8_MMA(0, 0, At, B0); PG8_MMA(0, 1, At, B1); PG8_BAR; PG8_SCHED;
            PG8_LDA(At, 0, 1); PG8_STAGE(PG8_SB(0, 0), b2, voffB); PG8_STAGE(PG8_SB(0, 1), b2 + hstepB, voffB); PG8_STAGE(PG8_SA(0, 0), a2, voffA);
            PG8_WAIT_V(8); PG8_WAIT_L(0); PG8_BAR; PG8_MMA(1, 0, At, B0); PG8_MMA(1, 1, At, B1); PG8_BAR; PG8_SCHED;
            PG8_LDB(B0, 1, 0); PG8_LDB(B1, 1, 1); PG8_SCHED; PG8_LDA(At, 1, 0); PG8_STAGE(PG8_SA(0, 1), a2 + hstepA, voffA);
            PG8_WAIT_V(8); PG8_WAIT_L(0); PG8_BAR; PG8_MMA(0, 0, At, B0); PG8_MMA(0, 1, At, B1); PG8_BAR; PG8_SCHED;
            PG8_LDA(At, 1, 1); PG8_STAGE(PG8_SB(1, 0), b3, voffB); PG8_STAGE(PG8_SB(1, 1), b3 + hstepB, voffB); PG8_STAGE(PG8_SA(1, 0), a3, voffA);
            PG8_WAIT_V(8); PG8_WAIT_L(0); PG8_BAR; PG8_MMA(1, 0, At, B0); PG8_MMA(1, 1, At, B1); PG8_BAR; PG8_SCHED;
            } else {
            PG8_LDB(B0, 0, 0); PG8_SCHED; PG8_LDA(At, 0, 0); PG8_STAGE(PG8_SA(1, 1), a1 + hstepA, voffA);
            PG8_WAIT_L(8); PG8_BAR; PG8_WAIT_L(0); PG8_MMA(0, 0, At, B0); PG8_BAR; PG8_SCHED;
            PG8_LDB(B1, 0, 1); PG8_STAGE(PG8_SB(0, 0), b2, voffB);
            PG8_BAR; PG8_WAIT_L(0); PG8_MMA(0, 1, At, B1); PG8_BAR;
            PG8_LDA(At, 0, 1); PG8_STAGE(PG8_SA(0, 0), a2, voffA);
            PG8_BAR; PG8_WAIT_L(0); PG8_MMA(1, 0, At, B0); PG8_BAR; PG8_SCHED;
            PG8_STAGE(PG8_SB(0, 1), b2 + hstepB, voffB);
            PG8_WAIT_V(6); PG8_BAR; PG8_MMA(1, 1, At, B1); PG8_BAR;
            PG8_LDB(B0, 1, 0); PG8_SCHED; PG8_LDA(At, 1, 0); PG8_STAGE(PG8_SA(0, 1), a2 + hstepA, voffA);
            PG8_WAIT_L(8); PG8_BAR; PG8_WAIT_L(0); PG8_MMA(0, 0, At, B0); PG8_BAR; PG8_SCHED;
            PG8_LDB(B1, 1, 1); PG8_STAGE(PG8_SB(1, 0), b3, voffB);
            PG8_BAR; PG8_WAIT_L(0); PG8_MMA(0, 1, At, B1); PG8_BAR;
            PG8_LDA(At, 1, 1); PG8_STAGE(PG8_SA(1, 0), a3, voffA);
            PG8_BAR; PG8_WAIT_L(0); PG8_MMA(1, 0, At, B0); PG8_BAR; PG8_SCHED;
            PG8_STAGE(PG8_SB(1, 1), b3 + hstepB, voffB);
            PG8_WAIT_V(6); PG8_BAR; PG8_MMA(1, 1, At, B1); PG8_BAR;
            }
        }
        if constexpr (ALIGN_EPI) { if (wr == 0) PG8_BAR; }
        if constexpr (!Epi::AFTER_DRAIN) { E(acc, cur, wr, wc, fr, fq); S.done(cur); }
        if (!has_next) break;
#pragma unroll
        for (int a = 0; a < 2; ++a)
#pragma unroll
            for (int b = 0; b < 2; ++b)
#pragma unroll
                for (int m = 0; m < 4; ++m)
#pragma unroll
                    for (int n = 0; n < 2; ++n) acc[a][b][m][n] = (f32x4){0.f, 0.f, 0.f, 0.f};
        cur = nxt; cA = nA; cB = nB; ++ui;
        if constexpr (ALIGN_EPI) { if (wr == 1) PG8_BAR; }
    }
    PG8_WAIT_V(0);
    if constexpr (!ALIGN_EPI) { if (wr == 0) PG8_BAR; }
    PG8_BAR;
    if constexpr (Epi::AFTER_DRAIN) { E.fused(acc, cur, wr, wc, fr, fq, lds, wid, lane); S.done(cur); }
#undef PG8_SA
#undef PG8_SB
#undef PG8_STAGE
#undef PG8_LDA
#undef PG8_LDB
#undef PG8_MMA
#undef PG8_WAIT_V
#undef PG8_WAIT_L
#undef PG8_BAR
#undef PG8_SCHED
}
}

#ifndef REP0
#define REP0 1
#endif
#ifndef REP3
#define REP3 1
#endif
#ifndef REP8
#define REP8 1
#endif
#ifndef REP4
#define REP4 1
#endif
#ifndef REP4S
#define REP4S 1
#endif
#ifndef REP2
#define REP2 1
#endif
#ifndef REP2S
#define REP2S 1
#endif
#define LAS __attribute__((address_space(3)))
typedef unsigned short bf16;
typedef float f32x4 __attribute__((ext_vector_type(4)));
typedef unsigned v4u __attribute__((ext_vector_type(4)));
typedef unsigned v2u __attribute__((ext_vector_type(2)));

constexpr int NB = 4, SEQ = 8192, D = 1024, PADR = 48, NREAL = NB * SEQ, MP = NREAL + NB * 64;
__device__ __forceinline__ int chunk_row0(int b, int c0) { return c0 == 0 ? NREAL + 64 * b : b * SEQ + 64 * (c0 - 1); }
constexpr int RW = 512, PROJW = 4352, DFF = 2816, UPW = 2 * DFF;
constexpr int C_K = 512, C_V = 1024, C_WD = 1536, C_AD = 1600, C_GD = 1664, C_U = 1792, C_GA = 2304, C_GB = 3328;
constexpr size_t QB = (size_t)MP * 512 * 2;
constexpr size_t WO_WIN = 1u << 20, WO_WBR = WO_WIN + (size_t)PROJW * D * 2, WO_WGLU = WO_WBR + (size_t)D * RW * 2, WO_WOUT = WO_WGLU + (size_t)2 * D * RW * 2,
                 WO_WUP = WO_WOUT + (size_t)D * D * 2, WO_WDN = WO_WUP + (size_t)UPW * D * 2, WO_END = WO_WDN + (size_t)D * DFF * 2;
static_assert(WO_END <= QB, "weights fit in the first quantum");
constexpr size_t WO_WUPT = WO_END, WO_AUPT = WO_WUPT + 65536, WO_GUPT = WO_AUPT + 65536, WO_END2 = WO_GUPT + 131072;
static_assert(WO_END2 <= QB, "small tables fit in the first quantum");
constexpr size_t WS_HN = QB, WS_GF = QB, WS_HF = 2 * QB, WS_PROJ = 3 * QB, WS_YR = 11 * QB + QB / 2, WS_QT = WS_YR + QB, WS_YB = WS_QT + QB, WS_BON = WS_YB + 2 * QB, WS_END = WS_BON + (size_t)MP * 8 * 4;
constexpr size_t WS_MIXIN = QB, WS_MIX = WS_YR, WS_HN2 = QB, WS_UP = 3 * QB, WS_F = QB;
constexpr int NCH = 129, NUNIT = NB * 8 * NCH, S5UNITS = NB * 32 * NCH;
constexpr size_t WO_BRT = WO_END2, WO_CRT = WO_BRT + 131072, WO_LAM = WO_CRT + 131072, WO_LAM64 = WO_LAM + 16384, WO_END3 = WO_LAM64 + 16384;
static_assert(WO_END3 <= QB, "S5 tables fit in the first quantum");
constexpr size_t WS_Z = WS_YB, WS_X0 = WS_Z + (size_t)NB * NCH * 4096 * 4, WS_S0 = WS_X0 + (size_t)NB * NCH * 4096 * 4;
static_assert(WS_S0 + QB <= WS_YB + 2 * QB, "S0 fits in the YB region");
static_assert(WS_END <= 536870912ull, "workspace");
constexpr int OP = 72, OPB = 64 * OP * 2, MISC_OFF = 17 * OPB;
constexpr int LDS_BYTES = 159744, XB_LDS_OFF = 159488;
typedef short bf16x8 __attribute__((ext_vector_type(8)));

__device__ __forceinline__ float bf2f(unsigned h) { return __uint_as_float(h << 16); }
typedef float f32x2_t __attribute__((ext_vector_type(2))); typedef __bf16 bf16x2_t __attribute__((ext_vector_type(2)));
__device__ __forceinline__ unsigned pk2(float lo, float hi) { const f32x2_t v = {lo, hi}; const bf16x2_t b = __builtin_convertvector(v, bf16x2_t); return __builtin_bit_cast(unsigned, b); }
__device__ __forceinline__ unsigned f2bf(float f) { return pk2(f, 0.f) & 0xffffu; }
__device__ __forceinline__ void unpack8(const v4u q, float (&o)[8]) {
    o[0] = __uint_as_float(q.x << 16); o[1] = __uint_as_float(q.x & 0xffff0000u); o[2] = __uint_as_float(q.y << 16); o[3] = __uint_as_float(q.y & 0xffff0000u);
    o[4] = __uint_as_float(q.z << 16); o[5] = __uint_as_float(q.z & 0xffff0000u); o[6] = __uint_as_float(q.w << 16); o[7] = __uint_as_float(q.w & 0xffff0000u);
}
__device__ __forceinline__ v4u pack8(const float (&o)[8]) { v4u w; w.x = pk2(o[0], o[1]); w.y = pk2(o[2], o[3]); w.z = pk2(o[4], o[5]); w.w = pk2(o[6], o[7]); return w; }
template <int CTRL> __device__ __forceinline__ float dppf(float v) { return __int_as_float(__builtin_amdgcn_update_dpp(0, __float_as_int(v), CTRL, 0xf, 0xf, true)); }
__device__ __forceinline__ float wave_sum(float v) {
    v += dppf<0xB1>(v); v += dppf<0x4E>(v); v += dppf<0x141>(v); v += dppf<0x140>(v);
    const int iv = __float_as_int(v);
    return (__int_as_float(__builtin_amdgcn_readlane(iv, 0)) + __int_as_float(__builtin_amdgcn_readlane(iv, 16))) + (__int_as_float(__builtin_amdgcn_readlane(iv, 32)) + __int_as_float(__builtin_amdgcn_readlane(iv, 48)));
}
__device__ __forceinline__ float tanh_fast(float x) { return 1.f - 2.f / (__expf(2.f * x) + 1.f); }
__device__ __forceinline__ float sigm(float x) { return 1.f / (1.f + __expf(-x)); }
__device__ __forceinline__ float gelu_t(float x) { const float z = 0.7978845608f * (x + 0.044715f * x * x * x); const float t = 1.f - 2.f / (__expf(2.f * z) + 1.f); return 0.5f * x * (1.f + t); }

#define SLOT(i) (ldsl + (i) * OPB)
__device__ __forceinline__ bf16x8 ldfrag(const LAS unsigned char* buf, int r0, int ks, int lane) { return *(const LAS bf16x8*)(buf + ((r0 + (lane & 15)) * OP + 32 * ks + 8 * (lane >> 4)) * 2); }
__device__ __forceinline__ f32x4 tmm(const LAS unsigned char* X, int x0, const LAS unsigned char* Y, int y0, f32x4 acc, int lane) {
#pragma unroll
    for (int ks = 0; ks < 2; ++ks) acc = __builtin_amdgcn_mfma_f32_16x16x32_bf16(ldfrag(X, x0, ks, lane), ldfrag(Y, y0, ks, lane), acc, 0, 0, 0);
    return acc; }
__device__ __forceinline__ void st4(LAS unsigned char* buf, int y, int x, f32x4 v) { *(LAS v2u*)(buf + (y * OP + x) * 2) = (v2u){pk2(v[0], v[1]), pk2(v[2], v[3])}; }
struct FStoreBf16 { bf16* O; int ldc;
    __device__ __forceinline__ void operator()(int row, int pn, int cw, f32x4 a00, f32x4 a01, f32x4 a10, f32x4 a11) const {
        bf16* p = O + (size_t)row * ldc + pn * 256 + cw;
        v4u w; w.x = pk2(a00[0], a00[1]); w.y = pk2(a00[2], a00[3]); w.z = pk2(a01[0], a01[1]); w.w = pk2(a01[2], a01[3]); *(v4u*)p = w;
        w.x = pk2(a10[0], a10[1]); w.y = pk2(a10[2], a10[3]); w.z = pk2(a11[0], a11[1]); w.w = pk2(a11[2], a11[3]); *(v4u*)(p + 128) = w; } };
struct FStoreF32 { float* O; int ldc;
    __device__ __forceinline__ void operator()(int row, int pn, int cw, f32x4 a00, f32x4 a01, f32x4 a10, f32x4 a11) const {
        float* p = O + (size_t)row * ldc + pn * 256 + cw;
        *(f32x4*)p = a00; *(f32x4*)(p + 4) = a01; *(f32x4*)(p + 128) = a10; *(f32x4*)(p + 132) = a11; } };
struct FGlu { bf16* YB;
    __device__ __forceinline__ void operator()(int row, int pn, int cw, f32x4 a00, f32x4 a01, f32x4 a10, f32x4 a11) const {
        float y[8];
#pragma unroll
        for (int e = 0; e < 4; ++e) { y[e] = a00[e] * sigm(a10[e]); y[4 + e] = a01[e] * sigm(a11[e]); }
        *(v4u*)(YB + (size_t)row * D + pn * 128 + cw) = pack8(y); } };
struct FMixin { const bf16* PROJ; const bf16* YB; bf16* MIXIN;
    __device__ __forceinline__ void one(int row, int col, f32x4 a0, f32x4 a1) const {
        float ga[8], gb[8], yb[8], o[8];
        unpack8(*(const v4u*)(PROJ + (size_t)row * PROJW + C_GA + col), ga); unpack8(*(const v4u*)(PROJ + (size_t)row * PROJW + C_GB + col), gb);
        unpack8(*(const v4u*)(YB + (size_t)row * D + col), yb);
#pragma unroll
        for (int e = 0; e < 4; ++e) { o[e] = sigm(ga[e]) * a0[e] + sigm(gb[e]) * yb[e]; o[4 + e] = sigm(ga[4 + e]) * a1[e] + sigm(gb[4 + e]) * yb[4 + e]; }
        *(v4u*)(MIXIN + (size_t)row * D + col) = pack8(o); }
    __device__ __forceinline__ void operator()(int row, int pn, int cw, f32x4 a00, f32x4 a01, f32x4 a10, f32x4 a11) const {
        one(row, pn * 256 + cw, a00, a01); one(row, pn * 256 + 128 + cw, a10, a11); } };

template <bool OUT> __device__ __forceinline__ void s5_unit(int id, bf16* PROJ, const bf16* BRT, const bf16* CRT, const float* LAM, const float* dvec, float* Z, const float* X0, LAS unsigned char* wl, int lane) {
    const int b = id / (32 * NCH), rem = id % (32 * NCH), g = rem / NCH, c0 = rem % NCH, row0 = chunk_row0(b, c0), lj = lane & 15, lq = lane >> 4, n = lane;
    LAS float* BU = (LAS float*)wl; LAS unsigned char* Xs = wl + 10240;
    const bf16x8 zf = {0, 0, 0, 0, 0, 0, 0, 0};
    bf16x8 bfrag[8];
#pragma unroll
    for (int nt = 0; nt < 8; ++nt) bfrag[nt] = lq < 2 ? *(const bf16x8*)(BRT + ((size_t)(g * 128 + 16 * nt + lj) * 16 + 8 * lq)) : zf;
    bf16x8 cfrag[4]; float dd[4];
    if (OUT) {
#pragma unroll
        for (int ks = 0; ks < 4; ++ks) cfrag[ks] = *(const bf16x8*)(CRT + ((size_t)(g * 16 + lj) * 128 + 32 * ks + 8 * lq));
#pragma unroll
        for (int r = 0; r < 4; ++r) dd[r] = dvec[g * 16 + 4 * lq + r];
    }
    const float lr = LAM[(g * 64 + n) * 2], li = LAM[(g * 64 + n) * 2 + 1];
    const size_t zi = ((size_t)(b * NCH + c0)) * 4096 + g * 128 + n;
    float xr = 0.f, xi = 0.f;
    if (OUT) { xr = X0[zi]; xi = X0[zi + 64]; }
#pragma unroll 1
    for (int rd2 = 0; rd2 < 4 * REP4S; ++rd2) { const int rd = rd2 / REP4S; const bool lastrep = (rd2 % REP4S) == REP4S - 1; const float sxr = xr, sxi = xi;
        bf16* up = PROJ + (size_t)(row0 + 16 * rd + lj) * PROJW + C_U + g * 16;
        const bf16x8 ufrag = lq < 2 ? *(const bf16x8*)(up + 8 * lq) : zf;
        v2u u4 = {0u, 0u}; if (OUT) u4 = *(const v2u*)(up + 4 * lq);
#pragma unroll
        for (int nt = 0; nt < 8; ++nt) { const f32x4 d = __builtin_amdgcn_mfma_f32_16x16x32_bf16(ufrag, bfrag[nt], (f32x4){0.f, 0.f, 0.f, 0.f}, 0, 0, 0);
            *(LAS f32x4*)(BU + (16 * nt + lj) * 20 + 4 * lq) = d; }
        asm volatile("s_waitcnt lgkmcnt(0)" ::: "memory");
#pragma unroll
        for (int t4 = 0; t4 < 4; ++t4) {
            const f32x4 br = *(const LAS f32x4*)(BU + n * 20 + 4 * t4), bi = *(const LAS f32x4*)(BU + (64 + n) * 20 + 4 * t4);
#pragma unroll
            for (int r = 0; r < 4; ++r) {
                const float nxr = lr * xr - li * xi + br[r], nxi = lr * xi + li * xr + bi[r]; xr = nxr; xi = nxi;
                if (OUT) { *(LAS bf16*)(Xs + ((4 * t4 + r) * 136 + n) * 2) = (bf16)f2bf(xr); *(LAS bf16*)(Xs + ((4 * t4 + r) * 136 + 64 + n) * 2) = (bf16)f2bf(xi); }
            }
        }
        if (OUT) {
            asm volatile("s_waitcnt lgkmcnt(0)" ::: "memory");
            f32x4 y = {0.f, 0.f, 0.f, 0.f};
#pragma unroll
            for (int ks = 0; ks < 4; ++ks) y = __builtin_amdgcn_mfma_f32_16x16x32_bf16(cfrag[ks], *(const LAS bf16x8*)(Xs + (lj * 136 + 32 * ks + 8 * lq) * 2), y, 0, 0, 0);
            const float u0 = __uint_as_float(u4.x << 16), u1 = __uint_as_float(u4.x & 0xffff0000u), u2 = __uint_as_float(u4.y << 16), u3 = __uint_as_float(u4.y & 0xffff0000u);
            if (lastrep) *(v2u*)(up + 4 * lq) = (v2u){pk2(gelu_t(y[0] + dd[0] * u0), gelu_t(y[1] + dd[1] * u1)), pk2(gelu_t(y[2] + dd[2] * u2), gelu_t(y[3] + dd[3] * u3))};
        }
        asm volatile("s_waitcnt lgkmcnt(0)" ::: "memory");
        if (!lastrep) { xr = sxr; xi = sxi; }
    }
    if (!OUT) { Z[zi] = xr; Z[zi + 64] = xi; }
}

struct Args { const float* in[33]; float* out; unsigned char* ws; };

__device__ __forceinline__ void transpose_item(const float* W, int K, int N, bf16* WT, int glu, float* scr, int item, int lane) {
    const int nblk = N / 32, kb = item / nblk, nb = item % nblk, k0 = 64 * kb, n0 = 32 * nb;
#pragma unroll 8
    for (int i = 0; i < 32; ++i) { const int kk = 2 * i + (lane >> 5); scr[kk * 33 + (lane & 31)] = W[(size_t)(k0 + kk) * N + n0 + (lane & 31)]; }
    asm volatile("s_waitcnt lgkmcnt(0)" ::: "memory");
    int d0 = n0; if (glu) { const int bj = n0 / 1024, rem = n0 % 1024; d0 = 256 * (rem / 128) + 128 * bj + (rem % 128); }
    const int c = lane & 7;
#pragma unroll
    for (int j = 0; j < 4; ++j) { const int n = (lane >> 3) + 8 * j; const float* s = scr + (8 * c) * 33 + n;
        v4u o; o.x = pk2(s[0 * 33], s[1 * 33]); o.y = pk2(s[2 * 33], s[3 * 33]); o.z = pk2(s[4 * 33], s[5 * 33]); o.w = pk2(s[6 * 33], s[7 * 33]);
        *(v4u*)(WT + (size_t)(d0 + n) * K + k0 + 8 * c) = o; }
    asm volatile("s_waitcnt lgkmcnt(0)" ::: "memory");
}

__device__ __forceinline__ float shiftv(const bf16* PROJ, int row, int j, int col, float mu) {
    const float cur = bf2f(PROJ[(size_t)row * PROJW + col]); const float prev = j > 0 ? bf2f(PROJ[(size_t)(row - 1) * PROJW + col]) : 0.f;
    return cur + (prev - cur) * mu;
}

#define XB_TMO      128
#define XB_XCNT(j)  (256  + 64 * (j))
#define XB_XSUB(j)  (1280 + 64 * (j))
#define XB_XGEN(j)  (2304 + 64 * (j))
#define XB_TOP      3328
#define XB_TOPGEN   3392
#define XCD_BAR_WORDS 3456
#define XB_SPIN_CAP (1u << 18)

__device__ __forceinline__ unsigned xb_ld(unsigned* p)              { return __hip_atomic_load(p, __ATOMIC_RELAXED, __HIP_MEMORY_SCOPE_AGENT); }
__device__ __forceinline__ unsigned xb_add(unsigned* p, unsigned v) { return __hip_atomic_fetch_add(p, v, __ATOMIC_RELAXED, __HIP_MEMORY_SCOPE_AGENT); }
__device__ __forceinline__ unsigned xb_xcc_id() { return (unsigned)__builtin_amdgcn_s_getreg((3 << 11) | 20) & 0xFu; }
#define XB_SPIN(cond, bar) do { unsigned _sp = 0; while (cond) { __builtin_amdgcn_s_sleep(1); \
    if ((++_sp & 255u) == 0u) { if (xb_ld(&(bar)[XB_TMO])) break; if (_sp > XB_SPIN_CAP) { atomicAdd(&(bar)[XB_TMO], 1u); break; } } } } while (0)

struct XcdBarrier {
    unsigned* bar; unsigned x;
    volatile LAS unsigned* st;
};

__device__ __forceinline__ XcdBarrier xcd_barrier_post(unsigned* bar, volatile LAS unsigned* st) {
    XcdBarrier b; b.bar = bar; b.x = xb_xcc_id(); b.st = st;
    if (threadIdx.x == 0) (void)xb_add(&bar[XB_XCNT(b.x)], 1u);
    return b;
}
__device__ __forceinline__ void xcd_barrier_complete(unsigned* bar, unsigned x, unsigned& nloc, unsigned& nx) {
    const unsigned G = gridDim.x * gridDim.y * gridDim.z;
    unsigned sum, cnt, mine, sp = 0u;
    for (;;) {
        sum = 0u; cnt = 0u; mine = 0u;
#pragma unroll
        for (unsigned j = 0; j < 16; ++j) { const unsigned c = xb_ld(&bar[XB_XCNT(j)]); sum += c; cnt += (c > 0u) ? 1u : 0u; mine = (j == x) ? c : mine; }
        if (sum == G) break;
        __builtin_amdgcn_s_sleep(1);
        if ((++sp & 255u) == 0u) { if (xb_ld(&bar[XB_TMO])) break; if (sp > XB_SPIN_CAP) { atomicAdd(&bar[XB_TMO], 1u); break; } }
    }
    nloc = mine > 0u ? mine : 1u; nx = cnt > 0u ? cnt : 1u;
}

__device__ __forceinline__ void xcd_barrier(const XcdBarrier& b) {
    asm volatile("s_waitcnt vmcnt(0)" ::: "memory");
    __syncthreads();
    if (threadIdx.x == 0) {
        unsigned* bar = b.bar;
        __builtin_amdgcn_s_waitcnt(0);
        unsigned nloc = b.st[0], nx = b.st[1];
        if (nloc == 0u) { xcd_barrier_complete(bar, b.x, nloc, nx); b.st[0] = nloc; b.st[1] = nx; }
        const unsigned old = xb_add(&bar[XB_XSUB(b.x)], 1u);
        const unsigned gen = old / nloc;
        if (old + 1u == (gen + 1u) * nloc) {
            __builtin_amdgcn_fence(__ATOMIC_RELEASE, "agent");
            asm volatile("s_waitcnt vmcnt(0)" ::: "memory");
            const unsigned og = xb_add(&bar[XB_TOP], 1u);
            const unsigned tg = og / nx;
            if (og + 1u == (tg + 1u) * nx) xb_add(&bar[XB_TOPGEN], 1u);
            else XB_SPIN(xb_ld(&bar[XB_TOPGEN]) == tg, bar);
            __builtin_amdgcn_fence(__ATOMIC_ACQUIRE, "agent");
            xb_add(&bar[XB_XGEN(b.x)], 1u);
            asm volatile("s_waitcnt vmcnt(0)" ::: "memory");
        } else {
            XB_SPIN(xb_ld(&bar[XB_XGEN(b.x)]) == gen, bar);
            __builtin_amdgcn_fence(__ATOMIC_ACQUIRE, "agent");
            asm volatile("s_waitcnt vmcnt(0)" ::: "memory");
        }
    }
    __syncthreads();
}

typedef const __attribute__((address_space(4))) Args* KArgsP;
__device__ __forceinline__ KArgsP kargs() { KArgsP p = (KArgsP)__builtin_amdgcn_kernarg_segment_ptr(); asm volatile("" : "+s"(p)); return p; }
#define PHASE_PTRS KArgsP ka = kargs(); unsigned char* ws = ka->ws; \
    const float* x = ka->in[0]; const float* meta = ka->in[1]; \
    bf16* WIN_T = (bf16*)(ws + WO_WIN); bf16* WBR_T = (bf16*)(ws + WO_WBR); bf16* WGLU_T = (bf16*)(ws + WO_WGLU); bf16* WOUT_T = (bf16*)(ws + WO_WOUT); \
    bf16* WUP_T = (bf16*)(ws + WO_WUP); bf16* WDN_T = (bf16*)(ws + WO_WDN); \
    bf16* HN = (bf16*)(ws + WS_HN); bf16* PROJ = (bf16*)(ws + WS_PROJ); \
    bf16* GF = (bf16*)(ws + WS_GF); bf16* HF = (bf16*)(ws + WS_HF); bf16* YR = (bf16*)(ws + WS_YR); bf16* QT = (bf16*)(ws + WS_QT); float* BON = (float*)(ws + WS_BON); \
    bf16* BRT = (bf16*)(ws + WO_BRT); bf16* CRT = (bf16*)(ws + WO_CRT); float* LAM = (float*)(ws + WO_LAM); float* LAM64 = (float*)(ws + WO_LAM64); float* ZB = (float*)(ws + WS_Z); float* X0B = (float*)(ws + WS_X0); bf16* S0B = (bf16*)(ws + WS_S0); \
    bf16* WUPT = (bf16*)(ws + WO_WUPT); bf16* AUPT = (bf16*)(ws + WO_AUPT); bf16* GUPT = (bf16*)(ws + WO_GUPT); \
    bf16* YB = (bf16*)(ws + WS_YB); bf16* MIXIN = (bf16*)(ws + WS_MIXIN); bf16* MIX = (bf16*)(ws + WS_MIX); bf16* HN2 = (bf16*)(ws + WS_HN2); bf16* UP = (bf16*)(ws + WS_UP); bf16* FB = (bf16*)(ws + WS_F);
__global__ void __launch_bounds__(512, 2) mega(Args a_unused) {
    extern __shared__ __attribute__((aligned(16))) unsigned char lds[];
    cg::grid_group grid = cg::this_grid();
    const int tid = threadIdx.x, lane = tid & 63, wave = __builtin_amdgcn_readfirstlane(tid >> 6);
    const int G = gridDim.x, gw = blockIdx.x * 8 + wave, NGW = G * 8;
    LAS unsigned char* ldsl = (LAS unsigned char*)lds;
    if (tid < 2) *(volatile LAS unsigned*)(ldsl + XB_LDS_OFF + 4 * tid) = 0u;
    if (blockIdx.x == 0) { unsigned* bw = (unsigned*)kargs()->ws; for (int i = tid; i < XCD_BAR_WORDS; i += 512) bw[i] = 0u; }

    { PHASE_PTRS
    {
        float* scr = (float*)(lds + wave * 16384);
        constexpr int I0 = 16 * 136, I1 = 8 * 32, I2 = 8 * 64, I3 = 16 * 32, I4 = 16 * 176, I5 = 44 * 32, I6 = 16, I7 = 16, I8 = 32;
        for (int rep_ = 0; rep_ < REP0; ++rep_)
        for (int it = gw; it < I0 + I1 + I2 + I3 + I4 + I5 + I6 + I7 + I8; it += NGW) {
            int r = it;
            if (r < I0) { transpose_item(ka->in[4], D, PROJW, WIN_T, 0, scr, r, lane); continue; } r -= I0;
            if (r < I1) { transpose_item(ka->in[16], RW, D, WBR_T, 0, scr, r, lane); continue; } r -= I1;
            if (r < I2) { transpose_item(ka->in[25], RW, 2 * D, WGLU_T, 1, scr, r, lane); continue; } r -= I2;
            if (r < I3) { transpose_item(ka->in[26], D, D, WOUT_T, 0, scr, r, lane); continue; } r -= I3;
            if (r < I4) { transpose_item(ka->in[29], D, UPW, WUP_T, 0, scr, r, lane); continue; } r -= I4;
            if (r < I5) { transpose_item(ka->in[32], DFF, D, WDN_T, 0, scr, r, lane); continue; } r -= I5;
            if (r < I6) { transpose_item(ka->in[7], 64, RW, WUPT, 0, scr, r, lane); continue; } r -= I6;
            if (r < I7) { transpose_item(ka->in[9], 64, RW, AUPT, 0, scr, r, lane); continue; } r -= I7;
            transpose_item(ka->in[10], 128, RW, GUPT, 0, scr, r, lane);
        }
        {
            const int gt = blockIdx.x * 512 + tid;
            if (gt < 2048) {
                const int g = gt >> 6, n = gt & 63;
                const float lre = fminf(ka->in[17][gt], -1e-4f), lim = ka->in[18][gt], dt = __expf(ka->in[19][g]);
                const float mag = __expf(lre * dt); float sn, cs; sincosf(lim * dt, &sn, &cs);
                const float lbr = mag * cs, lbi = mag * sn;
                LAM[gt * 2] = lbr; LAM[gt * 2 + 1] = lbi;
                const float m64 = __expf(64.f * lre * dt); float s64, c64; sincosf(64.f * lim * dt, &s64, &c64);
                LAM64[gt * 2] = m64 * c64; LAM64[gt * 2 + 1] = m64 * s64;
                const float den = lre * lre + lim * lim, nr = lbr - 1.f, ni = lbi;
                const float cr = (nr * lre + ni * lim) / den, ci = (ni * lre - nr * lim) / den;
                for (int i = 0; i < 16; ++i) { const float br = ka->in[20][gt * 16 + i], bi = ka->in[21][gt * 16 + i];
                    BRT[(size_t)(g * 128 + n) * 16 + i] = (bf16)f2bf(cr * br - ci * bi); BRT[(size_t)(g * 128 + 64 + n) * 16 + i] = (bf16)f2bf(cr * bi + ci * br); }
            }
            for (int idx = gt; idx < 32 * 16 * 128; idx += G * 512) { const int n2 = idx & 127, gh = idx >> 7;
                CRT[idx] = (bf16)f2bf(n2 < 64 ? ka->in[22][gh * 64 + n2] : -ka->in[23][gh * 64 + n2 - 64]); }
        }
        const float* g = ka->in[2];
        for (int rep_ = 0; rep_ < REP0; ++rep_)
        for (int row = gw; row < MP; row += NGW) {
            const int j = row < NREAL ? 64 : ((row - NREAL) & 63);
            v2u* o = (v2u*)(HN + (size_t)row * D) + lane;
            if (j < PADR) {
#pragma unroll
                for (int jj = 0; jj < 4; ++jj) o[64 * jj] = (v2u){0u, 0u};
                continue; }
            const float* src = j < 64 ? meta + (size_t)(j - PADR) * D : x + (size_t)row * D;
            f32x4 v[4]; float ss = 0.f;
#pragma unroll
            for (int jj = 0; jj < 4; ++jj) { v[jj] = ((const f32x4*)src)[lane + 64 * jj]; ss += (v[jj].x * v[jj].x + v[jj].y * v[jj].y) + (v[jj].z * v[jj].z + v[jj].w * v[jj].w); }
            const float rstd = rsqrtf(wave_sum(ss) * (1.f / D) + 1e-6f);
#pragma unroll
            for (int jj = 0; jj < 4; ++jj) { const f32x4 g4 = ((const f32x4*)g)[lane + 64 * jj];
                o[64 * jj] = (v2u){pk2(v[jj].x * rstd * g4.x, v[jj].y * rstd * g4.y), pk2(v[jj].z * rstd * g4.z, v[jj].w * rstd * g4.w)}; }
        }
    }
    }
    grid.sync();
    const XcdBarrier xb = xcd_barrier_post((unsigned*)kargs()->ws, (volatile LAS unsigned*)(ldsl + XB_LDS_OFF));
    { PHASE_PTRS
    { pg8::Gemm g{HN, WIN_T, MP, PROJW, D, D, D}; pg8::StaticOrder S; S.init(MP, PROJW, G, (int)blockIdx.x);
      pg8::EpiF<FStoreBf16> E{{PROJ, PROJW}};
      pg8::gemm_phase<pg8::EpiF<FStoreBf16>, pg8::StaticOrder, true, true>(ldsl, g, S, E); }
    }
    xcd_barrier(xb);
    { PHASE_PTRS
    {
        const float* mu = ka->in[5]; const float* w0 = ka->in[6]; const float* a0 = ka->in[8]; const float* k_k = ka->in[11]; const float* k_a = ka->in[12]; const float* r_k = ka->in[13];
        float* tot = (float*)(lds + MISC_OFF); float* WCs = tot + 512;
        float* WLf = (float*)(lds + 13 * OPB); float* ALf = WLf + 64 * 68;
        const int ty = wave >> 1, txb = 2 * (wave & 1), lj = lane & 15, lq = lane >> 4, y0 = 16 * ty, yy = y0 + lj;
        for (int rep_ = 0; rep_ < REP2; ++rep_)
        for (int unit = blockIdx.x; unit < NUNIT; unit += G) {
            const int c0 = unit % NCH, bh = unit / NCH, b = bh >> 3, h = bh & 7, row0 = chunk_row0(b, c0), prow = (c0 == 1) ? NREAL + 64 * b + 63 : row0 - 1, tq = wave, c = lane, hc = h * 64 + c;
            float rs[8], ks[8], vs[8];
            {
                float rv[9], kv[9], vv[9], wdv[9], adv[9];
#pragma unroll
                for (int i = 0; i < 9; ++i) {
                    const bool valid = (c0 > 0) || (8 * tq + i > 0);
                    const int rr_ = 8 * tq + i - 1; const bf16* p = PROJ + (size_t)(rr_ >= 0 ? row0 + rr_ : (valid ? prow : row0)) * PROJW;
                    rv[i] = valid ? bf2f(p[hc]) : 0.f; kv[i] = valid ? bf2f(p[C_K + hc]) : 0.f; vv[i] = valid ? bf2f(p[C_V + hc]) : 0.f;
                    wdv[i] = valid ? bf2f(p[C_WD + c]) : 0.f; adv[i] = valid ? bf2f(p[C_AD + c]) : 0.f;
                }
                const float mur = mu[hc], muk = mu[C_K + hc], muv = mu[C_V + hc], muw = mu[C_WD + c], mua = mu[C_AD + c];
#pragma unroll
                for (int u = 0; u < 8; ++u) {
                    rs[u] = rv[u + 1] + (rv[u] - rv[u + 1]) * mur; ks[u] = kv[u + 1] + (kv[u] - kv[u + 1]) * muk; vs[u] = vv[u + 1] + (vv[u] - vv[u + 1]) * muv;
                    const float wd = wdv[u + 1] + (wdv[u] - wdv[u + 1]) * muw, ad = adv[u + 1] + (adv[u] - adv[u + 1]) * mua;
                    *(LAS bf16*)(SLOT(11) + ((8 * tq + u) * OP + c) * 2) = (bf16)f2bf(tanh_fast(wd));
                    *(LAS bf16*)(SLOT(12) + ((8 * tq + u) * OP + c) * 2) = (bf16)f2bf(ad);
                }
            }
            __syncthreads();
#pragma unroll
            for (int e = 0; e < 2; ++e) {
                const int x0 = 16 * (txb + e), xs = x0 + 4 * lq;
                f32x4 aw = {0.f, 0.f, 0.f, 0.f}, aa = {0.f, 0.f, 0.f, 0.f};
#pragma unroll
                for (int kq = 0; kq < 2; ++kq) {
                    const bf16x8 fw = *(const bf16x8*)(WUPT + (size_t)(h * 64 + x0 + lj) * 64 + 32 * kq + 8 * lq);
                    const bf16x8 fa = *(const bf16x8*)(AUPT + (size_t)(h * 64 + x0 + lj) * 64 + 32 * kq + 8 * lq);
                    aw = __builtin_amdgcn_mfma_f32_16x16x32_bf16(fw, ldfrag(SLOT(11), y0, kq, lane), aw, 0, 0, 0);
                    aa = __builtin_amdgcn_mfma_f32_16x16x32_bf16(fa, ldfrag(SLOT(12), y0, kq, lane), aa, 0, 0, 0);
                }
                *(f32x4*)(WLf + yy * 68 + xs) = aw; *(f32x4*)(ALf + yy * 68 + xs) = aa;
            }
            __syncthreads();
            {
                float lw[8], av[8], cum[8];
                const float w0c = w0[hc], a0c = a0[hc], kkc = k_k[hc], kac = k_a[hc], rkc = r_k[hc];
#pragma unroll
                for (int u = 0; u < 8; ++u) { const int t = 8 * tq + u; lw[u] = -0.60653066f * sigm(w0c + WLf[t * 68 + c]); av[u] = sigm(a0c + ALf[t * 68 + c]); }
                cum[0] = lw[0];
#pragma unroll
                for (int u = 1; u < 8; ++u) cum[u] = cum[u - 1] + lw[u];
                tot[tq * 64 + c] = cum[7];
                __syncthreads();
                float off = 0.f, all = 0.f;
#pragma unroll
                for (int w = 0; w < 8; ++w) { const float tv = tot[w * 64 + c]; all += tv; off += (w < tq) ? tv : 0.f; }
                float kkdT[8], bdT[8], kdT[8];
#pragma unroll
                for (int u = 0; u < 8; ++u) {
                    const int t = 8 * tq + u; const float ci = off + cum[u], cx = ci - lw[u];
                    const float kkv = ks[u] * kkc; const float n2 = wave_sum(kkv * kkv); const float kk = kkv / fmaxf(sqrtf(n2), 1e-12f);
                    const float k2 = ks[u] * (1.f + (av[u] - 1.f) * kac), bb = kk * av[u];
                    const float em = __expf(-ci), ed = __expf(all - ci);
                    kkdT[u] = kk * __expf(cx); bdT[u] = bb * ed; kdT[u] = k2 * ed;
                    *(LAS bf16*)(SLOT(0) + (t * OP + c) * 2) = (bf16)f2bf(kkdT[u]);
                    *(LAS bf16*)(SLOT(1) + (t * OP + c) * 2) = (bf16)f2bf(bb * em);
                    *(LAS bf16*)(SLOT(2) + (t * OP + c) * 2) = (bf16)f2bf(k2 * em);
                    *(LAS bf16*)(SLOT(3) + (t * OP + c) * 2) = (bf16)f2bf(rs[u] * __expf(ci));
                    const float rk = wave_sum(rs[u] * k2 * rkc);
                    if (lane == 0) BON[(size_t)(row0 + t) * 8 + h] = rk;
                }
                *(LAS v4u*)(SLOT(4) + (c * OP + 8 * tq) * 2) = pack8(kkdT);
                *(LAS v4u*)(SLOT(5) + (c * OP + 8 * tq) * 2) = pack8(bdT);
                *(LAS v4u*)(SLOT(6) + (c * OP + 8 * tq) * 2) = pack8(kdT);
                *(LAS v4u*)(SLOT(7) + (c * OP + 8 * tq) * 2) = pack8(vs);
                if (tq == 0) WCs[c] = __expf(all);
            }
            __syncthreads();
            f32x4 Pacc[2];
#pragma unroll
            for (int e = 0; e < 2; ++e) {
                const int x0 = 16 * (txb + e), xs = x0 + 4 * lq; const f32x4 z = {0.f, 0.f, 0.f, 0.f};
                f32x4 v = tmm(SLOT(1), x0, SLOT(0), y0, z, lane);
#pragma unroll
                for (int r = 0; r < 4; ++r) { v[r] = (xs + r < yy) ? v[r] : 0.f; Pacc[e][r] = ((xs + r == yy) ? 1.f : 0.f) - v[r]; }
                st4(SLOT(11), yy, xs, v); st4(SLOT(15), yy, xs, Pacc[e]);
                v = tmm(SLOT(0), x0, SLOT(1), y0, z, lane);
#pragma unroll
                for (int r = 0; r < 4; ++r) v[r] = (yy < xs + r) ? v[r] : 0.f;
                st4(SLOT(12), yy, xs, v);
                v = tmm(SLOT(2), x0, SLOT(0), y0, z, lane);
#pragma unroll
                for (int r = 0; r < 4; ++r) v[r] = (xs + r < yy) ? v[r] : 0.f;
                st4(SLOT(8), yy, xs, v);
                v = tmm(SLOT(1), x0, SLOT(3), y0, z, lane);
#pragma unroll
                for (int r = 0; r < 4; ++r) v[r] = (xs + r <= yy) ? v[r] : 0.f;
                st4(SLOT(9), yy, xs, v);
                v = tmm(SLOT(2), x0, SLOT(3), y0, z, lane);
#pragma unroll
                for (int r = 0; r < 4; ++r) v[r] = (xs + r <= yy) ? v[r] : 0.f;
                st4(SLOT(10), yy, xs, v);
            }
            __syncthreads();
#pragma unroll
            for (int e = 0; e < 2; ++e) {
                const int x0 = 16 * (txb + e), xs = x0 + 4 * lq; const f32x4 z = {0.f, 0.f, 0.f, 0.f};
                st4(SLOT(13), yy, xs, tmm(SLOT(12), x0, SLOT(11), y0, z, lane));
                st4(SLOT(14), yy, xs, tmm(SLOT(11), x0, SLOT(12), y0, z, lane));
                st4(SLOT(1), yy, xs, tmm(SLOT(8), x0, SLOT(7), y0, z, lane));
            }
            __syncthreads();
#define NEUMANN_STAGE(LT_cur, L_cur, P_cur, P_nxt, L_nxt, LT_nxt, DO_SQ, DO_SQ_L) \
            _Pragma("unroll") for (int e = 0; e < 2; ++e) { \
                const int x0 = 16 * (txb + e), xs = x0 + 4 * lq; const f32x4 z = {0.f, 0.f, 0.f, 0.f}; \
                Pacc[e] = tmm(SLOT(LT_cur), x0, SLOT(P_cur), y0, Pacc[e], lane); st4(SLOT(P_nxt), yy, xs, Pacc[e]); \
                if (DO_SQ_L) st4(SLOT(L_nxt), yy, xs, tmm(SLOT(LT_cur), x0, SLOT(L_cur), y0, z, lane)); \
                if (DO_SQ) st4(SLOT(LT_nxt), yy, xs, tmm(SLOT(L_cur), x0, SLOT(LT_cur), y0, z, lane)); \
            } __syncthreads();
            NEUMANN_STAGE(14, 13, 15, 16, 11, 12, true, true)
            NEUMANN_STAGE(12, 11, 16, 15, 13, 14, true, true)
            NEUMANN_STAGE(14, 13, 15, 16, 11, 12, true, true)
            NEUMANN_STAGE(12, 11, 16, 15, 13, 14, true, false)
            NEUMANN_STAGE(14, 13, 15, 16, 11, 12, false, false)
#pragma unroll
            for (int e = 0; e < 2; ++e) {
                const int x0 = 16 * (txb + e), xs = x0 + 4 * lq; const f32x4 z = {0.f, 0.f, 0.f, 0.f};
                st4(SLOT(0), yy, xs, tmm(SLOT(16), x0, SLOT(4), y0, z, lane));
                f32x4 v = tmm(SLOT(16), x0, SLOT(1), y0, z, lane);
                st4(SLOT(2), yy, xs, -v);
            }
            __syncthreads();
#pragma unroll
            for (int e = 0; e < 2; ++e) {
                const int tx = txb + e, x0 = 16 * tx, xs = x0 + 4 * lq; const f32x4 z = {0.f, 0.f, 0.f, 0.f};
                f32x4 v = tmm(SLOT(0), x0, SLOT(5), y0, z, lane);
                const float wc = WCs[yy];
#pragma unroll
                for (int r = 0; r < 4; ++r) v[r] = ((xs + r == yy) ? wc : 0.f) - v[r];
                *(v2u*)(GF + (size_t)unit * 4096 + ((ty * 2 + (tx >> 1)) * 64 + lane) * 8 + 4 * (tx & 1)) = (v2u){pk2(v[0], v[1]), pk2(v[2], v[3])};
                v = tmm(SLOT(5), x0, SLOT(2), y0, z, lane); v = tmm(SLOT(6), x0, SLOT(7), y0, v, lane);
                *(v2u*)(HF + (size_t)unit * 4096 + ((ty * 4 + tx) * 64 + lane) * 4) = (v2u){pk2(v[0], v[1]), pk2(v[2], v[3])};
                v = tmm(SLOT(0), x0, SLOT(9), y0, z, lane);
                { const v2u rd = *(const LAS v2u*)(SLOT(3) + (yy * OP + xs) * 2);
                  v[0] = __uint_as_float(rd.x << 16) - v[0]; v[1] = __uint_as_float(rd.x & 0xffff0000u) - v[1]; v[2] = __uint_as_float(rd.y << 16) - v[2]; v[3] = __uint_as_float(rd.y & 0xffff0000u) - v[3]; }
                *(v2u*)(QT + (size_t)unit * 4096 + yy * 64 + xs) = (v2u){pk2(v[0], v[1]), pk2(v[2], v[3])};
                v = tmm(SLOT(2), x0, SLOT(9), y0, z, lane); v = tmm(SLOT(7), x0, SLOT(10), y0, v, lane);
                *(v2u*)(YR + (size_t)(row0 + yy) * RW + h * 64 + xs) = (v2u){pk2(v[0], v[1]), pk2(v[2], v[3])};
            }
            __syncthreads();
        }
        for (int rep_ = 0; rep_ < REP2S; ++rep_)
        for (int wu = gw; wu < S5UNITS; wu += NGW) s5_unit<false>(wu, PROJ, BRT, CRT, LAM, ka->in[24], ZB, X0B, ldsl + wave * 14592, lane);
    }
    }
    xcd_barrier(xb);
    { PHASE_PTRS
    for (int rep_ = 0; rep_ < REP3; ++rep_)
    for (int unit = blockIdx.x; unit < 48; unit += G) {
        if (unit < 32) {
            const int bh = unit;
            const bf16* gsrc = GF + (size_t)bh * NCH * 4096; const bf16* hsrc = HF + (size_t)bh * NCH * 4096;
            constexpr int DEPTH = 7;
            if (wave >= 4) {
                const int lt = tid - 256;
#define CH_ISSUE(step) do { const int st_ = (step) < NCH ? (step) : NCH - 1; const unsigned so_ = (unsigned)((step) & 7) * 16384u + (unsigned)(wave - 4) * 1024u; \
                    __builtin_amdgcn_global_load_lds((const unsigned*)(gsrc + (size_t)st_ * 4096 + lt * 8), (LAS unsigned*)(ldsl + so_), 16, 0, 0); \
                    __builtin_amdgcn_global_load_lds((const unsigned*)(gsrc + (size_t)st_ * 4096 + 2048 + lt * 8), (LAS unsigned*)(ldsl + so_ + 4096), 16, 0, 0); \
                    __builtin_amdgcn_global_load_lds((const unsigned*)(hsrc + (size_t)st_ * 4096 + lt * 8), (LAS unsigned*)(ldsl + so_ + 8192), 16, 0, 0); \
                    __builtin_amdgcn_global_load_lds((const unsigned*)(hsrc + (size_t)st_ * 4096 + 2048 + lt * 8), (LAS unsigned*)(ldsl + so_ + 12288), 16, 0, 0); } while (0)
                for (int s = 0; s < DEPTH; ++s) CH_ISSUE(s);
                for (int cidx = 0; cidx < NCH; ++cidx) {
                    asm volatile("s_waitcnt vmcnt(24)" ::: "memory");
                    __builtin_amdgcn_s_barrier();
                    CH_ISSUE(cidx + DEPTH);
                }
                asm volatile("s_waitcnt vmcnt(0)" ::: "memory");
            } else {
                const int vq = wave;
                f32x4 acc[4];
#pragma unroll
                for (int i = 0; i < 4; ++i) acc[i] = (f32x4){0.f, 0.f, 0.f, 0.f};
                for (int cidx = 0; cidx < NCH; ++cidx) {
                    __builtin_amdgcn_s_barrier();
                    const LAS unsigned char* base = ldsl + (cidx & 7) * 16384;
                    bf16x8 bfr[2];
#pragma unroll
                    for (int s = 0; s < 2; ++s) { v4u w; w.x = pk2(acc[2 * s][0], acc[2 * s][1]); w.y = pk2(acc[2 * s][2], acc[2 * s][3]); w.z = pk2(acc[2 * s + 1][0], acc[2 * s + 1][1]); w.w = pk2(acc[2 * s + 1][2], acc[2 * s + 1][3]);
                        bfr[s] = __builtin_bit_cast(bf16x8, w); }
                    f32x4 nacc[4];
#pragma unroll
                    for (int tk = 0; tk < 4; ++tk) {
                        const v2u hv = *(const LAS v2u*)(base + 8192 + ((vq * 4 + tk) * 64 + lane) * 8);
                        nacc[tk] = (f32x4){__uint_as_float(hv.x << 16), __uint_as_float(hv.x & 0xffff0000u), __uint_as_float(hv.y << 16), __uint_as_float(hv.y & 0xffff0000u)};
#pragma unroll
                        for (int s = 0; s < 2; ++s) nacc[tk] = __builtin_amdgcn_mfma_f32_16x16x32_bf16(*(const LAS bf16x8*)(base + ((tk * 2 + s) * 64 + lane) * 16), bfr[s], nacc[tk], 0, 0, 0);
                    }
#pragma unroll
                    for (int tk = 0; tk < 4; ++tk) { acc[tk] = nacc[tk];
                        *(v2u*)(S0B + ((size_t)bh * NCH + cidx) * 4096 + ((vq * 4 + tk) * 64 + lane) * 4) = (v2u){pk2(acc[tk][0], acc[tk][1]), pk2(acc[tk][2], acc[tk][3])}; }
                }
            }
            __syncthreads();
        } else {
            const int ch = (unit - 32) * 512 + tid, b = ch >> 11, gn = ch & 2047;
            const float l64r = LAM64[gn * 2], l64i = LAM64[gn * 2 + 1];
            const size_t cb = (size_t)b * NCH * 4096 + (gn >> 6) * 128 + (gn & 63);
            float xr = 0.f, xi = 0.f;
            for (int c0 = 0; c0 < NCH; c0 += 8) {
                float zr[8], zi[8];
#pragma unroll
                for (int u = 0; u < 8; ++u) { const int cc = c0 + u < NCH ? c0 + u : NCH - 1; zr[u] = ZB[cb + (size_t)cc * 4096]; zi[u] = ZB[cb + (size_t)cc * 4096 + 64]; }
#pragma unroll
                for (int u = 0; u < 8; ++u) if (c0 + u < NCH) {
                    X0B[cb + (size_t)(c0 + u) * 4096] = xr; X0B[cb + (size_t)(c0 + u) * 4096 + 64] = xi;
                    const float nxr = l64r * xr - l64i * xi + zr[u], nxi = l64r * xi + l64i * xr + zi[u]; xr = nxr; xi = nxi; }
            }
        }
    }
    }
    xcd_barrier(xb);
    { PHASE_PTRS
    {
        const float* mu = ka->in[5]; const float* ln_g = ka->in[14]; const float* ln_b = ka->in[15];
        LAS unsigned char* SG = ldsl; float* Yf = (float*)(lds + 17408); float* Gf32 = Yf + 64 * 68;
        const int ty = wave >> 1, txb = 2 * (wave & 1), lj = lane & 15, lq = lane >> 4, y0 = 16 * ty, yy = y0 + lj;
        for (int unit = blockIdx.x; unit < NUNIT; unit += G) for (int rep_ = 0; rep_ < REP4; ++rep_) {
            const int c0 = unit % NCH, bh = unit / NCH, b = bh >> 3, h = bh & 7, row0 = chunk_row0(b, c0), prow = (c0 == 1) ? NREAL + 64 * b + 63 : row0 - 1, tq = wave, c = lane, hc = h * 64 + c;
            float vs[8];
            {
                float vv[9], g0[9], g1[9];
#pragma unroll
                for (int i = 0; i < 9; ++i) {
                    const bool valid = (c0 > 0) || (8 * tq + i > 0);
                    const int rr_ = 8 * tq + i - 1; const bf16* p = PROJ + (size_t)(rr_ >= 0 ? row0 + rr_ : (valid ? prow : row0)) * PROJW;
                    vv[i] = valid ? bf2f(p[C_V + hc]) : 0.f; g0[i] = valid ? bf2f(p[C_GD + c]) : 0.f; g1[i] = valid ? bf2f(p[C_GD + 64 + c]) : 0.f;
                }
                const float muv = mu[C_V + hc], mg0 = mu[C_GD + c], mg1 = mu[C_GD + 64 + c];
#pragma unroll
                for (int u = 0; u < 8; ++u) {
                    vs[u] = vv[u + 1] + (vv[u] - vv[u + 1]) * muv;
                    *(LAS bf16*)(SG + ((8 * tq + u) * 136 + c) * 2) = (bf16)f2bf(sigm(g0[u + 1] + (g0[u] - g0[u + 1]) * mg0));
                    *(LAS bf16*)(SG + ((8 * tq + u) * 136 + 64 + c) * 2) = (bf16)f2bf(sigm(g1[u + 1] + (g1[u] - g1[u + 1]) * mg1));
                }
            }
#pragma unroll
            for (int e = 0; e < 2; ++e) {
                const int tx = txb + e, xs = 16 * tx + 4 * lq;
                f32x4 v = {0.f, 0.f, 0.f, 0.f};
                if (c0 > 0) {
                    const bf16* sp = S0B + (size_t)(unit - 1) * 4096; const bf16* qp = QT + (size_t)unit * 4096;
#pragma unroll
                    for (int kq = 0; kq < 2; ++kq) {
                        const v2u s0 = *(const v2u*)(sp + ((tx * 4 + 2 * kq + (lq >> 1)) * 64 + 16 * (2 * (lq & 1)) + lj) * 4);
                        const v2u s1 = *(const v2u*)(sp + ((tx * 4 + 2 * kq + (lq >> 1)) * 64 + 16 * (2 * (lq & 1) + 1) + lj) * 4);
                        const v4u sw = {s0.x, s0.y, s1.x, s1.y};
                        const bf16x8 qf = *(const bf16x8*)(qp + yy * 64 + 32 * kq + 8 * lq);
                        v = __builtin_amdgcn_mfma_f32_16x16x32_bf16(__builtin_bit_cast(bf16x8, sw), qf, v, 0, 0, 0);
                    }
                }
                const v2u yl = *(const v2u*)(YR + (size_t)(row0 + yy) * RW + h * 64 + xs);
                v[0] += __uint_as_float(yl.x << 16); v[1] += __uint_as_float(yl.x & 0xffff0000u); v[2] += __uint_as_float(yl.y << 16); v[3] += __uint_as_float(yl.y & 0xffff0000u);
                *(f32x4*)(Yf + yy * 68 + xs) = v;
            }
            __syncthreads();
#pragma unroll
            for (int e = 0; e < 2; ++e) {
                const int x0 = 16 * (txb + e), xs = x0 + 4 * lq;
                f32x4 v = {0.f, 0.f, 0.f, 0.f};
#pragma unroll
                for (int kq = 0; kq < 4; ++kq) {
                    const bf16x8 fg = *(const bf16x8*)(GUPT + (size_t)(h * 64 + x0 + lj) * 128 + 32 * kq + 8 * lq);
                    const bf16x8 fs = *(const LAS bf16x8*)(SG + ((y0 + lj) * 136 + 32 * kq + 8 * lq) * 2);
                    v = __builtin_amdgcn_mfma_f32_16x16x32_bf16(fg, fs, v, 0, 0, 0);
                }
                *(f32x4*)(Gf32 + yy * 68 + xs) = v;
            }
            __syncthreads();
            {
                const float lg = ln_g[hc], lb = ln_b[hc];
#pragma unroll
                for (int u = 0; u < 8; ++u) {
                    const int t = 8 * tq + u;
                    const float y = Yf[t * 68 + c]; const float mean = wave_sum(y) * (1.f / 64.f); const float dv = y - mean; const float var = wave_sum(dv * dv) * (1.f / 64.f);
                    const float yn = dv * rsqrtf(var + 64e-5f) * lg + lb;
                    const float bonus = BON[(size_t)(row0 + t) * 8 + h] * vs[u];
                    if (rep_ == REP4 - 1) YR[(size_t)(row0 + t) * RW + hc] = (bf16)f2bf((yn + bonus) * Gf32[t * 68 + c]);
                }
            }
            __syncthreads();
        }
        for (int wu = gw; wu < S5UNITS; wu += NGW) s5_unit<true>(wu, PROJ, BRT, CRT, LAM, ka->in[24], ZB, X0B, ldsl + wave * 14592, lane);
    }
    }
    xcd_barrier(xb);
    { PHASE_PTRS
    { pg8::Gemm g{PROJ + C_U, WGLU_T, MP, 2 * D, RW, PROJW, RW}; pg8::StaticOrder S; S.init(MP, 2 * D, G, (int)blockIdx.x);
      pg8::EpiF<FGlu> E{{YB}};
      pg8::gemm_phase<pg8::EpiF<FGlu>, pg8::StaticOrder, true, true>(ldsl, g, S, E); }
    }
    xcd_barrier(xb);
    { PHASE_PTRS
    { pg8::Gemm g{YR, WBR_T, MP, D, RW, RW, RW}; pg8::StaticOrder S; S.init(MP, D, G, (int)blockIdx.x);
      pg8::EpiF<FMixin> E{{PROJ, YB, MIXIN}};
      pg8::gemm_phase<pg8::EpiF<FMixin>, pg8::StaticOrder, true, true>(ldsl, g, S, E); }
    }
    xcd_barrier(xb);
    { PHASE_PTRS
    { pg8::Gemm g{MIXIN, WOUT_T, MP, D, D, D, D}; pg8::StaticOrder S; S.init(MP, D, G, (int)blockIdx.x);
      pg8::EpiF<FStoreBf16> E{{MIX, D}};
      pg8::gemm_phase<pg8::EpiF<FStoreBf16>, pg8::StaticOrder, true, true>(ldsl, g, S, E); }
    }
    xcd_barrier(xb);
    { PHASE_PTRS
    {
        const float* gp = ka->in[3]; const float* gf = ka->in[27];
        for (int rep_ = 0; rep_ < REP8; ++rep_)
        for (int row = gw; row < MP; row += NGW) {
            const int j = row < NREAL ? 64 : ((row - NREAL) & 63);
            v2u* o = (v2u*)(HN2 + (size_t)row * D) + lane;
            if (j < PADR) {
#pragma unroll
                for (int jj = 0; jj < 4; ++jj) o[64 * jj] = (v2u){0u, 0u};
                continue; }
            const float* src = j < 64 ? meta + (size_t)(j - PADR) * D : x + (size_t)row * D;
            const v2u* mr = (const v2u*)(MIX + (size_t)row * D);
            f32x4 m[4], hv[4]; float ss = 0.f;
#pragma unroll
            for (int jj = 0; jj < 4; ++jj) { { const v2u q = mr[lane + 64 * jj]; m[jj] = (f32x4){__uint_as_float(q.x << 16), __uint_as_float(q.x & 0xffff0000u), __uint_as_float(q.y << 16), __uint_as_float(q.y & 0xffff0000u)}; } hv[jj] = ((const f32x4*)src)[lane + 64 * jj]; ss += (m[jj].x * m[jj].x + m[jj].y * m[jj].y) + (m[jj].z * m[jj].z + m[jj].w * m[jj].w); }
            const float rstd = rsqrtf(wave_sum(ss) * (1.f / D) + 1e-6f); float s2 = 0.f;
#pragma unroll
            for (int jj = 0; jj < 4; ++jj) { const f32x4 g4 = ((const f32x4*)gp)[lane + 64 * jj]; hv[jj] = hv[jj] + m[jj] * rstd * g4;
                s2 += (hv[jj].x * hv[jj].x + hv[jj].y * hv[jj].y) + (hv[jj].z * hv[jj].z + hv[jj].w * hv[jj].w); }
            const float rstd2 = rsqrtf(wave_sum(s2) * (1.f / D) + 1e-6f);
            if (j >= 64) { f32x4* od = (f32x4*)(ka->out + (size_t)row * D);
#pragma unroll
                for (int jj = 0; jj < 4; ++jj) od[lane + 64 * jj] = hv[jj]; }
#pragma unroll
            for (int jj = 0; jj < 4; ++jj) { const f32x4 g4 = ((const f32x4*)gf)[lane + 64 * jj];
                o[64 * jj] = (v2u){pk2(hv[jj].x * rstd2 * g4.x, hv[jj].y * rstd2 * g4.y), pk2(hv[jj].z * rstd2 * g4.z, hv[jj].w * rstd2 * g4.w)}; }
        }
    }
    }
    xcd_barrier(xb);
    { PHASE_PTRS
    { pg8::Gemm g{HN2, WUP_T, MP, UPW, D, D, D}; pg8::StaticOrder S; S.init(MP, UPW, G, (int)blockIdx.x);
      pg8::EpiF<FStoreBf16> E{{UP, UPW}};
      pg8::gemm_phase<pg8::EpiF<FStoreBf16>, pg8::StaticOrder, true, true>(ldsl, g, S, E); }
    }
    xcd_barrier(xb);
    { PHASE_PTRS
    {
        const float* cw = ka->in[30]; const float* cb = ka->in[31];
        const unsigned total = (unsigned)NREAL * (DFF / 8);
        for (unsigned idx = blockIdx.x * 512u + tid; idx < total; idx += (unsigned)G * 512u) {
            const int row = (int)(idx / (unsigned)(DFF / 8)), c = (int)(idx % (unsigned)(DFF / 8)) * 8, j = row & (SEQ - 1), mrow = NREAL + 64 * (row >> 13) + 63;
            const bf16* p = UP + (size_t)row * UPW + c;
            float a0[8], a1[8], a2[8], gt[8], o[8];
            unpack8(*(const v4u*)p, a0); unpack8(*(const v4u*)(p + DFF), gt);
            unpack8(*(const v4u*)(j >= 1 ? p - UPW : UP + (size_t)mrow * UPW + c), a1);
            unpack8(*(const v4u*)(j >= 2 ? p - 2 * UPW : UP + (size_t)(mrow - 1 + j) * UPW + c), a2);
#pragma unroll
            for (int e = 0; e < 8; ++e) { const float cv = cw[c + e] * a2[e] + cw[DFF + c + e] * a1[e] + cw[2 * DFF + c + e] * a0[e] + cb[c + e]; o[e] = gelu_t(cv) * gt[e]; }
            *(v4u*)(UP + (size_t)row * UPW + DFF + c) = pack8(o);
        }
    }
    }
    xcd_barrier(xb);
    { PHASE_PTRS
    { pg8::Gemm g{UP + DFF, WDN_T, NREAL, D, DFF, UPW, DFF}; pg8::StaticOrder S; S.init(NREAL, D, G, (int)blockIdx.x);
      pg8::EpiF<FStoreBf16> E{{FB, D}};
      pg8::gemm_phase<pg8::EpiF<FStoreBf16>, pg8::StaticOrder, true, true>(ldsl, g, S, E); }
    }
    xcd_barrier(xb);
    { PHASE_PTRS
    {
        const float* gq = ka->in[28];
        for (int r = gw; r < NB * SEQ; r += NGW) {
            const int row = r;
            const v2u* fr = (const v2u*)(FB + (size_t)row * D);
            f32x4 fv[4]; float ss = 0.f;
#pragma unroll
            for (int jj = 0; jj < 4; ++jj) { const v2u q = fr[lane + 64 * jj]; fv[jj] = (f32x4){__uint_as_float(q.x << 16), __uint_as_float(q.x & 0xffff0000u), __uint_as_float(q.y << 16), __uint_as_float(q.y & 0xffff0000u)};
                ss += (fv[jj].x * fv[jj].x + fv[jj].y * fv[jj].y) + (fv[jj].z * fv[jj].z + fv[jj].w * fv[jj].w); }
            const float rstd = rsqrtf(wave_sum(ss) * (1.f / D) + 1e-6f);
            f32x4* od = (f32x4*)(ka->out + (size_t)r * D);
#pragma unroll
            for (int jj = 0; jj < 4; ++jj) { const f32x4 g4 = ((const f32x4*)gq)[lane + 64 * jj]; od[lane + 64 * jj] = od[lane + 64 * jj] + fv[jj] * rstd * g4; }
        }
    }
    }
}

extern "C" void kernel_launch(void* const* d_in, const int* in_sizes, int n_in, void* d_out, int out_size, void* d_ws, size_t ws_size, hipStream_t stream) {
    static int grid = 0;
    if (grid == 0) {
        if (n_in != 33 || ws_size < WS_END) { fprintf(stderr, "kernel_launch: unexpected n_in %d / ws_size %zu\n", n_in, ws_size); grid = -1; return; }
        int dev = 0, cus = 0, per_cu = 0;
        (void)hipGetDevice(&dev); (void)hipDeviceGetAttribute(&cus, hipDeviceAttributeMultiprocessorCount, dev);
        (void)hipFuncSetAttribute((const void*)mega, hipFuncAttributeMaxDynamicSharedMemorySize, LDS_BYTES);
        (void)hipOccupancyMaxActiveBlocksPerMultiprocessor(&per_cu, (const void*)mega, 512, LDS_BYTES);
        if (per_cu < 1) { fprintf(stderr, "kernel_launch: occupancy query says %d blocks/CU\n", per_cu); per_cu = 1; }
        (void)hipGetLastError();
        grid = cus * per_cu;
    }
    if (grid < 0) return;
    Args a{};
    for (int i = 0; i < 33; ++i) a.in[i] = (const float*)d_in[i];
    a.out = (float*)d_out; a.ws = (unsigned char*)d_ws;
    void* args[] = {&a};
    hipError_t e = hipLaunchCooperativeKernel((const void*)mega, dim3(grid), dim3(512), args, LDS_BYTES, stream);
    if (e != hipSuccess) fprintf(stderr, "cooperative launch failed: %s (grid %d)\n", hipGetErrorString(e), grid);
}
```

```cpp
#include <hip/hip_runtime.h>
#include <hip/hip_cooperative_groups.h>
#include <cstdio>
#include <cstdint>
namespace cg = cooperative_groups;
#ifndef REPG
#define REPG 1
#endif
namespace pg8 {
#define PG8_LAS __attribute__((address_space(3)))
typedef unsigned short bf16_t;
typedef short bf16x8 __attribute__((ext_vector_type(8)));
typedef float f32x4 __attribute__((ext_vector_type(4)));
typedef unsigned u32x4 __attribute__((ext_vector_type(4)));
constexpr int BM = 256, BK = 64, HALF = 128, HTB = HALF * BK * 2  , STAGE_BYTES = 8 * HTB, NXCD = 8, WGM = 8;

__host__ __device__ __forceinline__ int lds_byte(int r, int c) { const int st = (r >> 4) * 2 + (c >> 5), rr = r & 15, cc = c & 31, ob = rr * 64 + cc * 2; return st * 1024 + (ob ^ (((ob >> 9) & 1) << 5)); }
__host__ __device__ __forceinline__ void stage_rc(int b, int& R, int& C) { const int st = b / 1024, sb = b % 1024, swz = sb ^ (((sb >> 9) & 1) << 5); R = (st >> 1) * 16 + swz / 64; C = (st & 1) * 32 + (swz % 64) / 2; }
__host__ __device__ __forceinline__ int perm32(int rho) { const int n = rho >> 4, i = rho & 15; return 8 * (i >> 2) + 4 * n + (i & 3); }

struct Unit { int pm, pn; };
struct Gemm { const bf16_t* A; const bf16_t* Bt; int M, N, K, lda, ldb; };

struct StaticOrder {
    int nM, nN, nwg, G, c;
    __host__ __device__ void init(int M, int N, int G_, int c_) { nM = M / BM; nN = N / BM; nwg = nM * nN; G = G_; c = c_; }
    __host__ __device__ bool next(int i, Unit& u) const {
        const long L = (long)i * G + c; if (L >= (long)nwg * REPG) return false;
        int wgid = (int)(L % nwg); { const int q = nwg / NXCD, r = nwg % NXCD, xcd = wgid % NXCD, off = wgid / NXCD; wgid = (xcd < r ? xcd * (q + 1) : r * (q + 1) + (xcd - r) * q) + off; }
        const int nig = WGM * nN, gid = wgid / nig, fm = gid * WGM, gsz = (nM - fm) < WGM ? (nM - fm) : WGM;
        u.pm = fm + ((wgid % nig) % gsz); u.pn = (wgid % nig) / gsz; return true;
    }
    __device__ __forceinline__ void a_ready(const Unit&) const {}
    __device__ __forceinline__ void done(const Unit&) const {}
};


template <class F> struct EpiF {
    static constexpr bool PERM = true, AFTER_DRAIN = false; F f;
    __device__ __forceinline__ void operator()(const f32x4 (&acc)[2][2][4][2], const Unit& u, int wr, int wc, int fr, int fq) const {
        const int cw = wc * 32 + 8 * fq;
#pragma unroll
        for (int ai = 0; ai < 2; ++ai)
#pragma unroll
            for (int m = 0; m < 4; ++m) {
                const int row = u.pm * BM + ai * HALF + wr * 64 + m * 16 + fr;
                f(row, u.pn, cw, acc[ai][0][m][0], acc[ai][0][m][1], acc[ai][1][m][0], acc[ai][1][m][1]);
            }
    }
};
template <class Epi, class Sched, bool ALIGN_EPI = false, bool SP2 = false>
__device__ __forceinline__ void gemm_phase(PG8_LAS unsigned char* lds, const Gemm g, const Sched& S, const Epi& E) {
    const int tid = threadIdx.x, wid = __builtin_amdgcn_readfirstlane(tid >> 6), lane = tid & 63, wr = wid >> 2, wc = wid & 3, fr = lane & 15, fq = lane >> 4;
    const int K = g.K, nt = K / BK;
    unsigned voffA[2], voffB[2];
#pragma unroll
    for (int i = 0; i < 2; ++i) { int R, C; stage_rc(tid * 16 + i * 8192, R, C); const int Rb = Epi::PERM ? ((R & ~31) + perm32(R & 31)) : R;
        voffA[i] = (unsigned)(R * g.lda + C) * 2u; voffB[i] = (unsigned)(Rb * g.ldb + C) * 2u; }
    const size_t kstep = (size_t)(BK * 2);
    const size_t hstepA = (size_t)HALF * g.lda * 2, hstepB = (size_t)HALF * g.ldb * 2;
    const size_t tstepA = 2 * hstepA, tstepB = 2 * hstepB;
    const unsigned ldsw = (unsigned)wid * 1024u;
    const int aoff = lds_byte(wr * 64 + fr, fq * 8), boff = lds_byte(wc * 32 + fr, fq * 8);
#define PG8_SA(b, h) (((b) * 2 + (h)) * HTB)
#define PG8_SB(b, h) ((4 + (b) * 2 + (h)) * HTB)
#define PG8_STAGE(bufoff, gbase, voff) do { _Pragma("unroll") for (int _i = 0; _i < 2; ++_i) \
        __builtin_amdgcn_global_load_lds((const unsigned*)((const char*)(gbase) + (voff)[_i]), (PG8_LAS unsigned*)(lds + (bufoff) + ldsw + _i * 8192), 16, 0, 0); } while (0)
#define PG8_LDA(dst, b, h) do { _Pragma("unroll") for (int m = 0; m < 4; ++m) _Pragma("unroll") for (int k = 0; k < 2; ++k) dst[m][k] = *(const PG8_LAS bf16x8*)(lds + PG8_SA(b, h) + aoff + m * 2048 + k * 1024); } while (0)
#define PG8_LDB(dst, b, h) do { _Pragma("unroll") for (int n = 0; n < 2; ++n) _Pragma("unroll") for (int k = 0; k < 2; ++k) dst[n][k] = *(const PG8_LAS bf16x8*)(lds + PG8_SB(b, h) + boff + n * 2048 + k * 1024); } while (0)
#define PG8_MMA(ai, bj, At, Bt) do { __builtin_amdgcn_s_setprio(1); _Pragma("unroll") for (int m = 0; m < 4; ++m) _Pragma("unroll") for (int n = 0; n < 2; ++n) _Pragma("unroll") for (int k = 0; k < 2; ++k) \
        acc[ai][bj][m][n] = __builtin_amdgcn_mfma_f32_16x16x32_bf16(Bt[n][k], At[m][k], acc[ai][bj][m][n], 0, 0, 0); __builtin_amdgcn_s_setprio(0); } while (0)
#define PG8_WAIT_V(n) asm volatile("s_waitcnt vmcnt(" #n ")" ::: "memory")
#define PG8_WAIT_L(n) asm volatile("s_waitcnt lgkmcnt(" #n ")" ::: "memory")
#define PG8_BAR __builtin_amdgcn_s_barrier()
#define PG8_SCHED __builtin_amdgcn_sched_barrier(0)
    Unit cur, nxt; int ui = 0;
    if (!S.next(0, cur)) return;
    f32x4 acc[2][2][4][2];
#pragma unroll
    for (int a = 0; a < 2; ++a)
#pragma unroll
        for (int b = 0; b < 2; ++b)
#pragma unroll
            for (int m = 0; m < 4; ++m)
#pragma unroll
                for (int n = 0; n < 2; ++n) acc[a][b][m][n] = (f32x4){0.f, 0.f, 0.f, 0.f};
    bf16x8 At[4][2], B0[2][2], B1[2][2];
    const char* cA = (const char*)g.A + (size_t)cur.pm * tstepA; const char* cB = (const char*)g.Bt + (size_t)cur.pn * tstepB;
    S.a_ready(cur);
    if constexpr (SP2) {
        PG8_STAGE(PG8_SB(0, 0), cB, voffB); PG8_STAGE(PG8_SB(0, 1), cB + hstepB, voffB); PG8_STAGE(PG8_SA(0, 0), cA, voffA); PG8_STAGE(PG8_SA(0, 1), cA + hstepA, voffA);
        if (wr == 1) PG8_BAR;
        PG8_WAIT_V(2); PG8_BAR;
        PG8_STAGE(PG8_SB(1, 0), cB + kstep, voffB); PG8_STAGE(PG8_SA(1, 0), cA + kstep, voffA); PG8_STAGE(PG8_SB(1, 1), cB + hstepB + kstep, voffB);
        PG8_WAIT_V(6); PG8_BAR;
    } else {
        PG8_STAGE(PG8_SB(0, 0), cB, voffB); PG8_STAGE(PG8_SA(0, 0), cA, voffA); PG8_STAGE(PG8_SB(0, 1), cB + hstepB, voffB); PG8_STAGE(PG8_SA(0, 1), cA + hstepA, voffA);
        if (wr == 1) PG8_BAR;
        PG8_WAIT_V(4); PG8_BAR;
        PG8_STAGE(PG8_SB(1, 0), cB + kstep, voffB); PG8_STAGE(PG8_SA(1, 0), cA + kstep, voffA); PG8_STAGE(PG8_SB(1, 1), cB + hstepB + kstep, voffB);
        PG8_WAIT_V(6); PG8_BAR;
    }
    for (;;) {
        const bool has_next = S.next(ui + 1, nxt);
        const char* nA = has_next ? (const char*)g.A + (size_t)nxt.pm * tstepA : cA; const char* nB = has_next ? (const char*)g.Bt + (size_t)nxt.pn * tstepB : cB;
        for (int t = 0; t < nt; t += 2) {
            const bool last = (t == nt - 2);
            const char* a1 = cA + (size_t)(t + 1) * kstep;
            const char* a2 = last ? nA : cA + (size_t)(t + 2) * kstep; const char* b2 = last ? nB : cB + (size_t)(t + 2) * kstep;
            const char* a3 = a2 + kstep; const char* b3 = b2 + kstep;
            if (last && has_next) S.a_ready(nxt);
            if constexpr (SP2) {
            PG8_LDB(B0, 0, 0); PG8_LDB(B1, 0, 1); PG8_SCHED; PG8_LDA(At, 0, 0); PG8_STAGE(PG8_SA(1, 1), a1 + hstepA, voffA);
            PG8_WAIT_V(8); PG8_WAIT_L(0); PG8_BAR; PG8_MMA(0, 0, At, B0); PG8_MMA(0, 1, At, B1); PG8_BAR; PG8_SCHED;
            PG8_LDA(At, 0, 1); PG8_STAGE(PG8_SB(0, 0), b2, voffB); PG8_STAGE(PG8_SB(0, 1), b2 + hstepB, voffB); PG8_STAGE(PG8_SA(0, 0), a2, voffA);
            PG8_WAIT_V(8); PG8_WAIT_L(0); PG8_BAR; PG8_MMA(1, 0, At, B0); PG8_MMA(1, 1, At, B1); PG8_BAR; PG8_SCHED;
            PG8_LDB(B0, 1, 0); PG8_LDB(B1, 1, 1); PG8_SCHED; PG8_LDA(At, 1, 0); PG8_STAGE(PG8_SA(0, 1), a2 + hstepA, voffA);
            PG8_WAIT_V(8); PG8_WAIT_L(0); PG8_BAR; PG8_MMA(0, 0, At, B0); PG8_MMA(0, 1, At, B1); PG8_BAR; PG8_SCHED;
            PG8_LDA(At, 1, 1); PG8_STAGE(PG8_SB(1, 0), b3, voffB); PG8_STAGE(PG8_SB(1, 1), b3 + hstepB, voffB); PG8_STAGE(PG8_SA(1, 0), a3, voffA);
            PG8_WAIT_V(8); PG8_WAIT_L(0); PG8_BAR; PG8_MMA(1, 0, At, B0); PG8_MMA(1, 1, At, B1); PG8_BAR; PG8_SCHED;
            } else {
            PG8_LDB(B0, 0, 0); PG8_SCHED; PG8_LDA(At, 0, 0); PG8_STAGE(PG8_SA(1, 1), a1 + hstepA, voffA);
            PG8_WAIT_L(8); PG8_BAR; PG8_WAIT_L(0); PG8_MMA(0, 0, At, B0); PG8_BAR; PG8_SCHED;
            PG8_LDB(B1, 0, 1); PG8_STAGE(PG8_SB(0, 0), b2, voffB);
            PG8_BAR; PG8_WAIT_L(0); PG8_MMA(0, 1, At, B1); PG8_BAR;
            PG8_LDA(At, 0, 1); PG8_STAGE(PG8_SA(0, 0), a2, voffA);
            PG8_BAR; PG8_WAIT_L(0); PG8_MMA(1, 0, At, B0); PG8_BAR; PG8_SCHED;
            PG8_STAGE(PG8_SB(0, 1), b2 + hstepB, voffB);
            PG8_WAIT_V(6); PG8_BAR; PG8_MMA(1, 1, At, B1); PG8_BAR;
            PG8_LDB(B0, 1, 0); PG8_SCHED; PG8_LDA(At, 1, 0); PG8_STAGE(PG8_SA(0, 1), a2 + hstepA, voffA);
            PG8_WAIT_L(8); PG8_BAR; PG8_WAIT_L(0); PG8_MMA(0, 0, At, B0); PG8_BAR; PG8_SCHED;
            PG8_LDB(B1, 1, 1); PG8_STAGE(PG8_SB(1, 0), b3, voffB);
            PG8_BAR; PG8_WAIT_L(0); PG8_MMA(0, 1, At, B1); PG8_BAR;
            PG8_LDA(At, 1, 1); PG8_STAGE(PG8_SA(1, 0), a3, voffA);
            PG8_BAR; PG8_WAIT_L(0); PG8_MMA(1, 0, At, B0); PG8_BAR; PG8_SCHED;
            PG8_STAGE(PG8_SB(1, 1), b3 + hstepB, voffB);
            PG8_WAIT_V(6); PG8_BAR; PG8_MMA(1, 1, At, B1); PG8_BAR;
            }
        }
        if constexpr (ALIGN_EPI) { if (wr == 0) PG8_BAR; }
        if constexpr (!Epi::AFTER_DRAIN) { E(acc, cur, wr, wc, fr, fq); S.done(cur); }
        if (!has_next) break;
#pragma unroll
        for (int a = 0; a < 2; ++a)
#pragma unroll
            for (int b = 0; b < 2; ++b)
#pragma unroll
                for (int m = 0; m < 4; ++m)
#pragma unroll
                    for (int n = 0; n < 2; ++n) acc[a][b][m][n] = (f32x4){0.f, 0.f, 0.f, 0.f};
        cur = nxt; cA = nA; cB = nB; ++ui;
        if constexpr (ALIGN_EPI) { if (wr == 1) PG8_BAR; }
    }
    PG8_WAIT_V(0);
    if constexpr (!ALIGN_EPI) { if (wr == 0) PG8_BAR; }
    PG8_BAR;
    if constexpr (Epi::AFTER_DRAIN) { E.fused(acc, cur, wr, wc, fr, fq, lds, wid, lane); S.done(cur); }
#undef PG8_SA
#undef PG8_SB
#undef PG8_STAGE
#undef PG8_LDA
#undef PG8_LDB
#undef PG8_MMA
#undef PG8_WAIT_V
#undef PG8_WAIT_L
#undef PG8_BAR
#undef PG8_SCHED
}
}

#ifndef REP0
#define REP0 1
#endif
#ifndef REP3
#define REP3 1
#endif
#ifndef REP8
#define REP8 1
#endif
#ifndef REP4
#define REP4 1
#endif
#ifndef REP4S
#define REP4S 1
#endif
#ifndef REP2
#define REP2 1
#endif
#ifndef REP2S
#define REP2S 1
#endif
#define LAS __attribute__((address_space(3)))
typedef unsigned short bf16;
typedef float f32x4 __attribute__((ext_vector_type(4)));
typedef unsigned v4u __attribute__((ext_vector_type(4)));
typedef unsigned v2u __attribute__((ext_vector_type(2)));

constexpr int NB = 4, SEQ = 8192, D = 1024, PADR = 48, NREAL = NB * SEQ, MP = NREAL + NB * 64;
__device__ __forceinline__ int chunk_row0(int b, int c0) { return c0 == 0 ? NREAL + 64 * b : b * SEQ + 64 * (c0 - 1); }
constexpr int RW = 512, PROJW = 4352, DFF = 2816, UPW = 2 * DFF;
constexpr int C_K = 512, C_V = 1024, C_WD = 1536, C_AD = 1600, C_GD = 1664, C_U = 1792, C_GA = 2304, C_GB = 3328;
constexpr size_t QB = (size_t)MP * 512 * 2;
constexpr size_t WO_WIN = 1u << 20, WO_WBR = WO_WIN + (size_t)PROJW * D * 2, WO_WGLU = WO_WBR + (size_t)D * RW * 2, WO_WOUT = WO_WGLU + (size_t)2 * D * RW * 2,
                 WO_WUP = WO_WOUT + (size_t)D * D * 2, WO_WDN = WO_WUP + (size_t)UPW * D * 2, WO_END = WO_WDN + (size_t)D * DFF * 2;
static_assert(WO_END <= QB, "weights fit in the first quantum");
constexpr size_t WO_WUPT = WO_END, WO_AUPT = WO_WUPT + 65536, WO_GUPT = WO_AUPT + 65536, WO_END2 = WO_GUPT + 131072;
static_assert(WO_END2 <= QB, "small tables fit in the first quantum");
constexpr size_t WS_HN = QB, WS_GF = QB, WS_HF = 2 * QB, WS_PROJ = 3 * QB, WS_YR = 11 * QB + QB / 2, WS_QT = WS_YR + QB, WS_YB = WS_QT + QB, WS_BON = WS_YB + 2 * QB, WS_END = WS_BON + (size_t)MP * 8 * 4;
constexpr size_t WS_MIXIN = QB, WS_MIX = WS_YR, WS_HN2 = QB, WS_UP = 3 * QB, WS_F = QB;
constexpr int NCH = 129, NUNIT = NB * 8 * NCH, S5UNITS = NB * 32 * NCH;
constexpr size_t WO_BRT = WO_END2, WO_CRT = WO_BRT + 131072, WO_LAM = WO_CRT + 131072, WO_LAM64 = WO_LAM + 16384, WO_END3 = WO_LAM64 + 16384;
static_assert(WO_END3 <= QB, "S5 tables fit in the first quantum");
constexpr size_t WS_Z = WS_YB, WS_X0 = WS_Z + (size_t)NB * NCH * 4096 * 4, WS_S0 = WS_X0 + (size_t)NB * NCH * 4096 * 4;
static_assert(WS_S0 + QB <= WS_YB + 2 * QB, "S0 fits in the YB region");
static_assert(WS_END <= 536870912ull, "workspace");
constexpr int OP = 72, OPB = 64 * OP * 2, MISC_OFF = 17 * OPB;
constexpr int LDS_BYTES = 159744, XB_LDS_OFF = 159488;
typedef short bf16x8 __attribute__((ext_vector_type(8)));

__device__ __forceinline__ float bf2f(unsigned h) { return __uint_as_float(h << 16); }
typedef float f32x2_t __attribute__((ext_vector_type(2))); typedef __bf16 bf16x2_t __attribute__((ext_vector_type(2)));
__device__ __forceinline__ unsigned pk2(float lo, float hi) { const f32x2_t v = {lo, hi}; const bf16x2_t b = __builtin_convertvector(v, bf16x2_t); return __builtin_bit_cast(unsigned, b); }
__device__ __forceinline__ unsigned f2bf(float f) { return pk2(f, 0.f) & 0xffffu; }
__device__ __forceinline__ void unpack8(const v4u q, float (&o)[8]) {
    o[0] = __uint_as_float(q.x << 16); o[1] = __uint_as_float(q.x & 0xffff0000u); o[2] = __uint_as_float(q.y << 16); o[3] = __uint_as_float(q.y & 0xffff0000u);
    o[4] = __uint_as_float(q.z << 16); o[5] = __uint_as_float(q.z & 0xffff0000u); o[6] = __uint_as_float(q.w << 16); o[7] = __uint_as_float(q.w & 0xffff0000u);
}
__device__ __forceinline__ v4u pack8(const float (&o)[8]) { v4u w; w.x = pk2(o[0], o[1]); w.y = pk2(o[2], o[3]); w.z = pk2(o[4], o[5]); w.w = pk2(o[6], o[7]); return w; }
template <int CTRL> __device__ __forceinline__ float dppf(float v) { return __int_as_float(__builtin_amdgcn_update_dpp(0, __float_as_int(v), CTRL, 0xf, 0xf, true)); }
__device__ __forceinline__ float wave_sum(float v) {
    v += dppf<0xB1>(v); v += dppf<0x4E>(v); v += dppf<0x141>(v); v += dppf<0x140>(v);
    const int iv = __float_as_int(v);
    return (__int_as_float(__builtin_amdgcn_readlane(iv, 0)) + __int_as_float(__builtin_amdgcn_readlane(iv, 16))) + (__int_as_float(__builtin_amdgcn_readlane(iv, 32)) + __int_as_float(__builtin_amdgcn_readlane(iv, 48)));
}
__device__ __forceinline__ float tanh_fast(float x) { return 1.f - 2.f / (__expf(2.f * x) + 1.f); }
__device__ __forceinline__ float sigm(float x) { return 1.f / (1.f + __expf(-x)); }
__device__ __forceinline__ float gelu_t(float x) { const float z = 0.7978845608f * (x + 0.044715f * x * x * x); const float t = 1.f - 2.f / (__expf(2.f * z) + 1.f); return 0.5f * x * (1.f + t); }

#define SLOT(i) (ldsl + (i) * OPB)
__device__ __forceinline__ bf16x8 ldfrag(const LAS unsigned char* buf, int r0, int ks, int lane) { return *(const LAS bf16x8*)(buf + ((r0 + (lane & 15)) * OP + 32 * ks + 8 * (lane >> 4)) * 2); }
__device__ __forceinline__ f32x4 tmm(const LAS unsigned char* X, int x0, const LAS unsigned char* Y, int y0, f32x4 acc, int lane) {
#pragma unroll
    for (int ks = 0; ks < 2; ++ks) acc = __builtin_amdgcn_mfma_f32_16x16x32_bf16(ldfrag(X, x0, ks, lane), ldfrag(Y, y0, ks, lane), acc, 0, 0, 0);
    return acc; }
__device__ __forceinline__ f32x4 tmmk(const LAS unsigned char* X, int x0, const LAS unsigned char* Y, int y0, f32x4 acc, int lane, bool k0, bool k1) {
    if (k0) acc = __builtin_amdgcn_mfma_f32_16x16x32_bf16(ldfrag(X, x0, 0, lane), ldfrag(Y, y0, 0, lane), acc, 0, 0, 0);
    if (k1) acc = __builtin_amdgcn_mfma_f32_16x16x32_bf16(ldfrag(X, x0, 1, lane), ldfrag(Y, y0, 1, lane), acc, 0, 0, 0);
    return acc; }
struct RawA { unsigned r[9], k[9], v[9], w[9], a[9]; };
__device__ __forceinline__ void a0_load(RawA& R, const unsigned short* PROJ, int unit, int tq, int c) {
    const int c0 = unit % 129, bh = unit / 129, b = bh >> 3, h = bh & 7, hc = h * 64 + c;
    const int row0 = c0 == 0 ? 32768 + 64 * b : b * 8192 + 64 * (c0 - 1), prow = (c0 == 1) ? 32768 + 64 * b + 63 : row0 - 1;
#pragma unroll
    for (int i = 0; i < 9; ++i) {
        const int rr_ = 8 * tq + i - 1; const bool valid = (c0 > 0) || (rr_ >= 0);
        const unsigned short* p = PROJ + (size_t)(rr_ >= 0 ? row0 + rr_ : (valid ? prow : row0)) * 4352;
        R.r[i] = valid ? p[hc] : 0u; R.k[i] = valid ? p[512 + hc] : 0u; R.v[i] = valid ? p[1024 + hc] : 0u; R.w[i] = valid ? p[1536 + c] : 0u; R.a[i] = valid ? p[1600 + c] : 0u;
    }
}
__device__ __forceinline__ void st4(LAS unsigned char* buf, int y, int x, f32x4 v) { *(LAS v2u*)(buf + (y * OP + x) * 2) = (v2u){pk2(v[0], v[1]), pk2(v[2], v[3])}; }
struct FStoreBf16 { bf16* O; int ldc;
    __device__ __forceinline__ void operator()(int row, int pn, int cw, f32x4 a00, f32x4 a01, f32x4 a10, f32x4 a11) const {
        bf16* p = O + (size_t)row * ldc + pn * 256 + cw;
        v4u w; w.x = pk2(a00[0], a00[1]); w.y = pk2(a00[2], a00[3]); w.z = pk2(a01[0], a01[1]); w.w = pk2(a01[2], a01[3]); *(v4u*)p = w;
        w.x = pk2(a10[0], a10[1]); w.y = pk2(a10[2], a10[3]); w.z = pk2(a11[0], a11[1]); w.w = pk2(a11[2], a11[3]); *(v4u*)(p + 128) = w; } };
struct FStoreF32 { float* O; int ldc;
    __device__ __forceinline__ void operator()(int row, int pn, int cw, f32x4 a00, f32x4 a01, f32x4 a10, f32x4 a11) const {
        float* p = O + (size_t)row * ldc + pn * 256 + cw;
        *(f32x4*)p = a00; *(f32x4*)(p + 4) = a01; *(f32x4*)(p + 128) = a10; *(f32x4*)(p + 132) = a11; } };
struct FGlu { bf16* YB;
    __device__ __forceinline__ void operator()(int row, int pn, int cw, f32x4 a00, f32x4 a01, f32x4 a10, f32x4 a11) const {
        float y[8];
#pragma unroll
        for (int e = 0; e < 4; ++e) { y[e] = a00[e] * sigm(a10[e]); y[4 + e] = a01[e] * sigm(a11[e]); }
        *(v4u*)(YB + (size_t)row * D + pn * 128 + cw) = pack8(y); } };
struct FMixin { const bf16* PROJ; const bf16* YB; bf16* MIXIN;
    __device__ __forceinline__ void one(int row, int col, f32x4 a0, f32x4 a1) const {
        float ga[8], gb[8], yb[8], o[8];
        unpack8(*(const v4u*)(PROJ + (size_t)row * PROJW + C_GA + col), ga); unpack8(*(const v4u*)(PROJ + (size_t)row * PROJW + C_GB + col), gb);
        unpack8(*(const v4u*)(YB + (size_t)row * D + col), yb);
#pragma unroll
        for (int e = 0; e < 4; ++e) { o[e] = sigm(ga[e]) * a0[e] + sigm(gb[e]) * yb[e]; o[4 + e] = sigm(ga[4 + e]) * a1[e] + sigm(gb[4 + e]) * yb[4 + e]; }
        *(v4u*)(MIXIN + (size_t)row * D + col) = pack8(o); }
    __device__ __forceinline__ void operator()(int row, int pn, int cw, f32x4 a00, f32x4 a01, f32x4 a10, f32x4 a11) const {
        one(row, pn * 256 + cw, a00, a01); one(row, pn * 256 + 128 + cw, a10, a11); } };

template <bool OUT> __device__ __forceinline__ void s5_unit(int id, bf16* PROJ, const bf16* BRT, const bf16* CRT, const float* LAM, const float* dvec, float* Z, const float* X0, LAS unsigned char* wl, int lane) {
    const int b = id / (32 * NCH), rem = id % (32 * NCH), g = rem / NCH, c0 = rem % NCH, row0 = chunk_row0(b, c0), lj = lane & 15, lq = lane >> 4, n = lane;
    LAS float* BU = (LAS float*)wl; LAS unsigned char* Xs = wl + 10240;
    const bf16x8 zf = {0, 0, 0, 0, 0, 0, 0, 0};
    bf16x8 bfrag[8];
#pragma unroll
    for (int nt = 0; nt < 8; ++nt) bfrag[nt] = lq < 2 ? *(const bf16x8*)(BRT + ((size_t)(g * 128 + 16 * nt + lj) * 16 + 8 * lq)) : zf;
    bf16x8 cfrag[4]; float dd[4];
    if (OUT) {
#pragma unroll
        for (int ks = 0; ks < 4; ++ks) cfrag[ks] = *(const bf16x8*)(CRT + ((size_t)(g * 16 + lj) * 128 + 32 * ks + 8 * lq));
#pragma unroll
        for (int r = 0; r < 4; ++r) dd[r] = dvec[g * 16 + 4 * lq + r];
    }
    const float lr = LAM[(g * 64 + n) * 2], li = LAM[(g * 64 + n) * 2 + 1];
    const size_t zi = ((size_t)(b * NCH + c0)) * 4096 + g * 128 + n;
    float xr = 0.f, xi = 0.f;
    if (OUT && c0 > 0) { xr = X0[zi]; xi = X0[zi + 64]; }
#pragma unroll 1
    for (int rd2 = 0; rd2 < 4 * REP4S; ++rd2) { const int rd = rd2 / REP4S; const bool lastrep = (rd2 % REP4S) == REP4S - 1; const float sxr = xr, sxi = xi;
        bf16* up = PROJ + (size_t)(row0 + 16 * rd + lj) * PROJW + C_U + g * 16;
        const bf16x8 ufrag = lq < 2 ? *(const bf16x8*)(up + 8 * lq) : zf;
        v2u u4 = {0u, 0u}; if (OUT) u4 = *(const v2u*)(up + 4 * lq);
#pragma unroll
        for (int nt = 0; nt < 8; ++nt) { const f32x4 d = __builtin_amdgcn_mfma_f32_16x16x32_bf16(ufrag, bfrag[nt], (f32x4){0.f, 0.f, 0.f, 0.f}, 0, 0, 0);
            *(LAS f32x4*)(BU + (16 * nt + lj) * 20 + 4 * lq) = d; }
        asm volatile("s_waitcnt lgkmcnt(0)" ::: "memory");
#pragma unroll
        for (int t4 = 0; t4 < 4; ++t4) {
            const f32x4 br = *(const LAS f32x4*)(BU + n * 20 + 4 * t4), bi = *(const LAS f32x4*)(BU + (64 + n) * 20 + 4 * t4);
#pragma unroll
            for (int r = 0; r < 4; ++r) {
                const float nxr = lr * xr - li * xi + br[r], nxi = lr * xi + li * xr + bi[r]; xr = nxr; xi = nxi;
                if (OUT) { *(LAS bf16*)(Xs + ((4 * t4 + r) * 136 + n) * 2) = (bf16)f2bf(xr); *(LAS bf16*)(Xs + ((4 * t4 + r) * 136 + 64 + n) * 2) = (bf16)f2bf(xi); }
            }
        }
        if (OUT) {
            asm volatile("s_waitcnt lgkmcnt(0)" ::: "memory");
            f32x4 y = {0.f, 0.f, 0.f, 0.f};
#pragma unroll
            for (int ks = 0; ks < 4; ++ks) y = __builtin_amdgcn_mfma_f32_16x16x32_bf16(cfrag[ks], *(const LAS bf16x8*)(Xs + (lj * 136 + 32 * ks + 8 * lq) * 2), y, 0, 0, 0);
            const float u0 = __uint_as_float(u4.x << 16), u1 = __uint_as_float(u4.x & 0xffff0000u), u2 = __uint_as_float(u4.y << 16), u3 = __uint_as_float(u4.y & 0xffff0000u);
            if (lastrep) *(v2u*)(up + 4 * lq) = (v2u){pk2(gelu_t(y[0] + dd[0] * u0), gelu_t(y[1] + dd[1] * u1)), pk2(gelu_t(y[2] + dd[2] * u2), gelu_t(y[3] + dd[3] * u3))};
        }
        asm volatile("s_waitcnt lgkmcnt(0)" ::: "memory");
        if (!lastrep) { xr = sxr; xi = sxi; }
    }
    if (!OUT) { Z[zi] = xr; Z[zi + 64] = xi; }
}

template <int K> __device__ __forceinline__ void dot2b(const bf16* wrow, const bf16* a0, const bf16* a1, int lane, float& s0, float& s1) {
    float p0 = 0.f, p1 = 0.f;
#pragma unroll
    for (int kk = 0; kk < K / 512; ++kk) { float wf[8], x0[8], x1[8]; unpack8(*(const v4u*)(wrow + kk * 512 + lane * 8), wf); unpack8(*(const v4u*)(a0 + kk * 512 + lane * 8), x0); unpack8(*(const v4u*)(a1 + kk * 512 + lane * 8), x1);
#pragma unroll
        for (int e = 0; e < 8; ++e) { p0 += wf[e] * x0[e]; p1 += wf[e] * x1[e]; } }
    s0 = wave_sum(p0); s1 = wave_sum(p1);
}
template <int K> __device__ __forceinline__ void dot2f(const bf16* wrow, const float* a0, const float* a1, int lane, float& s0, float& s1) {
    float p0 = 0.f, p1 = 0.f;
#pragma unroll
    for (int kk = 0; kk < K / 512; ++kk) { float wf[8]; unpack8(*(const v4u*)(wrow + kk * 512 + lane * 8), wf);
        const f32x4 xa = *(const f32x4*)(a0 + kk * 512 + lane * 8), xb = *(const f32x4*)(a0 + kk * 512 + lane * 8 + 4), ya = *(const f32x4*)(a1 + kk * 512 + lane * 8), yb = *(const f32x4*)(a1 + kk * 512 + lane * 8 + 4);
#pragma unroll
        for (int e = 0; e < 4; ++e) { p0 += wf[e] * xa[e] + wf[4 + e] * xb[e]; p1 += wf[e] * ya[e] + wf[4 + e] * yb[e]; } }
    s0 = wave_sum(p0); s1 = wave_sum(p1);
}

struct Args { const float* in[33]; float* out; unsigned char* ws; };

__device__ __forceinline__ void transpose_item(const float* W, int K, int N, bf16* WT, int glu, float* scr, int item, int lane) {
    const int nblk = N / 32, kb = item / nblk, nb = item % nblk, k0 = 64 * kb, n0 = 32 * nb;
#pragma unroll 8
    for (int i = 0; i < 32; ++i) { const int kk = 2 * i + (lane >> 5); scr[kk * 33 + (lane & 31)] = W[(size_t)(k0 + kk) * N + n0 + (lane & 31)]; }
    asm volatile("s_waitcnt lgkmcnt(0)" ::: "memory");
    int d0 = n0; if (glu) { const int bj = n0 / 1024, rem = n0 % 1024; d0 = 256 * (rem / 128) + 128 * bj + (rem % 128); }
    const int c = lane & 7;
#pragma unroll
    for (int j = 0; j < 4; ++j) { const int n = (lane >> 3) + 8 * j; const float* s = scr + (8 * c) * 33 + n;
        v4u o; o.x = pk2(s[0 * 33], s[1 * 33]); o.y = pk2(s[2 * 33], s[3 * 33]); o.z = pk2(s[4 * 33], s[5 * 33]); o.w = pk2(s[6 * 33], s[7 * 33]);
        *(v4u*)(WT + (size_t)(d0 + n) * K + k0 + 8 * c) = o; }
    asm volatile("s_waitcnt lgkmcnt(0)" ::: "memory");
}

__device__ __forceinline__ float shiftv(const bf16* PROJ, int row, int j, int col, float mu) {
    const float cur = bf2f(PROJ[(size_t)row * PROJW + col]); const float prev = j > 0 ? bf2f(PROJ[(size_t)(row - 1) * PROJW + col]) : 0.f;
    return cur + (prev - cur) * mu;
}

#define XB_TMO      128
#define XB_XCNT(j)  (256  + 64 * (j))
#define XB_XSUB(j)  (1280 + 64 * (j))
#define XB_XGEN(j)  (2304 + 64 * (j))
#define XB_TOP      3328
#define XB_TOPGEN   3392
#define XCD_BAR_WORDS 3456
#define XB_SPIN_CAP (1u << 18)

__device__ __forceinline__ unsigned xb_ld(unsigned* p)              { return __hip_atomic_load(p, __ATOMIC_RELAXED, __HIP_MEMORY_SCOPE_AGENT); }
__device__ __forceinline__ unsigned xb_add(unsigned* p, unsigned v) { return __hip_atomic_fetch_add(p, v, __ATOMIC_RELAXED, __HIP_MEMORY_SCOPE_AGENT); }
__device__ __forceinline__ unsigned xb_xcc_id() { return (unsigned)__builtin_amdgcn_s_getreg((3 << 11) | 20) & 0xFu; }
#define XB_SPIN(cond, bar) do { unsigned _sp = 0; while (cond) { __builtin_amdgcn_s_sleep(1); \
    if ((++_sp & 255u) == 0u) { if (xb_ld(&(bar)[XB_TMO])) break; if (_sp > XB_SPIN_CAP) { atomicAdd(&(bar)[XB_TMO], 1u); break; } } } } while (0)

struct XcdBarrier {
    unsigned* bar; unsigned x;
    volatile LAS unsigned* st;
};

__device__ __forceinline__ XcdBarrier xcd_barrier_post(unsigned* bar, volatile LAS unsigned* st) {
    XcdBarrier b; b.bar = bar; b.x = xb_xcc_id(); b.st = st;
    if (threadIdx.x == 0) (void)xb_add(&bar[XB_XCNT(b.x)], 1u);
    return b;
}
__device__ __forceinline__ void xcd_barrier_complete(unsigned* bar, unsigned x, unsigned& nloc, unsigned& nx) {
    const unsigned G = gridDim.x * gridDim.y * gridDim.z;
    unsigned sum, cnt, mine, sp = 0u;
    for (;;) {
        sum = 0u; cnt = 0u; mine = 0u;
#pragma unroll
        for (unsigned j = 0; j < 16; ++j) { const unsigned c = xb_ld(&bar[XB_XCNT(j)]); sum += c; cnt += (c > 0u) ? 1u : 0u; mine = (j == x) ? c : mine; }
        if (sum == G) break;
        __builtin_amdgcn_s_sleep(1);
        if ((++sp & 255u) == 0u) { if (xb_ld(&bar[XB_TMO])) break; if (sp > XB_SPIN_CAP) { atomicAdd(&bar[XB_TMO], 1u); break; } }
    }
    nloc = mine > 0u ? mine : 1u; nx = cnt > 0u ? cnt : 1u;
}

__device__ __forceinline__ void xcd_barrier(const XcdBarrier& b) {
    asm volatile("s_waitcnt vmcnt(0)" ::: "memory");
    __syncthreads();
    if (threadIdx.x == 0) {
        unsigned* bar = b.bar;
        __builtin_amdgcn_s_waitcnt(0);
        unsigned nloc = b.st[0], nx = b.st[1];
        if (nloc == 0u) { xcd_barrier_complete(bar, b.x, nloc, nx); b.st[0] = nloc; b.st[1] = nx; }
        const unsigned old = xb_add(&bar[XB_XSUB(b.x)], 1u);
        const unsigned gen = old / nloc;
        if (old + 1u == (gen + 1u) * nloc) {
            __builtin_amdgcn_fence(__ATOMIC_RELEASE, "agent");
            asm volatile("s_waitcnt vmcnt(0)" ::: "memory");
            const unsigned og = xb_add(&bar[XB_TOP], 1u);
            const unsigned tg = og / nx;
            if (og + 1u == (tg + 1u) * nx) xb_add(&bar[XB_TOPGEN], 1u);
            else XB_SPIN(xb_ld(&bar[XB_TOPGEN]) == tg, bar);
            __builtin_amdgcn_fence(__ATOMIC_ACQUIRE, "agent");
            xb_add(&bar[XB_XGEN(b.x)], 1u);
            asm volatile("s_waitcnt vmcnt(0)" ::: "memory");
        } else {
            XB_SPIN(xb_ld(&bar[XB_XGEN(b.x)]) == gen, bar);
            __builtin_amdgcn_fence(__ATOMIC_ACQUIRE, "agent");
            asm volatile("s_waitcnt vmcnt(0)" ::: "memory");
        }
    }
    __syncthreads();
}

typedef const __attribute__((address_space(4))) Args* KArgsP;
__device__ __forceinline__ KArgsP kargs() { KArgsP p = (KArgsP)__builtin_amdgcn_kernarg_segment_ptr(); asm volatile("" : "+s"(p)); return p; }
#define RWKV_C_UNIT(unit) do { \
            const int c0 = unit % NCH, bh = unit / NCH, b = bh >> 3, h = bh & 7, row0 = chunk_row0(b, c0), prow = (c0 == 1) ? NREAL + 64 * b + 63 : row0 - 1, tq = wave, c = lane, hc = h * 64 + c; \
            float vs[8]; \
            { \
                float vv[9], g0[9], g1[9]; \
_Pragma("unroll") \
                for (int i = 0; i < 9; ++i) { \
                    const bool valid = (c0 > 0) || (8 * tq + i > 0); \
                    const int rr_ = 8 * tq + i - 1; const bf16* p = PROJ + (size_t)(rr_ >= 0 ? row0 + rr_ : (valid ? prow : row0)) * PROJW; \
                    vv[i] = valid ? bf2f(p[C_V + hc]) : 0.f; g0[i] = valid ? bf2f(p[C_GD + c]) : 0.f; g1[i] = valid ? bf2f(p[C_GD + 64 + c]) : 0.f; \
                } \
                const float muv = mu[C_V + hc], mg0 = mu[C_GD + c], mg1 = mu[C_GD + 64 + c]; \
_Pragma("unroll") \
                for (int u = 0; u < 8; ++u) { \
                    vs[u] = vv[u + 1] + (vv[u] - vv[u + 1]) * muv; \
                    *(LAS bf16*)(SG + ((8 * tq + u) * 136 + c) * 2) = (bf16)f2bf(sigm(g0[u + 1] + (g0[u] - g0[u + 1]) * mg0)); \
                    *(LAS bf16*)(SG + ((8 * tq + u) * 136 + 64 + c) * 2) = (bf16)f2bf(sigm(g1[u + 1] + (g1[u] - g1[u + 1]) * mg1)); \
                } \
            } \
 \
_Pragma("unroll") \
            for (int e = 0; e < 2; ++e) { \
                const int tx = txb + e, xs = 16 * tx + 4 * lq; \
                f32x4 v = {0.f, 0.f, 0.f, 0.f}; \
                if (c0 > 0) { \
                    const bf16* sp = S0B + (size_t)(unit - 1) * 4096; const bf16* qp = QT + (size_t)unit * 4096; \
_Pragma("unroll") \
                    for (int kq = 0; kq < 2; ++kq) { \
                        const v2u s0 = *(const v2u*)(sp + ((tx * 4 + 2 * kq + (lq >> 1)) * 64 + 16 * (2 * (lq & 1)) + lj) * 4); \
                        const v2u s1 = *(const v2u*)(sp + ((tx * 4 + 2 * kq + (lq >> 1)) * 64 + 16 * (2 * (lq & 1) + 1) + lj) * 4); \
                        const v4u sw = {s0.x, s0.y, s1.x, s1.y}; \
                        const bf16x8 qf = *(const bf16x8*)(qp + yy * 64 + 32 * kq + 8 * lq); \
                        v = __builtin_amdgcn_mfma_f32_16x16x32_bf16(__builtin_bit_cast(bf16x8, sw), qf, v, 0, 0, 0); \
                    } \
                } \
                const v2u yl = *(const v2u*)(YR + (size_t)(row0 + yy) * RW + h * 64 + xs); \
                v[0] += __uint_as_float(yl.x << 16); v[1] += __uint_as_float(yl.x & 0xffff0000u); v[2] += __uint_as_float(yl.y << 16); v[3] += __uint_as_float(yl.y & 0xffff0000u); \
                *(f32x4*)(Yf + yy * 68 + xs) = v; \
            } \
            __syncthreads(); \
 \
_Pragma("unroll") \
            for (int e = 0; e < 2; ++e) { \
                const int x0 = 16 * (txb + e), xs = x0 + 4 * lq; \
                f32x4 v = {0.f, 0.f, 0.f, 0.f}; \
_Pragma("unroll") \
                for (int kq = 0; kq < 4; ++kq) { \
                    const bf16x8 fg = *(const bf16x8*)(GUPT + (size_t)(h * 64 + x0 + lj) * 128 + 32 * kq + 8 * lq); \
                    const bf16x8 fs = *(const LAS bf16x8*)(SG + ((y0 + lj) * 136 + 32 * kq + 8 * lq) * 2); \
                    v = __builtin_amdgcn_mfma_f32_16x16x32_bf16(fg, fs, v, 0, 0, 0); \
                } \
                *(f32x4*)(Gf32 + yy * 68 + xs) = v; \
            } \
            __syncthreads(); \
            { \
                const float lg = ln_g[hc], lb = ln_b[hc]; \
_Pragma("unroll") \
                for (int u = 0; u < 8; ++u) { \
                    const int t = 8 * tq + u; \
                    const float y = Yf[t * 68 + c]; const float mean = wave_sum(y) * (1.f / 64.f); const float dv = y - mean; const float var = wave_sum(dv * dv) * (1.f / 64.f); \
                    const float yn = dv * rsqrtf(var + 64e-5f) * lg + lb; \
                    const float bonus = BON[(size_t)(row0 + t) * 8 + h] * vs[u]; \
                    YR[(size_t)(row0 + t) * RW + hc] = (bf16)f2bf((yn + bonus) * Gf32[t * 68 + c]); \
                } \
            } \
            __syncthreads(); \
} while (0)
#define RWKV_C_DEFS const float* mu = ka->in[5]; const float* ln_g = ka->in[14]; const float* ln_b = ka->in[15]; \
        LAS unsigned char* SG = ldsl; float* Yf = (float*)(lds + 17408); float* Gf32 = Yf + 64 * 68; \
        const int ty = wave >> 1, txb = 2 * (wave & 1), lj = lane & 15, lq = lane >> 4, y0 = 16 * ty, yy = y0 + lj;
#define PHASE_PTRS KArgsP ka = kargs(); unsigned char* ws = ka->ws; \
    const float* x = ka->in[0]; const float* meta = ka->in[1]; \
    bf16* WIN_T = (bf16*)(ws + WO_WIN); bf16* WBR_T = (bf16*)(ws + WO_WBR); bf16* WGLU_T = (bf16*)(ws + WO_WGLU); bf16* WOUT_T = (bf16*)(ws + WO_WOUT); \
    bf16* WUP_T = (bf16*)(ws + WO_WUP); bf16* WDN_T = (bf16*)(ws + WO_WDN); \
    bf16* HN = (bf16*)(ws + WS_HN); bf16* PROJ = (bf16*)(ws + WS_PROJ); \
    bf16* GF = (bf16*)(ws + WS_GF); bf16* HF = (bf16*)(ws + WS_HF); bf16* YR = (bf16*)(ws + WS_YR); bf16* QT = (bf16*)(ws + WS_QT); float* BON = (float*)(ws + WS_BON); \
    bf16* BRT = (bf16*)(ws + WO_BRT); bf16* CRT = (bf16*)(ws + WO_CRT); float* LAM = (float*)(ws + WO_LAM); float* LAM64 = (float*)(ws + WO_LAM64); float* ZB = (float*)(ws + WS_Z); float* X0B = (float*)(ws + WS_X0); bf16* S0B = (bf16*)(ws + WS_S0); float* YBm = (float*)(ws + 65536); float* MIXINm = YBm + 2048; float* MIXm = YBm + 4096; float* HN2m = YBm + 6144; \
    bf16* WUPT = (bf16*)(ws + WO_WUPT); bf16* AUPT = (bf16*)(ws + WO_AUPT); bf16* GUPT = (bf16*)(ws + WO_GUPT); \
    bf16* YB = (bf16*)(ws + WS_YB); bf16* MIXIN = (bf16*)(ws + WS_MIXIN); bf16* MIX = (bf16*)(ws + WS_MIX); bf16* HN2 = (bf16*)(ws + WS_HN2); bf16* UP = (bf16*)(ws + WS_UP); bf16* FB = (bf16*)(ws + WS_F);
__global__ void __launch_bounds__(512, 2) mega(Args a_unused) {
    extern __shared__ __attribute__((aligned(16))) unsigned char lds[];
    cg::grid_group grid = cg::this_grid();
    const int tid = threadIdx.x, lane = tid & 63, wave = __builtin_amdgcn_readfirstlane(tid >> 6);
    const int G = gridDim.x, gw = blockIdx.x * 8 + wave, NGW = G * 8;
    LAS unsigned char* ldsl = (LAS unsigned char*)lds;
    if (tid < 2) *(volatile LAS unsigned*)(ldsl + XB_LDS_OFF + 4 * tid) = 0u;
    if (blockIdx.x == 0) { unsigned* bw = (unsigned*)kargs()->ws; for (int i = tid; i < XCD_BAR_WORDS; i += 512) bw[i] = 0u; }

    { PHASE_PTRS
    {
        float* scr = (float*)(lds + wave * 16384);
        constexpr int I0 = 16 * 136, I1 = 8 * 32, I2 = 8 * 64, I3 = 16 * 32, I4 = 16 * 176, I5 = 44 * 32, I6 = 16, I7 = 16, I8 = 32;
        for (int rep_ = 0; rep_ < REP0; ++rep_)
        for (int it = gw; it < I0 + I1 + I2 + I3 + I4 + I5 + I6 + I7 + I8; it += NGW) {
            int r = it;
            if (r < I0) { transpose_item(ka->in[4], D, PROJW, WIN_T, 0, scr, r, lane); continue; } r -= I0;
            if (r < I1) { transpose_item(ka->in[16], RW, D, WBR_T, 0, scr, r, lane); continue; } r -= I1;
            if (r < I2) { transpose_item(ka->in[25], RW, 2 * D, WGLU_T, 1, scr, r, lane); continue; } r -= I2;
            if (r < I3) { transpose_item(ka->in[26], D, D, WOUT_T, 0, scr, r, lane); continue; } r -= I3;
            if (r < I4) { transpose_item(ka->in[29], D, UPW, WUP_T, 0, scr, r, lane); continue; } r -= I4;
            if (r < I5) { transpose_item(ka->in[32], DFF, D, WDN_T, 0, scr, r, lane); continue; } r -= I5;
            if (r < I6) { transpose_item(ka->in[7], 64, RW, WUPT, 0, scr, r, lane); continue; } r -= I6;
            if (r < I7) { transpose_item(ka->in[9], 64, RW, AUPT, 0, scr, r, lane); continue; } r -= I7;
            transpose_item(ka->in[10], 128, RW, GUPT, 0, scr, r, lane);
        }
        {
            const int gt = blockIdx.x * 512 + tid;
            if (gt < 2048) {
                const int g = gt >> 6, n = gt & 63;
                const float lre = fminf(ka->in[17][gt], -1e-4f), lim = ka->in[18][gt], dt = __expf(ka->in[19][g]);
                const float mag = __expf(lre * dt); float sn, cs; sincosf(lim * dt, &sn, &cs);
                const float lbr = mag * cs, lbi = mag * sn;
                LAM[gt * 2] = lbr; LAM[gt * 2 + 1] = lbi;
                const float m64 = __expf(64.f * lre * dt); float s64, c64; sincosf(64.f * lim * dt, &s64, &c64);
                LAM64[gt * 2] = m64 * c64; LAM64[gt * 2 + 1] = m64 * s64;
                const float den = lre * lre + lim * lim, nr = lbr - 1.f, ni = lbi;
                const float cr = (nr * lre + ni * lim) / den, ci = (ni * lre - nr * lim) / den;
                for (int i = 0; i < 16; ++i) { const float br = ka->in[20][gt * 16 + i], bi = ka->in[21][gt * 16 + i];
                    BRT[(size_t)(g * 128 + n) * 16 + i] = (bf16)f2bf(cr * br - ci * bi); BRT[(size_t)(g * 128 + 64 + n) * 16 + i] = (bf16)f2bf(cr * bi + ci * br); }
            }
            for (int idx = gt; idx < 32 * 16 * 128; idx += G * 512) { const int n2 = idx & 127, gh = idx >> 7;
                CRT[idx] = (bf16)f2bf(n2 < 64 ? ka->in[22][gh * 64 + n2] : -ka->in[23][gh * 64 + n2 - 64]); }
        }
        const float* g = ka->in[2];
        for (int rep_ = 0; rep_ < REP0; ++rep_)
        for (int row = gw; row < MP; row += NGW) {
            const int j = row < NREAL ? 64 : ((row - NREAL) & 63);
            v2u* o = (v2u*)(HN + (size_t)row * D) + lane;
            if (j < PADR) {
#pragma unroll
                for (int jj = 0; jj < 4; ++jj) o[64 * jj] = (v2u){0u, 0u};
                continue; }
            const float* src = j < 64 ? meta + (size_t)(j - PADR) * D : x + (size_t)row * D;
            f32x4 v[4]; float ss = 0.f;
#pragma unroll
            for (int jj = 0; jj < 4; ++jj) { v[jj] = ((const f32x4*)src)[lane + 64 * jj]; ss += (v[jj].x * v[jj].x + v[jj].y * v[jj].y) + (v[jj].z * v[jj].z + v[jj].w * v[jj].w); }
            const float rstd = rsqrtf(wave_sum(ss) * (1.f / D) + 1e-6f);
#pragma unroll
            for (int jj = 0; jj < 4; ++jj) { const f32x4 g4 = ((const f32x4*)g)[lane + 64 * jj];
                o[64 * jj] = (v2u){pk2(v[jj].x * rstd * g4.x, v[jj].y * rstd * g4.y), pk2(v[jj].z * rstd * g4.z, v[jj].w * rstd * g4.w)}; }
        }
    }
    }
    grid.sync();
    const XcdBarrier xb = xcd_barrier_post((unsigned*)kargs()->ws, (volatile LAS unsigned*)(ldsl + XB_LDS_OFF));
    { PHASE_PTRS
    { pg8::Gemm g{HN, WIN_T, MP, PROJW, D, D, D}; pg8::StaticOrder S; S.init(MP, PROJW, G, (int)blockIdx.x);
      pg8::EpiF<FStoreBf16> E{{PROJ, PROJW}};
      pg8::gemm_phase<pg8::EpiF<FStoreBf16>, pg8::StaticOrder, true, true>(ldsl, g, S, E); }
    }
    xcd_barrier(xb);
    { PHASE_PTRS
    {
        const float* mu = ka->in[5]; const float* w0 = ka->in[6]; const float* a0 = ka->in[8]; const float* k_k = ka->in[11]; const float* k_a = ka->in[12]; const float* r_k = ka->in[13];
        float* tot = (float*)(lds + MISC_OFF); float* WCs = tot + 512;
        float* WLf = (float*)(lds + 13 * OPB); float* ALf = WLf + 64 * 68;
        const int ty = wave >> 1, txb = 2 * (wave & 1), lj = lane & 15, lq = lane >> 4, y0 = 16 * ty, yy = y0 + lj;
        RawA raw;
        if ((int)blockIdx.x < NUNIT) a0_load(raw, PROJ, blockIdx.x, wave, lane);
        for (int unit = blockIdx.x; unit < NUNIT; unit += G) {
            const int c0 = unit % NCH, bh = unit / NCH, b = bh >> 3, h = bh & 7, row0 = chunk_row0(b, c0), tq = wave, c = lane, hc = h * 64 + c;
            float rs[8], ks[8], vs[8];
            {
                float rv[9], kv[9], vv[9], wdv[9], adv[9];
#pragma unroll
                for (int i = 0; i < 9; ++i) { rv[i] = bf2f(raw.r[i]); kv[i] = bf2f(raw.k[i]); vv[i] = bf2f(raw.v[i]); wdv[i] = bf2f(raw.w[i]); adv[i] = bf2f(raw.a[i]); }
                const float mur = mu[hc], muk = mu[C_K + hc], muv = mu[C_V + hc], muw = mu[C_WD + c], mua = mu[C_AD + c];
#pragma unroll
                for (int u = 0; u < 8; ++u) {
                    rs[u] = rv[u + 1] + (rv[u] - rv[u + 1]) * mur; ks[u] = kv[u + 1] + (kv[u] - kv[u + 1]) * muk; vs[u] = vv[u + 1] + (vv[u] - vv[u + 1]) * muv;
                    const float wd = wdv[u + 1] + (wdv[u] - wdv[u + 1]) * muw, ad = adv[u + 1] + (adv[u] - adv[u + 1]) * mua;
                    *(LAS bf16*)(SLOT(11) + ((8 * tq + u) * OP + c) * 2) = (bf16)f2bf(tanh_fast(wd));
                    *(LAS bf16*)(SLOT(12) + ((8 * tq + u) * OP + c) * 2) = (bf16)f2bf(ad);
                }
            }
            if (unit + G < NUNIT) a0_load(raw, PROJ, unit + G, wave, lane);
            __syncthreads();
#pragma unroll
            for (int e = 0; e < 2; ++e) {
                const int x0 = 16 * (txb + e), xs = x0 + 4 * lq;
                f32x4 aw = {0.f, 0.f, 0.f, 0.f}, aa = {0.f, 0.f, 0.f, 0.f};
#pragma unroll
                for (int kq = 0; kq < 2; ++kq) {
                    const bf16x8 fw = *(const bf16x8*)(WUPT + (size_t)(h * 64 + x0 + lj) * 64 + 32 * kq + 8 * lq);
                    const bf16x8 fa = *(const bf16x8*)(AUPT + (size_t)(h * 64 + x0 + lj) * 64 + 32 * kq + 8 * lq);
                    aw = __builtin_amdgcn_mfma_f32_16x16x32_bf16(fw, ldfrag(SLOT(11), y0, kq, lane), aw, 0, 0, 0);
                    aa = __builtin_amdgcn_mfma_f32_16x16x32_bf16(fa, ldfrag(SLOT(12), y0, kq, lane), aa, 0, 0, 0);
                }
                *(f32x4*)(WLf + yy * 68 + xs) = aw; *(f32x4*)(ALf + yy * 68 + xs) = aa;
            }
            __syncthreads();
            {
                float lw[8], av[8], cum[8];
                const float w0c = w0[hc], a0c = a0[hc], kkc = k_k[hc], kac = k_a[hc], rkc = r_k[hc];
#pragma unroll
                for (int u = 0; u < 8; ++u) { const int t = 8 * tq + u; lw[u] = -0.60653066f * sigm(w0c + WLf[t * 68 + c]); av[u] = sigm(a0c + ALf[t * 68 + c]); }
                cum[0] = lw[0];
#pragma unroll
                for (int u = 1; u < 8; ++u) cum[u] = cum[u - 1] + lw[u];
                tot[tq * 64 + c] = cum[7];
                __syncthreads();
                float off = 0.f, all = 0.f;
#pragma unroll
                for (int w = 0; w < 8; ++w) { const float tv = tot[w * 64 + c]; all += tv; off += (w < tq) ? tv : 0.f; }
                float kkdT[8], bdT[8], kdT[8];
#pragma unroll
                for (int u = 0; u < 8; ++u) {
                    const int t = 8 * tq + u; const float ci = off + cum[u], cx = ci - lw[u];
                    const float kkv = ks[u] * kkc; const float n2 = wave_sum(kkv * kkv); const float kk = kkv / fmaxf(sqrtf(n2), 1e-12f);
                    const float k2 = ks[u] * (1.f + (av[u] - 1.f) * kac), bb = kk * av[u];
                    const float em = __expf(-ci), ed = __expf(all - ci);
                    kkdT[u] = kk * __expf(cx); bdT[u] = bb * ed; kdT[u] = k2 * ed;
                    *(LAS bf16*)(SLOT(0) + (t * OP + c) * 2) = (bf16)f2bf(kkdT[u]);
                    *(LAS bf16*)(SLOT(1) + (t * OP + c) * 2) = (bf16)f2bf(bb * em);
                    *(LAS bf16*)(SLOT(2) + (t * OP + c) * 2) = (bf16)f2bf(k2 * em);
                    *(LAS bf16*)(SLOT(3) + (t * OP + c) * 2) = (bf16)f2bf(rs[u] * __expf(ci));
                    const float rk = wave_sum(rs[u] * k2 * rkc);
                    if (lane == 0) BON[(size_t)(row0 + t) * 8 + h] = rk;
                }
                *(LAS v4u*)(SLOT(4) + (c * OP + 8 * tq) * 2) = pack8(kkdT);
                *(LAS v4u*)(SLOT(5) + (c * OP + 8 * tq) * 2) = pack8(bdT);
                *(LAS v4u*)(SLOT(6) + (c * OP + 8 * tq) * 2) = pack8(kdT);
                *(LAS v4u*)(SLOT(7) + (c * OP + 8 * tq) * 2) = pack8(vs);
                if (tq == 0) WCs[c] = __expf(all);
            }
            __syncthreads();
            f32x4 Pacc[2];
#pragma unroll
            for (int e = 0; e < 2; ++e) {
                const int tx = txb + e, x0 = 16 * tx, xs = x0 + 4 * lq; const f32x4 z = {0.f, 0.f, 0.f, 0.f};
                const bool lo = tx <= ty, up = ty <= tx;
                f32x4 v = lo ? tmm(SLOT(1), x0, SLOT(0), y0, z, lane) : z;
#pragma unroll
                for (int r = 0; r < 4; ++r) { v[r] = (xs + r < yy) ? v[r] : 0.f; Pacc[e][r] = ((xs + r == yy) ? 1.f : 0.f) - v[r]; }
                st4(SLOT(11), yy, xs, v); st4(SLOT(15), yy, xs, Pacc[e]);
                v = up ? tmm(SLOT(0), x0, SLOT(1), y0, z, lane) : z;
#pragma unroll
                for (int r = 0; r < 4; ++r) v[r] = (yy < xs + r) ? v[r] : 0.f;
                st4(SLOT(12), yy, xs, v);
                v = lo ? tmm(SLOT(2), x0, SLOT(0), y0, z, lane) : z;
#pragma unroll
                for (int r = 0; r < 4; ++r) v[r] = (xs + r < yy) ? v[r] : 0.f;
                st4(SLOT(8), yy, xs, v);
                v = lo ? tmm(SLOT(1), x0, SLOT(3), y0, z, lane) : z;
#pragma unroll
                for (int r = 0; r < 4; ++r) v[r] = (xs + r <= yy) ? v[r] : 0.f;
                st4(SLOT(9), yy, xs, v);
                v = lo ? tmm(SLOT(2), x0, SLOT(3), y0, z, lane) : z;
#pragma unroll
                for (int r = 0; r < 4; ++r) v[r] = (xs + r <= yy) ? v[r] : 0.f;
                st4(SLOT(10), yy, xs, v);
            }
            __syncthreads();
#pragma unroll
            for (int e = 0; e < 2; ++e) {
                const int tx = txb + e, x0 = 16 * tx, xs = x0 + 4 * lq; const f32x4 z = {0.f, 0.f, 0.f, 0.f};
                st4(SLOT(13), yy, xs, tx <= ty ? tmmk(SLOT(12), x0, SLOT(11), y0, z, lane, tx <= 1, ty >= 2) : z);
                st4(SLOT(14), yy, xs, ty <= tx ? tmmk(SLOT(11), x0, SLOT(12), y0, z, lane, ty <= 1, tx >= 2) : z);
                st4(SLOT(1), yy, xs, tmmk(SLOT(8), x0, SLOT(7), y0, z, lane, true, tx >= 2));
            }
            __syncthreads();
#define NEUMANN_STAGE(LT_cur, L_cur, P_cur, P_nxt, L_nxt, LT_nxt, DO_SQ, DO_SQ_L) \
            _Pragma("unroll") for (int e = 0; e < 2; ++e) { \
                const int tx = txb + e, x0 = 16 * tx, xs = x0 + 4 * lq; const f32x4 z = {0.f, 0.f, 0.f, 0.f}; \
                if (tx <= ty) Pacc[e] = tmmk(SLOT(LT_cur), x0, SLOT(P_cur), y0, Pacc[e], lane, tx <= 1, ty >= 2); \
                st4(SLOT(P_nxt), yy, xs, Pacc[e]); \
                if (DO_SQ_L) st4(SLOT(L_nxt), yy, xs, tx <= ty ? tmmk(SLOT(LT_cur), x0, SLOT(L_cur), y0, z, lane, tx <= 1, ty >= 2) : z); \
                if (DO_SQ) st4(SLOT(LT_nxt), yy, xs, ty <= tx ? tmmk(SLOT(L_cur), x0, SLOT(LT_cur), y0, z, lane, ty <= 1, tx >= 2) : z); \
            } __syncthreads();
            NEUMANN_STAGE(14, 13, 15, 16, 11, 12, true, true)
            NEUMANN_STAGE(12, 11, 16, 15, 13, 14, true, true)
            NEUMANN_STAGE(14, 13, 15, 16, 11, 12, true, true)
            NEUMANN_STAGE(12, 11, 16, 15, 13, 14, true, false)
            NEUMANN_STAGE(14, 13, 15, 16, 11, 12, false, false)
#pragma unroll
            for (int e = 0; e < 2; ++e) {
                const int tx = txb + e, x0 = 16 * tx, xs = x0 + 4 * lq; const f32x4 z = {0.f, 0.f, 0.f, 0.f};
                st4(SLOT(0), yy, xs, tmmk(SLOT(16), x0, SLOT(4), y0, z, lane, true, tx >= 2));
                f32x4 v = tmmk(SLOT(16), x0, SLOT(1), y0, z, lane, true, tx >= 2);
                st4(SLOT(2), yy, xs, -v);
            }
            __syncthreads();
#pragma unroll
            for (int e = 0; e < 2; ++e) {
                const int tx = txb + e, x0 = 16 * tx, xs = x0 + 4 * lq; const f32x4 z = {0.f, 0.f, 0.f, 0.f};
                f32x4 v = tmm(SLOT(0), x0, SLOT(5), y0, z, lane);
                const float wc = WCs[yy];
#pragma unroll
                for (int r = 0; r < 4; ++r) v[r] = ((xs + r == yy) ? wc : 0.f) - v[r];
                *(v2u*)(GF + (size_t)unit * 4096 + ((ty * 2 + (tx >> 1)) * 64 + lane) * 8 + 4 * (tx & 1)) = (v2u){pk2(v[0], v[1]), pk2(v[2], v[3])};
                v = tmm(SLOT(5), x0, SLOT(2), y0, z, lane); v = tmm(SLOT(6), x0, SLOT(7), y0, v, lane);
                *(v2u*)(HF + (size_t)unit * 4096 + ((ty * 4 + tx) * 64 + lane) * 4) = (v2u){pk2(v[0], v[1]), pk2(v[2], v[3])};
                v = tmmk(SLOT(0), x0, SLOT(9), y0, z, lane, true, ty >= 2);
                { const v2u rd = *(const LAS v2u*)(SLOT(3) + (yy * OP + xs) * 2);
                  v[0] = __uint_as_float(rd.x << 16) - v[0]; v[1] = __uint_as_float(rd.x & 0xffff0000u) - v[1]; v[2] = __uint_as_float(rd.y << 16) - v[2]; v[3] = __uint_as_float(rd.y & 0xffff0000u) - v[3]; }
                *(v2u*)(QT + (size_t)unit * 4096 + yy * 64 + xs) = (v2u){pk2(v[0], v[1]), pk2(v[2], v[3])};
                v = tmmk(SLOT(2), x0, SLOT(9), y0, z, lane, true, ty >= 2); v = tmmk(SLOT(7), x0, SLOT(10), y0, v, lane, true, ty >= 2);
                *(v2u*)(YR + (size_t)(row0 + yy) * RW + h * 64 + xs) = (v2u){pk2(v[0], v[1]), pk2(v[2], v[3])};
            }
            __syncthreads();
        }
        for (int rep_ = 0; rep_ < REP2S; ++rep_)
        for (int wu = gw; wu < S5UNITS; wu += NGW) s5_unit<false>(wu, PROJ, BRT, CRT, LAM, ka->in[24], ZB, X0B, ldsl + wave * 14592, lane);
    }
    }
    xcd_barrier(xb);
    { PHASE_PTRS
    for (int rep_ = 0; rep_ < REP3; ++rep_)
    for (int unit = blockIdx.x; unit < 48; unit += G) {
        if (unit < 32) {
            const int bh = unit;
            const bf16* gsrc = GF + (size_t)bh * NCH * 4096; const bf16* hsrc = HF + (size_t)bh * NCH * 4096;
            constexpr int DEPTH = 7;
            if (wave >= 4) {
                const int lt = tid - 256;
#define CH_ISSUE(step) do { const int st_ = (step) < NCH ? (step) : NCH - 1; const unsigned so_ = (unsigned)((step) & 7) * 16384u + (unsigned)(wave - 4) * 1024u; \
                    __builtin_amdgcn_global_load_lds((const unsigned*)(gsrc + (size_t)st_ * 4096 + lt * 8), (LAS unsigned*)(ldsl + so_), 16, 0, 0); \
                    __builtin_amdgcn_global_load_lds((const unsigned*)(gsrc + (size_t)st_ * 4096 + 2048 + lt * 8), (LAS unsigned*)(ldsl + so_ + 4096), 16, 0, 0); \
                    __builtin_amdgcn_global_load_lds((const unsigned*)(hsrc + (size_t)st_ * 4096 + lt * 8), (LAS unsigned*)(ldsl + so_ + 8192), 16, 0, 0); \
                    __builtin_amdgcn_global_load_lds((const unsigned*)(hsrc + (size_t)st_ * 4096 + 2048 + lt * 8), (LAS unsigned*)(ldsl + so_ + 12288), 16, 0, 0); } while (0)
                for (int s = 0; s < DEPTH; ++s) CH_ISSUE(s);
                for (int cidx = 0; cidx < NCH; ++cidx) {
                    asm volatile("s_waitcnt vmcnt(24)" ::: "memory");
                    __builtin_amdgcn_s_barrier();
                    CH_ISSUE(cidx + DEPTH);
                }
                asm volatile("s_waitcnt vmcnt(0)" ::: "memory");
            } else {
                const int vq = wave;
                f32x4 acc[4];
#pragma unroll
                for (int i = 0; i < 4; ++i) acc[i] = (f32x4){0.f, 0.f, 0.f, 0.f};
                for (int cidx = 0; cidx < NCH; ++cidx) {
                    __builtin_amdgcn_s_barrier();
                    const LAS unsigned char* base = ldsl + (cidx & 7) * 16384;
                    bf16x8 bfr[2];
#pragma unroll
                    for (int s = 0; s < 2; ++s) { v4u w; w.x = pk2(acc[2 * s][0], acc[2 * s][1]); w.y = pk2(acc[2 * s][2], acc[2 * s][3]); w.z = pk2(acc[2 * s + 1][0], acc[2 * s + 1][1]); w.w = pk2(acc[2 * s + 1][2], acc[2 * s + 1][3]);
                        bfr[s] = __builtin_bit_cast(bf16x8, w); }
                    f32x4 nacc[4];
#pragma unroll
                    for (int tk = 0; tk < 4; ++tk) {
                        const v2u hv = *(const LAS v2u*)(base + 8192 + ((vq * 4 + tk) * 64 + lane) * 8);
                        nacc[tk] = (f32x4){__uint_as_float(hv.x << 16), __uint_as_float(hv.x & 0xffff0000u), __uint_as_float(hv.y << 16), __uint_as_float(hv.y & 0xffff0000u)};
#pragma unroll
                        for (int s = 0; s < 2; ++s) nacc[tk] = __builtin_amdgcn_mfma_f32_16x16x32_bf16(*(const LAS bf16x8*)(base + ((tk * 2 + s) * 64 + lane) * 16), bfr[s], nacc[tk], 0, 0, 0);
                    }
#pragma unroll
                    for (int tk = 0; tk < 4; ++tk) { acc[tk] = nacc[tk];
                        *(v2u*)(S0B + ((size_t)bh * NCH + cidx) * 4096 + ((vq * 4 + tk) * 64 + lane) * 4) = (v2u){pk2(acc[tk][0], acc[tk][1]), pk2(acc[tk][2], acc[tk][3])}; }
                }
            }
            __syncthreads();
        } else {
            const int ch = (unit - 32) * 512 + tid, b = ch >> 11, gn = ch & 2047;
            const float l64r = LAM64[gn * 2], l64i = LAM64[gn * 2 + 1];
            const size_t cb = (size_t)b * NCH * 4096 + (gn >> 6) * 128 + (gn & 63);
            float xr = 0.f, xi = 0.f;
            for (int c0 = 0; c0 < NCH; c0 += 8) {
                float zr[8], zi[8];
#pragma unroll
                for (int u = 0; u < 8; ++u) { const int cc = c0 + u < NCH ? c0 + u : NCH - 1; zr[u] = ZB[cb + (size_t)cc * 4096]; zi[u] = ZB[cb + (size_t)cc * 4096 + 64]; }
#pragma unroll
                for (int u = 0; u < 8; ++u) if (c0 + u < NCH) {
                    X0B[cb + (size_t)(c0 + u) * 4096] = xr; X0B[cb + (size_t)(c0 + u) * 4096 + 64] = xi;
                    const float nxr = l64r * xr - l64i * xi + zr[u], nxi = l64r * xi + l64i * xr + zi[u]; xr = nxr; xi = nxi; }
            }
        }
    }
    if (blockIdx.x >= 48 && blockIdx.x < 56) { RWKV_C_DEFS const int munit = ((int)blockIdx.x - 48) * NCH; RWKV_C_UNIT(munit); }
    if (blockIdx.x >= 56 && blockIdx.x < 60) s5_unit<true>((((int)blockIdx.x - 56) * 8 + wave) * NCH, PROJ, BRT, CRT, LAM, ka->in[24], ZB, X0B, ldsl + wave * 14592, lane);
    }
    xcd_barrier(xb);
    { PHASE_PTRS
    {
        RWKV_C_DEFS
        for (int u4 = blockIdx.x; u4 < NB * 8 * (NCH - 1); u4 += G) { const int unit = (u4 >> 7) * NCH + (u4 & 127) + 1; RWKV_C_UNIT(unit); }
        for (int wu = gw; wu < S5UNITS; wu += NGW) if (wu % NCH != 0) s5_unit<true>(wu, PROJ, BRT, CRT, LAM, ka->in[24], ZB, X0B, ldsl + wave * 14592, lane);
        for (int n = gw; n < D; n += NGW) {
            const int d = 256 * (n >> 7) + (n & 127); const bf16* y0p = PROJ + (size_t)(NREAL + 62) * PROJW + C_U; float a0, a1, b0, b1;
            dot2b<512>(WGLU_T + (size_t)d * RW, y0p, y0p + PROJW, lane, a0, a1); dot2b<512>(WGLU_T + (size_t)(d + 128) * RW, y0p, y0p + PROJW, lane, b0, b1);
            if (lane == 0) { YBm[n] = a0 * sigm(b0); YBm[D + n] = a1 * sigm(b1); } }
    }
    }
    xcd_barrier(xb);
    { PHASE_PTRS
    { for (int n = gw; n < D; n += NGW) {
          const bf16* y0p = YR + (size_t)(NREAL + 62) * RW; float a0, a1; dot2b<512>(WBR_T + (size_t)n * RW, y0p, y0p + RW, lane, a0, a1);
          if (lane == 0) {
#pragma unroll
              for (int r = 0; r < 2; ++r) { const bf16* pg = PROJ + (size_t)(NREAL + 62 + r) * PROJW; MIXINm[r * D + n] = sigm(bf2f(pg[C_GA + n])) * (r ? a1 : a0) + sigm(bf2f(pg[C_GB + n])) * YBm[r * D + n]; } } }
      pg8::Gemm g{PROJ + C_U, WGLU_T, NREAL, 2 * D, RW, PROJW, RW}; pg8::StaticOrder S; S.init(NREAL, 2 * D, G, (int)blockIdx.x);
      pg8::EpiF<FGlu> E{{YB}};
      pg8::gemm_phase<pg8::EpiF<FGlu>, pg8::StaticOrder, true, true>(ldsl, g, S, E); }
    }
    xcd_barrier(xb);
    { PHASE_PTRS
    { for (int n = gw; n < D; n += NGW) { float a0, a1; dot2f<1024>(WOUT_T + (size_t)n * D, MIXINm, MIXINm + D, lane, a0, a1); if (lane == 0) { MIXm[n] = a0; MIXm[D + n] = a1; } }
      pg8::Gemm g{YR, WBR_T, NREAL, D, RW, RW, RW}; pg8::StaticOrder S; S.init(NREAL, D, G, (int)blockIdx.x);
      pg8::EpiF<FMixin> E{{PROJ, YB, MIXIN}};
      pg8::gemm_phase<pg8::EpiF<FMixin>, pg8::StaticOrder, true, true>(ldsl, g, S, E); }
    }
    xcd_barrier(xb);
    { PHASE_PTRS
    { if (gw < 2) {
          const float* mrw = MIXm + gw * D; const float* hsrc = meta + (size_t)(14 + gw) * D; const float* gp = ka->in[3]; const float* gf = ka->in[27];
          f32x4 m[4], hv[4]; float ss = 0.f;
#pragma unroll
          for (int jj = 0; jj < 4; ++jj) { m[jj] = ((const f32x4*)mrw)[lane + 64 * jj]; hv[jj] = ((const f32x4*)hsrc)[lane + 64 * jj]; ss += (m[jj].x * m[jj].x + m[jj].y * m[jj].y) + (m[jj].z * m[jj].z + m[jj].w * m[jj].w); }
          const float rstd = rsqrtf(wave_sum(ss) * (1.f / D) + 1e-6f); float s2 = 0.f;
#pragma unroll
          for (int jj = 0; jj < 4; ++jj) { const f32x4 g4 = ((const f32x4*)gp)[lane + 64 * jj]; hv[jj] = hv[jj] + m[jj] * rstd * g4; s2 += (hv[jj].x * hv[jj].x + hv[jj].y * hv[jj].y) + (hv[jj].z * hv[jj].z + hv[jj].w * hv[jj].w); }
          const float rstd2 = rsqrtf(wave_sum(s2) * (1.f / D) + 1e-6f);
#pragma unroll
          for (int jj = 0; jj < 4; ++jj) { const f32x4 g4 = ((const f32x4*)gf)[lane + 64 * jj]; ((f32x4*)(HN2m + gw * D))[lane + 64 * jj] = hv[jj] * rstd2 * g4; } }
      pg8::Gemm g{MIXIN, WOUT_T, NREAL, D, D, D, D}; pg8::StaticOrder S; S.init(NREAL, D, G, (int)blockIdx.x);
      pg8::EpiF<FStoreBf16> E{{MIX, D}};
      pg8::gemm_phase<pg8::EpiF<FStoreBf16>, pg8::StaticOrder, true, true>(ldsl, g, S, E); }
    }
    xcd_barrier(xb);
    { PHASE_PTRS
    {
        const float* gp = ka->in[3]; const float* gf = ka->in[27];
        for (int n = gw; n < DFF; n += NGW) { float a0, a1; dot2f<1024>(WUP_T + (size_t)n * D, HN2m, HN2m + D, lane, a0, a1);
            if (lane == 0) { UP[(size_t)(NREAL + 62) * UPW + n] = (bf16)f2bf(a0); UP[(size_t)(NREAL + 63) * UPW + n] = (bf16)f2bf(a1); } }
        for (int row = gw; row < NREAL; row += NGW) {
            const int j = 64;
            v2u* o = (v2u*)(HN2 + (size_t)row * D) + lane;
            if (j < PADR) {
#pragma unroll
                for (int jj = 0; jj < 4; ++jj) o[64 * jj] = (v2u){0u, 0u};
                continue; }
            const float* src = j < 64 ? meta + (size_t)(j - PADR) * D : x + (size_t)row * D;
            const v2u* mr = (const v2u*)(MIX + (size_t)row * D);
            f32x4 m[4], hv[4]; float ss = 0.f;
#pragma unroll
            for (int jj = 0; jj < 4; ++jj) { { const v2u q = mr[lane + 64 * jj]; m[jj] = (f32x4){__uint_as_float(q.x << 16), __uint_as_float(q.x & 0xffff0000u), __uint_as_float(q.y << 16), __uint_as_float(q.y & 0xffff0000u)}; } hv[jj] = ((const f32x4*)src)[lane + 64 * jj]; ss += (m[jj].x * m[jj].x + m[jj].y * m[jj].y) + (m[jj].z * m[jj].z + m[jj].w * m[jj].w); }
            const float rstd = rsqrtf(wave_sum(ss) * (1.f / D) + 1e-6f); float s2 = 0.f;
#pragma unroll
            for (int jj = 0; jj < 4; ++jj) { const f32x4 g4 = ((const f32x4*)gp)[lane + 64 * jj]; hv[jj] = hv[jj] + m[jj] * rstd * g4;
                s2 += (hv[jj].x * hv[jj].x + hv[jj].y * hv[jj].y) + (hv[jj].z * hv[jj].z + hv[jj].w * hv[jj].w); }
            const float rstd2 = rsqrtf(wave_sum(s2) * (1.f / D) + 1e-6f);
            if (j >= 64) { f32x4* od = (f32x4*)(ka->out + (size_t)row * D);
#pragma unroll
                for (int jj = 0; jj < 4; ++jj) od[lane + 64 * jj] = hv[jj]; }
#pragma unroll
            for (int jj = 0; jj < 4; ++jj) { const f32x4 g4 = ((const f32x4*)gf)[lane + 64 * jj];
                o[64 * jj] = (v2u){pk2(hv[jj].x * rstd2 * g4.x, hv[jj].y * rstd2 * g4.y), pk2(hv[jj].z * rstd2 * g4.z, hv[jj].w * rstd2 * g4.w)}; }
        }
    }
    }
    xcd_barrier(xb);
    { PHASE_PTRS
    { pg8::Gemm g{HN2, WUP_T, NREAL, UPW, D, D, D}; pg8::StaticOrder S; S.init(NREAL, UPW, G, (int)blockIdx.x);
      pg8::EpiF<FStoreBf16> E{{UP, UPW}};
      pg8::gemm_phase<pg8::EpiF<FStoreBf16>, pg8::StaticOrder, true, true>(ldsl, g, S, E); }
    }
    xcd_barrier(xb);
    { PHASE_PTRS
    {
        const float* cw = ka->in[30]; const float* cb = ka->in[31];
        const unsigned total = (unsigned)NREAL * (DFF / 8);
        for (unsigned idx = blockIdx.x * 512u + tid; idx < total; idx += (unsigned)G * 512u) {
            const int row = (int)(idx / (unsigned)(DFF / 8)), c = (int)(idx % (unsigned)(DFF / 8)) * 8, j = row & (SEQ - 1), mrow = NREAL + 63;
            const bf16* p = UP + (size_t)row * UPW + c;
            float a0[8], a1[8], a2[8], gt[8], o[8];
            unpack8(*(const v4u*)p, a0); unpack8(*(const v4u*)(p + DFF), gt);
            unpack8(*(const v4u*)(j >= 1 ? p - UPW : UP + (size_t)mrow * UPW + c), a1);
            unpack8(*(const v4u*)(j >= 2 ? p - 2 * UPW : UP + (size_t)(mrow - 1 + j) * UPW + c), a2);
#pragma unroll
            for (int e = 0; e < 8; ++e) { const float cv = cw[c + e] * a2[e] + cw[DFF + c + e] * a1[e] + cw[2 * DFF + c + e] * a0[e] + cb[c + e]; o[e] = gelu_t(cv) * gt[e]; }
            *(v4u*)(UP + (size_t)row * UPW + DFF + c) = pack8(o);
        }
    }
    }
    xcd_barrier(xb);
    { PHASE_PTRS
    { pg8::Gemm g{UP + DFF, WDN_T, NREAL, D, DFF, UPW, DFF}; pg8::StaticOrder S; S.init(NREAL, D, G, (int)blockIdx.x);
      pg8::EpiF<FStoreBf16> E{{FB, D}};
      pg8::gemm_phase<pg8::EpiF<FStoreBf16>, pg8::StaticOrder, true, true>(ldsl, g, S, E); }
    }
    xcd_barrier(xb);
    { PHASE_PTRS
    {
        const float* gq = ka->in[28];
        for (int r = gw; r < NB * SEQ; r += NGW) {
            const int row = r;
            const v2u* fr = (const v2u*)(FB + (size_t)row * D);
            f32x4 fv[4]; float ss = 0.f;
#pragma unroll
            for (int jj = 0; jj < 4; ++jj) { const v2u q = fr[lane + 64 * jj]; fv[jj] = (f32x4){__uint_as_float(q.x << 16), __uint_as_float(q.x & 0xffff0000u), __uint_as_float(q.y << 16), __uint_as_float(q.y & 0xffff0000u)};
                ss += (fv[jj].x * fv[jj].x + fv[jj].y * fv[jj].y) + (fv[jj].z * fv[jj].z + fv[jj].w * fv[jj].w); }
            const float rstd = rsqrtf(wave_sum(ss) * (1.f / D) + 1e-6f);
            f32x4* od = (f32x4*)(ka->out + (size_t)r * D);
#pragma unroll
            for (int jj = 0; jj < 4; ++jj) { const f32x4 g4 = ((const f32x4*)gq)[lane + 64 * jj]; od[lane + 64 * jj] = od[lane + 64 * jj] + fv[jj] * rstd * g4; }
        }
    }
    }
}

extern "C" void kernel_launch(void* const* d_in, const int* in_sizes, int n_in, void* d_out, int out_size, void* d_ws, size_t ws_size, hipStream_t stream) {
    static int grid = 0;
    if (grid == 0) {
        if (n_in != 33 || ws_size < WS_END) { fprintf(stderr, "kernel_launch: unexpected n_in %d / ws_size %zu\n", n_in, ws_size); grid = -1; return; }
        int dev = 0, cus = 0, per_cu = 0;
        (void)hipGetDevice(&dev); (void)hipDeviceGetAttribute(&cus, hipDeviceAttributeMultiprocessorCount, dev);
        (void)hipFuncSetAttribute((const void*)mega, hipFuncAttributeMaxDynamicSharedMemorySize, LDS_BYTES);
        (void)hipOccupancyMaxActiveBlocksPerMultiprocessor(&per_cu, (const void*)mega, 512, LDS_BYTES);
        if (per_cu < 1) { fprintf(stderr, "kernel_launch: occupancy query says %d blocks/CU\n", per_cu); per_cu = 1; }
        (void)hipGetLastError();
        grid = cus * per_cu;
    }
    if (grid < 0) return;
    Args a{};
    for (int i = 0; i < 33; ++i) a.in[i] = (const float*)d_in[i];
    a.out = (float*)d_out; a.ws = (unsigned char*)d_ws;
    void* args[] = {&a};
    hipError_t e = hipLaunchCooperativeKernel((const void*)mega, dim3(grid), dim3(512), args, LDS_BYTES, stream);
    if (e != hipSuccess) fprintf(stderr, "cooperative launch failed: %s (grid %d)\n", hipGetErrorString(e), grid);
}
```

```cpp
#include <hip/hip_runtime.h>
#include <hip/hip_cooperative_groups.h>
#include <cstdio>
#include <cstdint>
namespace cg = cooperative_groups;
#ifndef REPG
#define REPG 1
#endif
namespace pg8 {
#define PG8_LAS __attribute__((address_space(3)))
typedef unsigned short bf16_t;
typedef short bf16x8 __attribute__((ext_vector_type(8)));
typedef float f32x4 __attribute__((ext_vector_type(4)));
typedef unsigned u32x4 __attribute__((ext_vector_type(4)));
constexpr int BM = 256, BK = 64, HALF = 128, HTB = HALF * BK * 2  , STAGE_BYTES = 8 * HTB, NXCD = 8, WGM = 8;

__host__ __device__ __forceinline__ int lds_byte(int r, int c) { const int st = (r >> 4) * 2 + (c >> 5), rr = r & 15, cc = c & 31, ob = rr * 64 + cc * 2; return st * 1024 + (ob ^ (((ob >> 9) & 1) << 5)); }
__host__ __device__ __forceinline__ void stage_rc(int b, int& R, int& C) { const int st = b / 1024, sb = b % 1024, swz = sb ^ (((sb >> 9) & 1) << 5); R = (st >> 1) * 16 + swz / 64; C = (st & 1) * 32 + (swz % 64) / 2; }
__host__ __device__ __forceinline__ int perm32(int rho) { const int n = rho >> 4, i = rho & 15; return 8 * (i >> 2) + 4 * n + (i & 3); }

struct Unit { int pm, pn; };
struct Gemm { const bf16_t* A; const bf16_t* Bt; int M, N, K, lda, ldb; };

struct StaticOrder {
    int nM, nN, nwg, G, c;
    __host__ __device__ void init(int M, int N, int G_, int c_) { nM = M / BM; nN = N / BM; nwg = nM * nN; G = G_; c = c_; }
    __host__ __device__ bool next(int i, Unit& u) const {
        const long L = (long)i * G + c; if (L >= (long)nwg * REPG) return false;
        int wgid = (int)(L % nwg); { const int q = nwg / NXCD, r = nwg % NXCD, xcd = wgid % NXCD, off = wgid / NXCD; wgid = (xcd < r ? xcd * (q + 1) : r * (q + 1) + (xcd - r) * q) + off; }
        const int nig = WGM * nN, gid = wgid / nig, fm = gid * WGM, gsz = (nM - fm) < WGM ? (nM - fm) : WGM;
        u.pm = fm + ((wgid % nig) % gsz); u.pn = (wgid % nig) / gsz; return true;
    }
    __device__ __forceinline__ void a_ready(const Unit&) const {}
    __device__ __forceinline__ void done(const Unit&) const {}
};


template <class F> struct EpiF {
    static constexpr bool PERM = true, AFTER_DRAIN = false; F f;
    __device__ __forceinline__ void operator()(const f32x4 (&acc)[2][2][4][2], const Unit& u, int wr, int wc, int fr, int fq) const {
        const int cw = wc * 32 + 8 * fq;
#pragma unroll
        for (int ai = 0; ai < 2; ++ai)
#pragma unroll
            for (int m = 0; m < 4; ++m) {
                const int row = u.pm * BM + ai * HALF + wr * 64 + m * 16 + fr;
                f(row, u.pn, cw, acc[ai][0][m][0], acc[ai][0][m][1], acc[ai][1][m][0], acc[ai][1][m][1]);
            }
    }
};
template <class Epi, class Sched, bool ALIGN_EPI = false, bool SP2 = false>
__device__ __forceinline__ void gemm_phase(PG8_LAS unsigned char* lds, const Gemm g, const Sched& S, const Epi& E) {
    const int tid = threadIdx.x, wid = __builtin_amdgcn_readfirstlane(tid >> 6), lane = tid & 63, wr = wid >> 2, wc = wid & 3, fr = lane & 15, fq = lane >> 4;
    const int K = g.K, nt = K / BK;
    unsigned voffA[2], voffB[2];
#pragma unroll
    for (int i = 0; i < 2; ++i) { int R, C; stage_rc(tid * 16 + i * 8192, R, C); const int Rb = Epi::PERM ? ((R & ~31) + perm32(R & 31)) : R;
        voffA[i] = (unsigned)(R * g.lda + C) * 2u; voffB[i] = (unsigned)(Rb * g.ldb + C) * 2u; }
    const size_t kstep = (size_t)(BK * 2);
    const size_t hstepA = (size_t)HALF * g.lda * 2, hstepB = (size_t)HALF * g.ldb * 2;
    const size_t tstepA = 2 * hstepA, tstepB = 2 * hstepB;
    const unsigned ldsw = (unsigned)wid * 1024u;
    const int aoff = lds_byte(wr * 64 + fr, fq * 8), boff = lds_byte(wc * 32 + fr, fq * 8);
#define PG8_SA(b, h) (((b) * 2 + (h)) * HTB)
#define PG8_SB(b, h) ((4 + (b) * 2 + (h)) * HTB)
#define PG8_STAGE(bufoff, gbase, voff) do { _Pragma("unroll") for (int _i = 0; _i < 2; ++_i) \
        __builtin_amdgcn_global_load_lds((const unsigned*)((const char*)(gbase) + (voff)[_i]), (PG8_LAS unsigned*)(lds + (bufoff) + ldsw + _i * 8192), 16, 0, 0); } while (0)
#define PG8_LDA(dst, b, h) do { _Pragma("unroll") for (int m = 0; m < 4; ++m) _Pragma("unroll") for (int k = 0; k < 2; ++k) dst[m][k] = *(const PG8_LAS bf16x8*)(lds + PG8_SA(b, h) + aoff + m * 2048 + k * 1024); } while (0)
#define PG8_LDB(dst, b, h) do { _Pragma("unroll") for (int n = 0; n < 2; ++n) _Pragma("unroll") for (int k = 0; k < 2; ++k) dst[n][k] = *(const PG8_LAS bf16x8*)(lds + PG8_SB(b, h) + boff + n * 2048 + k * 1024); } while (0)
#define PG8_MMA(ai, bj, At, Bt) do { __builtin_amdgcn_s_setprio(1); _Pragma("unroll") for (int m = 0; m < 4; ++m) _Pragma("unroll") for (int n = 0; n < 2; ++n) _Pragma("unroll") for (int k = 0; k < 2; ++k) \
        acc[ai][bj][m][n] = __builtin_amdgcn_mfma_f32_16x16x32_bf16(Bt[n][k], At[m][k], acc[ai][bj][m][n], 0, 0, 0); __builtin_amdgcn_s_setprio(0); } while (0)
#define PG8_WAIT_V(n) asm volatile("s_waitcnt vmcnt(" #n ")" ::: "memory")
#define PG8_WAIT_L(n) asm volatile("s_waitcnt lgkmcnt(" #n ")" ::: "memory")
#define PG8_BAR __builtin_amdgcn_s_barrier()
#define PG8_SCHED __builtin_amdgcn_sched_barrier(0)
    Unit cur, nxt; int ui = 0;
    if (!S.next(0, cur)) return;
    f32x4 acc[2][2][4][2];
#pragma unroll
    for (int a = 0; a < 2; ++a)
#pragma unroll
        for (int b = 0; b < 2; ++b)
#pragma unroll
            for (int m = 0; m < 4; ++m)
#pragma unroll
                for (int n = 0; n < 2; ++n) acc[a][b][m][n] = (f32x4){0.f, 0.f, 0.f, 0.f};
    bf16x8 At[4][2], B0[2][2], B1[2][2];
    const char* cA = (const char*)g.A + (size_t)cur.pm * tstepA; const char* cB = (const char*)g.Bt + (size_t)cur.pn * tstepB;
    S.a_ready(cur);
    if constexpr (SP2) {
        PG8_STAGE(PG8_SB(0, 0), cB, voffB); PG8_STAGE(PG8_SB(0, 1), cB + hstepB, voffB); PG8_STAGE(PG8_SA(0, 0), cA, voffA); PG8_STAGE(PG8_SA(0, 1), cA + hstepA, voffA);
        if (wr == 1) PG8_BAR;
        PG8_WAIT_V(2); PG8_BAR;
        PG8_STAGE(PG8_SB(1, 0), cB + kstep, voffB); PG8_STAGE(PG8_SA(1, 0), cA + kstep, voffA); PG8_STAGE(PG8_SB(1, 1), cB + hstepB + kstep, voffB);
        PG8_WAIT_V(6); PG8_BAR;
    } else {
        PG8_STAGE(PG8_SB(0, 0), cB, voffB); PG8_STAGE(PG8_SA(0, 0), cA, voffA); PG8_STAGE(PG8_SB(0, 1), cB + hstepB, voffB); PG8_STAGE(PG8_SA(0, 1), cA + hstepA, voffA);
        if (wr == 1) PG8_BAR;
        PG8_WAIT_V(4); PG8_BAR;
        PG8_STAGE(PG8_SB(1, 0), cB + kstep, voffB); PG8_STAGE(PG8_SA(1, 0), cA + kstep, voffA); PG8_STAGE(PG8_SB(1, 1), cB + hstepB + kstep, voffB);
        PG8_WAIT_V(6); PG8_BAR;
    }
    for (;;) {
        const bool has_next = S.next(ui + 1, nxt);
        const char* nA = has_next ? (const char*)g.A + (size_t)nxt.pm * tstepA : cA; const char* nB = has_next ? (const char*)g.Bt + (size_t)nxt.pn * tstepB : cB;
        for (int t = 0; t < nt; t += 2) {
            const bool last = (t == nt - 2);
            const char* a1 = cA + (size_t)(t + 1) * kstep;
            const char* a2 = last ? nA : cA + (size_t)(t + 2) * kstep; const char* b2 = last ? nB : cB + (size_t)(t + 2) * kstep;
            const char* a3 = a2 + kstep; const char* b3 = b2 + kstep;
            if (last && has_next) S.a_ready(nxt);
            if constexpr (SP2) {
            PG8_LDB(B0, 0, 0); PG8_LDB(B1, 0, 1); PG8_SCHED; PG8_LDA(At, 0, 0); PG8_STAGE(PG8_SA(1, 1), a1 + hstepA, voffA);
            PG8_WAIT_V(8); PG8_WAIT_L(0); PG8_BAR; PG8_MMA(0, 0, At, B0); PG8_MMA(0, 1, At, B1); PG8_BAR; PG8_SCHED;
            PG8_LDA(At, 0, 1); PG8_STAGE(PG8_SB(0, 0), b2, voffB); PG8_STAGE(PG8_SB(0, 1), b2 + hstepB, voffB); PG8_STAGE(PG8_SA(0, 0), a2, voffA);
            PG8_WAIT_V(8); PG8_WAIT_L(0); PG8_BAR; PG8_MMA(1, 0, At, B0); PG8_MMA(1, 1, At, B1); PG8_BAR; PG8_SCHED;
            PG8_LDB(B0, 1, 0); PG8_LDB(B1, 1, 1); PG8_SCHED; PG8_LDA(At, 1, 0); PG8_STAGE(PG8_SA(0, 1), a2 + hstepA, voffA);
            PG8_WAIT_V(8); PG8_WAIT_L(0); PG8_BAR; PG8_MMA(0, 0, At, B0); PG8_MMA(0, 1, At, B1); PG8_BAR; PG8_SCHED;
            PG8_LDA(At, 1, 1); PG8_STAGE(PG8_SB(1, 0), b3, voffB); PG8_STAGE(PG8_SB(1, 1), b3 + hstepB, voffB); PG8_STAGE(PG8_SA(1, 0), a3, voffA);
            PG8_WAIT_V(8); PG8_WAIT_L(0); PG8_BAR; PG8_MMA(1, 0, At, B0); PG8_MMA(1, 1, At, B1); PG8_BAR; PG8_SCHED;
            } else {
            PG8_LDB(B0, 0, 0); PG8_SCHED; PG8_LDA(At, 0, 0); PG8_STAGE(PG8_SA(1, 1), a1 + hstepA, voffA);
            PG8_WAIT_L(8); PG8_BAR; PG8_WAIT_L(0); PG8_MMA(0, 0, At, B0); PG8_BAR; PG8_SCHED;
            PG8_LDB(B1, 0, 1); PG8_STAGE(PG8_SB(0, 0), b2, voffB);
            PG8_BAR; PG8_WAIT_L(0); PG8_MMA(0, 1, At, B1); PG8_BAR;
            PG8_LDA(At, 0, 1); PG8_STAGE(PG8_SA(0, 0), a2, voffA);
            PG8_BAR; PG8_WAIT_L(0); PG8_MMA(1, 0, At, B0); PG8_BAR; PG8_SCHED;
            PG8_STAGE(PG8_SB(0, 1), b2 + hstepB, voffB);
            PG8_WAIT_V(6); PG8_BAR; PG8_MMA(1, 1, At, B1); PG8_BAR;
            PG8_LDB(B0, 1, 0); PG8_SCHED; PG8_LDA(At, 1, 0); PG8_STAGE(PG8_SA(0, 1), a2 + hstepA, voffA);
            PG8_WAIT_L(8); PG8_BAR; PG8_WAIT_L(0); PG8_MMA(0, 0, At, B0); PG8_BAR; PG8_SCHED;
            PG8_LDB(B1, 1, 1); PG8_STAGE(PG8_SB(1, 0), b3, voffB);
            PG8_BAR; PG8_WAIT_L(0); PG8_MMA(0, 1, At, B1); PG8_BAR;
            PG8_LDA(At, 1, 1); PG8_STAGE(PG8_SA(1, 0), a3, voffA);
            PG8_BAR; PG8_WAIT_L(0); PG8_MMA(1, 0, At, B0); PG8_BAR; PG8_SCHED;
            PG8_STAGE(PG8_SB(1, 1), b3 + hstepB, voffB);
            PG8_WAIT_V(6); PG8_BAR; PG8_MMA(1, 1, At, B1); PG8_BAR;
            }
        }
        if constexpr (ALIGN_EPI) { if (wr == 0) PG8_BAR; }
        if constexpr (!Epi::AFTER_DRAIN) { E(acc, cur, wr, wc, fr, fq); S.done(cur); }
        if (!has_next) break;
#pragma unroll
        for (int a = 0; a < 2; ++a)
#pragma unroll
            for (int b = 0; b < 2; ++b)
#pragma unroll
                for (int m = 0; m < 4; ++m)
#pragma unroll
                    for (int n = 0; n < 2; ++n) acc[a][b][m][n] = (f32x4){0.f, 0.f, 0.f, 0.f};
        cur = nxt; cA = nA; cB = nB; ++ui;
        if constexpr (ALIGN_EPI) { if (wr == 1) PG8_BAR; }
    }
    PG8_WAIT_V(0);
    if constexpr (!ALIGN_EPI) { if (wr == 0) PG8_BAR; }
    PG8_BAR;
    if constexpr (Epi::AFTER_DRAIN) { E.fused(acc, cur, wr, wc, fr, fq, lds, wid, lane); S.done(cur); }
#undef PG8_SA
#undef PG8_SB
#undef PG8_STAGE
#undef PG8_LDA
#undef PG8_LDB
#undef PG8_MMA
#undef PG8_WAIT_V
#undef PG8_WAIT_L
#undef PG8_BAR
#undef PG8_SCHED
}
}

#ifndef REP0
#define REP0 1
#endif
#ifndef REP3
#define REP3 1
#endif
#ifndef REP8
#define REP8 1
#endif
#ifndef REP4
#define REP4 1
#endif
#ifndef REP4S
#define REP4S 1
#endif
#ifndef REP2
#define REP2 1
#endif
#ifndef REP2S
#define REP2S 1
#endif
#define LAS __attribute__((address_space(3)))
typedef unsigned short bf16;
typedef float f32x4 __attribute__((ext_vector_type(4)));
typedef unsigned v4u __attribute__((ext_vector_type(4)));
typedef unsigned v2u __attribute__((ext_vector_type(2)));

constexpr int NB = 4, SEQ = 8192, D = 1024, PADR = 48, NREAL = NB * SEQ, MP = NREAL + NB * 64;
__device__ __forceinline__ int chunk_row0(int b, int c0) { return c0 == 0 ? NREAL + 64 * b : b * SEQ + 64 * (c0 - 1); }
constexpr int RW = 512, PROJW = 4352, DFF = 2816, UPW = 2 * DFF;
constexpr int C_K = 512, C_V = 1024, C_WD = 1536, C_AD = 1600, C_GD = 1664, C_U = 1792, C_GA = 2304, C_GB = 3328;
constexpr size_t QB = (size_t)MP * 512 * 2;
constexpr size_t WO_WIN = 1u << 20, WO_WBR = WO_WIN + (size_t)PROJW * D * 2, WO_WGLU = WO_WBR + (size_t)D * RW * 2, WO_WOUT = WO_WGLU + (size_t)2 * D * RW * 2,
                 WO_WUP = WO_WOUT + (size_t)D * D * 2, WO_WDN = WO_WUP + (size_t)UPW * D * 2, WO_END = WO_WDN + (size_t)D * DFF * 2;
static_assert(WO_END <= QB, "weights fit in the first quantum");
constexpr size_t WO_WUPT = WO_END, WO_AUPT = WO_WUPT + 65536, WO_GUPT = WO_AUPT + 65536, WO_END2 = WO_GUPT + 131072;
static_assert(WO_END2 <= QB, "small tables fit in the first quantum");
constexpr size_t WS_HN = QB, WS_GF = QB, WS_HF = 2 * QB, WS_PROJ = 3 * QB, WS_YR = 11 * QB + QB / 2, WS_QT = WS_YR + QB, WS_YB = WS_QT + QB, WS_BON = WS_YB + 2 * QB, WS_END = WS_BON + (size_t)MP * 8 * 4;
constexpr size_t WS_MIXIN = QB, WS_MIX = WS_YR, WS_HN2 = QB, WS_UP = 3 * QB, WS_F = QB;
constexpr int NCH = 129, NUNIT = NB * 8 * NCH, S5UNITS = NB * 32 * NCH;
constexpr size_t WO_BRT = WO_END2, WO_CRT = WO_BRT + 131072, WO_LAM = WO_CRT + 131072, WO_LAM64 = WO_LAM + 16384, WO_END3 = WO_LAM64 + 16384;
static_assert(WO_END3 <= QB, "S5 tables fit in the first quantum");
constexpr size_t WS_Z = WS_YB, WS_X0 = WS_Z + (size_t)NB * NCH * 4096 * 4, WS_S0 = WS_X0 + (size_t)NB * NCH * 4096 * 4;
static_assert(WS_S0 + QB <= WS_YB + 2 * QB, "S0 fits in the YB region");
static_assert(WS_END <= 536870912ull, "workspace");
constexpr int OP = 72, OPB = 64 * OP * 2, MISC_OFF = 17 * OPB;
constexpr int LDS_BYTES = 159744, XB_LDS_OFF = 159488;
typedef short bf16x8 __attribute__((ext_vector_type(8)));

__device__ __forceinline__ float bf2f(unsigned h) { return __uint_as_float(h << 16); }
typedef float f32x2_t __attribute__((ext_vector_type(2))); typedef __bf16 bf16x2_t __attribute__((ext_vector_type(2)));
__device__ __forceinline__ unsigned pk2(float lo, float hi) { const f32x2_t v = {lo, hi}; const bf16x2_t b = __builtin_convertvector(v, bf16x2_t); return __builtin_bit_cast(unsigned, b); }
__device__ __forceinline__ unsigned f2bf(float f) { return pk2(f, 0.f) & 0xffffu; }
__device__ __forceinline__ void unpack8(const v4u q, float (&o)[8]) {
    o[0] = __uint_as_float(q.x << 16); o[1] = __uint_as_float(q.x & 0xffff0000u); o[2] = __uint_as_float(q.y << 16); o[3] = __uint_as_float(q.y & 0xffff0000u);
    o[4] = __uint_as_float(q.z << 16); o[5] = __uint_as_float(q.z & 0xffff0000u); o[6] = __uint_as_float(q.w << 16); o[7] = __uint_as_float(q.w & 0xffff0000u);
}
__device__ __forceinline__ v4u pack8(const float (&o)[8]) { v4u w; w.x = pk2(o[0], o[1]); w.y = pk2(o[2], o[3]); w.z = pk2(o[4], o[5]); w.w = pk2(o[6], o[7]); return w; }
template <int CTRL> __device__ __forceinline__ float dppf(float v) { return __int_as_float(__builtin_amdgcn_update_dpp(0, __float_as_int(v), CTRL, 0xf, 0xf, true)); }
__device__ __forceinline__ float wave_sum(float v) {
    v += dppf<0xB1>(v); v += dppf<0x4E>(v); v += dppf<0x141>(v); v += dppf<0x140>(v);
    const int iv = __float_as_int(v);
    return (__int_as_float(__builtin_amdgcn_readlane(iv, 0)) + __int_as_float(__builtin_amdgcn_readlane(iv, 16))) + (__int_as_float(__builtin_amdgcn_readlane(iv, 32)) + __int_as_float(__builtin_amdgcn_readlane(iv, 48)));
}
__device__ __forceinline__ float tanh_fast(float x) { return 1.f - 2.f / (__expf(2.f * x) + 1.f); }
__device__ __forceinline__ float sigm(float x) { return 1.f / (1.f + __expf(-x)); }
__device__ __forceinline__ float gelu_t(float x) { const float z = 0.7978845608f * (x + 0.044715f * x * x * x); const float t = 1.f - 2.f / (__expf(2.f * z) + 1.f); return 0.5f * x * (1.f + t); }

#define SLOT(i) (ldsl + (i) * OPB)
__device__ __forceinline__ bf16x8 ldfrag(const LAS unsigned char* buf, int r0, int ks, int lane) { return *(const LAS bf16x8*)(buf + ((r0 + (lane & 15)) * OP + 32 * ks + 8 * (lane >> 4)) * 2); }
__device__ __forceinline__ f32x4 tmm(const LAS unsigned char* X, int x0, const LAS unsigned char* Y, int y0, f32x4 acc, int lane) {
#pragma unroll
    for (int ks = 0; ks < 2; ++ks) acc = __builtin_amdgcn_mfma_f32_16x16x32_bf16(ldfrag(X, x0, ks, lane), ldfrag(Y, y0, ks, lane), acc, 0, 0, 0);
    return acc; }
__device__ __forceinline__ f32x4 tmmk(const LAS unsigned char* X, int x0, const LAS unsigned char* Y, int y0, f32x4 acc, int lane, bool k0, bool k1) {
    if (k0) acc = __builtin_amdgcn_mfma_f32_16x16x32_bf16(ldfrag(X, x0, 0, lane), ldfrag(Y, y0, 0, lane), acc, 0, 0, 0);
    if (k1) acc = __builtin_amdgcn_mfma_f32_16x16x32_bf16(ldfrag(X, x0, 1, lane), ldfrag(Y, y0, 1, lane), acc, 0, 0, 0);
    return acc; }
struct RawA { unsigned r[9], k[9], v[9], w[9], a[9]; };
__device__ __forceinline__ void a0_load(RawA& R, const unsigned short* PROJ, int unit, int tq, int c) {
    const int c0 = unit % 129, bh = unit / 129, b = bh >> 3, h = bh & 7, hc = h * 64 + c;
    const int row0 = c0 == 0 ? 32768 + 64 * b : b * 8192 + 64 * (c0 - 1), prow = (c0 == 1) ? 32768 + 64 * b + 63 : row0 - 1;
#pragma unroll
    for (int i = 0; i < 9; ++i) {
        const int rr_ = 8 * tq + i - 1; const bool valid = (c0 > 0) || (rr_ >= 0);
        const unsigned short* p = PROJ + (size_t)(rr_ >= 0 ? row0 + rr_ : (valid ? prow : row0)) * 4352;
        R.r[i] = valid ? p[hc] : 0u; R.k[i] = valid ? p[512 + hc] : 0u; R.v[i] = valid ? p[1024 + hc] : 0u; R.w[i] = valid ? p[1536 + c] : 0u; R.a[i] = valid ? p[1600 + c] : 0u;
    }
}
__device__ __forceinline__ void st4(LAS unsigned char* buf, int y, int x, f32x4 v) { *(LAS v2u*)(buf + (y * OP + x) * 2) = (v2u){pk2(v[0], v[1]), pk2(v[2], v[3])}; }
struct FStoreBf16 { bf16* O; int ldc;
    __device__ __forceinline__ void operator()(int row, int pn, int cw, f32x4 a00, f32x4 a01, f32x4 a10, f32x4 a11) const {
        bf16* p = O + (size_t)row * ldc + pn * 256 + cw;
        v4u w; w.x = pk2(a00[0], a00[1]); w.y = pk2(a00[2], a00[3]); w.z = pk2(a01[0], a01[1]); w.w = pk2(a01[2], a01[3]); *(v4u*)p = w;
        w.x = pk2(a10[0], a10[1]); w.y = pk2(a10[2], a10[3]); w.z = pk2(a11[0], a11[1]); w.w = pk2(a11[2], a11[3]); *(v4u*)(p + 128) = w; } };
struct FStoreF32 { float* O; int ldc;
    __device__ __forceinline__ void operator()(int row, int pn, int cw, f32x4 a00, f32x4 a01, f32x4 a10, f32x4 a11) const {
        float* p = O + (size_t)row * ldc + pn * 256 + cw;
        *(f32x4*)p = a00; *(f32x4*)(p + 4) = a01; *(f32x4*)(p + 128) = a10; *(f32x4*)(p + 132) = a11; } };
struct FGlu { bf16* YB;
    __device__ __forceinline__ void operator()(int row, int pn, int cw, f32x4 a00, f32x4 a01, f32x4 a10, f32x4 a11) const {
        float y[8];
#pragma unroll
        for (int e = 0; e < 4; ++e) { y[e] = a00[e] * sigm(a10[e]); y[4 + e] = a01[e] * sigm(a11[e]); }
        *(v4u*)(YB + (size_t)row * D + pn * 128 + cw) = pack8(y); } };
struct FMixin { const bf16* PROJ; const bf16* YB; bf16* MIXIN;
    __device__ __forceinline__ void one(int row, int col, f32x4 a0, f32x4 a1) const {
        float ga[8], gb[8], yb[8], o[8];
        unpack8(*(const v4u*)(PROJ + (size_t)row * PROJW + C_GA + col), ga); unpack8(*(const v4u*)(PROJ + (size_t)row * PROJW + C_GB + col), gb);
        unpack8(*(const v4u*)(YB + (size_t)row * D + col), yb);
#pragma unroll
        for (int e = 0; e < 4; ++e) { o[e] = sigm(ga[e]) * a0[e] + sigm(gb[e]) * yb[e]; o[4 + e] = sigm(ga[4 + e]) * a1[e] + sigm(gb[4 + e]) * yb[4 + e]; }
        *(v4u*)(MIXIN + (size_t)row * D + col) = pack8(o); }
    __device__ __forceinline__ void operator()(int row, int pn, int cw, f32x4 a00, f32x4 a01, f32x4 a10, f32x4 a11) const {
        one(row, pn * 256 + cw, a00, a01); one(row, pn * 256 + 128 + cw, a10, a11); } };

template <bool OUT> __device__ __forceinline__ void s5_unit(int id, bf16* PROJ, const bf16* BRT, const bf16* CRT, const float* LAM, const float* dvec, float* Z, const float* X0, LAS unsigned char* wl, int lane) {
    const int b = id / (32 * NCH), rem = id % (32 * NCH), g = rem / NCH, c0 = rem % NCH, row0 = chunk_row0(b, c0), lj = lane & 15, lq = lane >> 4, n = lane;
    LAS float* BU = (LAS float*)wl; LAS unsigned char* Xs = wl + 10240;
    const bf16x8 zf = {0, 0, 0, 0, 0, 0, 0, 0};
    bf16x8 bfrag[8];
#pragma unroll
    for (int nt = 0; nt < 8; ++nt) bfrag[nt] = lq < 2 ? *(const bf16x8*)(BRT + ((size_t)(g * 128 + 16 * nt + lj) * 16 + 8 * lq)) : zf;
    bf16x8 cfrag[4]; float dd[4];
    if (OUT) {
#pragma unroll
        for (int ks = 0; ks < 4; ++ks) cfrag[ks] = *(const bf16x8*)(CRT + ((size_t)(g * 16 + lj) * 128 + 32 * ks + 8 * lq));
#pragma unroll
        for (int r = 0; r < 4; ++r) dd[r] = dvec[g * 16 + 4 * lq + r];
    }
    const float lr = LAM[(g * 64 + n) * 2], li = LAM[(g * 64 + n) * 2 + 1];
    const size_t zi = ((size_t)(b * NCH + c0)) * 4096 + g * 128 + n;
    float xr = 0.f, xi = 0.f;
    if (OUT && c0 > 0) { xr = X0[zi]; xi = X0[zi + 64]; }
    bf16* up0 = PROJ + (size_t)(row0 + lj) * PROJW + C_U + g * 16;
    bf16x8 ufn = lq < 2 ? *(const bf16x8*)(up0 + 8 * lq) : zf; v2u u4n = {0u, 0u}; if (OUT) u4n = *(const v2u*)(up0 + 4 * lq);
#pragma unroll 1
    for (int rd = 0; rd < 4; ++rd) { const bool lastrep = true;
        bf16* up = PROJ + (size_t)(row0 + 16 * rd + lj) * PROJW + C_U + g * 16;
        const bf16x8 ufrag = ufn; const v2u u4 = u4n;
        if (rd < 3) { const bf16* upn = up + (size_t)16 * PROJW; ufn = lq < 2 ? *(const bf16x8*)(upn + 8 * lq) : zf; if (OUT) u4n = *(const v2u*)(upn + 4 * lq); }
#pragma unroll
        for (int nt = 0; nt < 8; ++nt) { const f32x4 d = __builtin_amdgcn_mfma_f32_16x16x32_bf16(ufrag, bfrag[nt], (f32x4){0.f, 0.f, 0.f, 0.f}, 0, 0, 0);
            *(LAS f32x4*)(BU + (16 * nt + lj) * 20 + 4 * lq) = d; }
        asm volatile("s_waitcnt lgkmcnt(0)" ::: "memory");
#pragma unroll
        for (int t4 = 0; t4 < 4; ++t4) {
            const f32x4 br = *(const LAS f32x4*)(BU + n * 20 + 4 * t4), bi = *(const LAS f32x4*)(BU + (64 + n) * 20 + 4 * t4);
#pragma unroll
            for (int r = 0; r < 4; ++r) {
                const float nxr = lr * xr - li * xi + br[r], nxi = lr * xi + li * xr + bi[r]; xr = nxr; xi = nxi;
                if (OUT) { *(LAS bf16*)(Xs + ((4 * t4 + r) * 136 + n) * 2) = (bf16)f2bf(xr); *(LAS bf16*)(Xs + ((4 * t4 + r) * 136 + 64 + n) * 2) = (bf16)f2bf(xi); }
            }
        }
        if (OUT) {
            asm volatile("s_waitcnt lgkmcnt(0)" ::: "memory");
            f32x4 y = {0.f, 0.f, 0.f, 0.f};
#pragma unroll
            for (int ks = 0; ks < 4; ++ks) y = __builtin_amdgcn_mfma_f32_16x16x32_bf16(cfrag[ks], *(const LAS bf16x8*)(Xs + (lj * 136 + 32 * ks + 8 * lq) * 2), y, 0, 0, 0);
            const float u0 = __uint_as_float(u4.x << 16), u1 = __uint_as_float(u4.x & 0xffff0000u), u2 = __uint_as_float(u4.y << 16), u3 = __uint_as_float(u4.y & 0xffff0000u);
            if (lastrep) *(v2u*)(up + 4 * lq) = (v2u){pk2(gelu_t(y[0] + dd[0] * u0), gelu_t(y[1] + dd[1] * u1)), pk2(gelu_t(y[2] + dd[2] * u2), gelu_t(y[3] + dd[3] * u3))};
        }
        asm volatile("s_waitcnt lgkmcnt(0)" ::: "memory");
    }
    if (!OUT) { Z[zi] = xr; Z[zi + 64] = xi; }
}

template <int K> __device__ __forceinline__ void dot2b(const bf16* wrow, const bf16* a0, const bf16* a1, int lane, float& s0, float& s1) {
    float p0 = 0.f, p1 = 0.f;
#pragma unroll
    for (int kk = 0; kk < K / 512; ++kk) { float wf[8], x0[8], x1[8]; unpack8(*(const v4u*)(wrow + kk * 512 + lane * 8), wf); unpack8(*(const v4u*)(a0 + kk * 512 + lane * 8), x0); unpack8(*(const v4u*)(a1 + kk * 512 + lane * 8), x1);
#pragma unroll
        for (int e = 0; e < 8; ++e) { p0 += wf[e] * x0[e]; p1 += wf[e] * x1[e]; } }
    s0 = wave_sum(p0); s1 = wave_sum(p1);
}
template <int K> __device__ __forceinline__ void dot2f(const bf16* wrow, const float* a0, const float* a1, int lane, float& s0, float& s1) {
    float p0 = 0.f, p1 = 0.f;
#pragma unroll
    for (int kk = 0; kk < K / 512; ++kk) { float wf[8]; unpack8(*(const v4u*)(wrow + kk * 512 + lane * 8), wf);
        const f32x4 xa = *(const f32x4*)(a0 + kk * 512 + lane * 8), xb = *(const f32x4*)(a0 + kk * 512 + lane * 8 + 4), ya = *(const f32x4*)(a1 + kk * 512 + lane * 8), yb = *(const f32x4*)(a1 + kk * 512 + lane * 8 + 4);
#pragma unroll
        for (int e = 0; e < 4; ++e) { p0 += wf[e] * xa[e] + wf[4 + e] * xb[e]; p1 += wf[e] * ya[e] + wf[4 + e] * yb[e]; } }
    s0 = wave_sum(p0); s1 = wave_sum(p1);
}

struct Args { const float* in[33]; float* out; unsigned char* ws; };

__device__ __forceinline__ void transpose_item(const float* W, int K, int N, bf16* WT, int glu, float* scr, int item, int lane) {
    const int nblk = N / 32, kb = item / nblk, nb = item % nblk, k0 = 64 * kb, n0 = 32 * nb;
#pragma unroll 8
    for (int i = 0; i < 32; ++i) { const int kk = 2 * i + (lane >> 5); scr[kk * 33 + (lane & 31)] = W[(size_t)(k0 + kk) * N + n0 + (lane & 31)]; }
    asm volatile("s_waitcnt lgkmcnt(0)" ::: "memory");
    int d0 = n0; if (glu) { const int bj = n0 / 1024, rem = n0 % 1024; d0 = 256 * (rem / 128) + 128 * bj + (rem % 128); }
    const int c = lane & 7;
#pragma unroll
    for (int j = 0; j < 4; ++j) { const int n = (lane >> 3) + 8 * j; const float* s = scr + (8 * c) * 33 + n;
        v4u o; o.x = pk2(s[0 * 33], s[1 * 33]); o.y = pk2(s[2 * 33], s[3 * 33]); o.z = pk2(s[4 * 33], s[5 * 33]); o.w = pk2(s[6 * 33], s[7 * 33]);
        *(v4u*)(WT + (size_t)(d0 + n) * K + k0 + 8 * c) = o; }
    asm volatile("s_waitcnt lgkmcnt(0)" ::: "memory");
}

__device__ __forceinline__ float shiftv(const bf16* PROJ, int row, int j, int col, float mu) {
    const float cur = bf2f(PROJ[(size_t)row * PROJW + col]); const float prev = j > 0 ? bf2f(PROJ[(size_t)(row - 1) * PROJW + col]) : 0.f;
    return cur + (prev - cur) * mu;
}

#define XB_TMO      128
#define XB_XCNT(j)  (256  + 64 * (j))
#define XB_XSUB(j)  (1280 + 64 * (j))
#define XB_XGEN(j)  (2304 + 64 * (j))
#define XB_TOP      3328
#define XB_TOPGEN   3392
#define XCD_BAR_WORDS 3456
#define XB_SPIN_CAP (1u << 18)

__device__ __forceinline__ unsigned xb_ld(unsigned* p)              { return __hip_atomic_load(p, __ATOMIC_RELAXED, __HIP_MEMORY_SCOPE_AGENT); }
__device__ __forceinline__ unsigned xb_add(unsigned* p, unsigned v) { return __hip_atomic_fetch_add(p, v, __ATOMIC_RELAXED, __HIP_MEMORY_SCOPE_AGENT); }
__device__ __forceinline__ unsigned xb_xcc_id() { return (unsigned)__builtin_amdgcn_s_getreg((3 << 11) | 20) & 0xFu; }
#define XB_SPIN(cond, bar) do { unsigned _sp = 0; while (cond) { __builtin_amdgcn_s_sleep(1); \
    if ((++_sp & 255u) == 0u) { if (xb_ld(&(bar)[XB_TMO])) break; if (_sp > XB_SPIN_CAP) { atomicAdd(&(bar)[XB_TMO], 1u); break; } } } } while (0)

struct XcdBarrier {
    unsigned* bar; unsigned x;
    volatile LAS unsigned* st;
};

__device__ __forceinline__ XcdBarrier xcd_barrier_post(unsigned* bar, volatile LAS unsigned* st) {
    XcdBarrier b; b.bar = bar; b.x = xb_xcc_id(); b.st = st;
    if (threadIdx.x == 0) (void)xb_add(&bar[XB_XCNT(b.x)], 1u);
    return b;
}
__device__ __forceinline__ void xcd_barrier_complete(unsigned* bar, unsigned x, unsigned& nloc, unsigned& nx) {
    const unsigned G = gridDim.x * gridDim.y * gridDim.z;
    unsigned sum, cnt, mine, sp = 0u;
    for (;;) {
        sum = 0u; cnt = 0u; mine = 0u;
#pragma unroll
        for (unsigned j = 0; j < 16; ++j) { const unsigned c = xb_ld(&bar[XB_XCNT(j)]); sum += c; cnt += (c > 0u) ? 1u : 0u; mine = (j == x) ? c : mine; }
        if (sum == G) break;
        __builtin_amdgcn_s_sleep(1);
        if ((++sp & 255u) == 0u) { if (xb_ld(&bar[XB_TMO])) break; if (sp > XB_SPIN_CAP) { atomicAdd(&bar[XB_TMO], 1u); break; } }
    }
    nloc = mine > 0u ? mine : 1u; nx = cnt > 0u ? cnt : 1u;
}

__device__ __forceinline__ void xcd_barrier(const XcdBarrier& b) {
    asm volatile("s_waitcnt vmcnt(0)" ::: "memory");
    __syncthreads();
    if (threadIdx.x == 0) {
        unsigned* bar = b.bar;
        __builtin_amdgcn_s_waitcnt(0);
        unsigned nloc = b.st[0], nx = b.st[1];
        if (nloc == 0u) { xcd_barrier_complete(bar, b.x, nloc, nx); b.st[0] = nloc; b.st[1] = nx; }
        const unsigned old = xb_add(&bar[XB_XSUB(b.x)], 1u);
        const unsigned gen = old / nloc;
        if (old + 1u == (gen + 1u) * nloc) {
            __builtin_amdgcn_fence(__ATOMIC_RELEASE, "agent");
            asm volatile("s_waitcnt vmcnt(0)" ::: "memory");
            const unsigned og = xb_add(&bar[XB_TOP], 1u);
            const unsigned tg = og / nx;
            if (og + 1u == (tg + 1u) * nx) xb_add(&bar[XB_TOPGEN], 1u);
            else XB_SPIN(xb_ld(&bar[XB_TOPGEN]) == tg, bar);
            __builtin_amdgcn_fence(__ATOMIC_ACQUIRE, "agent");
            xb_add(&bar[XB_XGEN(b.x)], 1u);
            asm volatile("s_waitcnt vmcnt(0)" ::: "memory");
        } else {
            XB_SPIN(xb_ld(&bar[XB_XGEN(b.x)]) == gen, bar);
            __builtin_amdgcn_fence(__ATOMIC_ACQUIRE, "agent");
            asm volatile("s_waitcnt vmcnt(0)" ::: "memory");
        }
    }
    __syncthreads();
}

typedef const __attribute__((address_space(4))) Args* KArgsP;
__device__ __forceinline__ KArgsP kargs() { KArgsP p = (KArgsP)__builtin_amdgcn_kernarg_segment_ptr(); asm volatile("" : "+s"(p)); return p; }
struct RawC { unsigned vv[9], g0[9], g1[9]; v2u s[2][2][2]; bf16x8 q[2]; v2u yl[2]; float bon[8]; };
__device__ __forceinline__ void c_load(RawC& R, const bf16* PROJ, const bf16* S0B, const bf16* QT, const bf16* YR, const float* BON, int unit, int wave, int lane) {
    const int c0 = unit % NCH, bh = unit / NCH, b = bh >> 3, h = bh & 7, row0 = chunk_row0(b, c0), prow = (c0 == 1) ? NREAL + 64 * b + 63 : row0 - 1, tq = wave, c = lane, hc = h * 64 + c;
    const int ty = wave >> 1, txb = 2 * (wave & 1), lj = lane & 15, lq = lane >> 4, yy = 16 * ty + lj;
#pragma unroll
    for (int i = 0; i < 9; ++i) {
        const bool valid = (c0 > 0) || (8 * tq + i > 0);
        const int rr_ = 8 * tq + i - 1; const bf16* p = PROJ + (size_t)(rr_ >= 0 ? row0 + rr_ : (valid ? prow : row0)) * PROJW;
        R.vv[i] = valid ? p[C_V + hc] : 0u; R.g0[i] = valid ? p[C_GD + c] : 0u; R.g1[i] = valid ? p[C_GD + 64 + c] : 0u;
    }
    const bf16* sp = S0B + (size_t)(c0 > 0 ? unit - 1 : unit) * 4096; const bf16* qp = QT + (size_t)unit * 4096;
#pragma unroll
    for (int kq = 0; kq < 2; ++kq) {
        const bf16x8 zq = {0, 0, 0, 0, 0, 0, 0, 0};
        R.q[kq] = c0 > 0 ? *(const bf16x8*)(qp + yy * 64 + 32 * kq + 8 * lq) : zq;
#pragma unroll
        for (int e = 0; e < 2; ++e) { const int tx = txb + e;
            const v2u z2 = {0u, 0u};
            R.s[e][kq][0] = c0 > 0 ? *(const v2u*)(sp + ((tx * 4 + 2 * kq + (lq >> 1)) * 64 + 16 * (2 * (lq & 1)) + lj) * 4) : z2;
            R.s[e][kq][1] = c0 > 0 ? *(const v2u*)(sp + ((tx * 4 + 2 * kq + (lq >> 1)) * 64 + 16 * (2 * (lq & 1) + 1) + lj) * 4) : z2; }
    }
#pragma unroll
    for (int e = 0; e < 2; ++e) R.yl[e] = *(const v2u*)(YR + (size_t)(row0 + yy) * RW + h * 64 + 16 * (txb + e) + 4 * lq);
#pragma unroll
    for (int u = 0; u < 8; ++u) R.bon[u] = BON[(size_t)(row0 + 8 * tq + u) * 8 + h];
}
#define RWKV_C_UNIT(unit, nxt) do { \
            const int c0 = unit % NCH, bh = unit / NCH, b = bh >> 3, h = bh & 7, row0 = chunk_row0(b, c0), tq = wave, c = lane, hc = h * 64 + c; \
            float vs[8], bon[8]; \
            { \
                float vv[9], g0[9], g1[9]; \
_Pragma("unroll") \
                for (int i = 0; i < 9; ++i) { vv[i] = bf2f(rawc.vv[i]); g0[i] = bf2f(rawc.g0[i]); g1[i] = bf2f(rawc.g1[i]); } \
_Pragma("unroll") \
                for (int u = 0; u < 8; ++u) bon[u] = rawc.bon[u]; \
                const float muv = mu[C_V + hc], mg0 = mu[C_GD + c], mg1 = mu[C_GD + 64 + c]; \
_Pragma("unroll") \
                for (int u = 0; u < 8; ++u) { \
                    vs[u] = vv[u + 1] + (vv[u] - vv[u + 1]) * muv; \
                    *(LAS bf16*)(SG + ((8 * tq + u) * 136 + c) * 2) = (bf16)f2bf(sigm(g0[u + 1] + (g0[u] - g0[u + 1]) * mg0)); \
                    *(LAS bf16*)(SG + ((8 * tq + u) * 136 + 64 + c) * 2) = (bf16)f2bf(sigm(g1[u + 1] + (g1[u] - g1[u + 1]) * mg1)); \
                } \
            } \
 \
_Pragma("unroll") \
            for (int e = 0; e < 2; ++e) { \
                const int tx = txb + e, xs = 16 * tx + 4 * lq; \
                f32x4 v = {0.f, 0.f, 0.f, 0.f}; \
_Pragma("unroll") \
                for (int kq = 0; kq < 2; ++kq) { \
                    const v4u sw = {rawc.s[e][kq][0].x, rawc.s[e][kq][0].y, rawc.s[e][kq][1].x, rawc.s[e][kq][1].y}; \
                    v = __builtin_amdgcn_mfma_f32_16x16x32_bf16(__builtin_bit_cast(bf16x8, sw), rawc.q[kq], v, 0, 0, 0); \
                } \
                const v2u yl = rawc.yl[e]; \
                v[0] += __uint_as_float(yl.x << 16); v[1] += __uint_as_float(yl.x & 0xffff0000u); v[2] += __uint_as_float(yl.y << 16); v[3] += __uint_as_float(yl.y & 0xffff0000u); \
                *(f32x4*)(Yf + yy * 68 + xs) = v; \
            } \
            if ((nxt) >= 0) c_load(rawc, PROJ, S0B, QT, YR, BON, (nxt), wave, lane); \
            __syncthreads(); \
 \
_Pragma("unroll") \
            for (int e = 0; e < 2; ++e) { \
                const int x0 = 16 * (txb + e), xs = x0 + 4 * lq; \
                f32x4 v = {0.f, 0.f, 0.f, 0.f}; \
_Pragma("unroll") \
                for (int kq = 0; kq < 4; ++kq) { \
                    const bf16x8 fg = *(const bf16x8*)(GUPT + (size_t)(h * 64 + x0 + lj) * 128 + 32 * kq + 8 * lq); \
                    const bf16x8 fs = *(const LAS bf16x8*)(SG + ((y0 + lj) * 136 + 32 * kq + 8 * lq) * 2); \
                    v = __builtin_amdgcn_mfma_f32_16x16x32_bf16(fg, fs, v, 0, 0, 0); \
                } \
                *(f32x4*)(Gf32 + yy * 68 + xs) = v; \
            } \
            __syncthreads(); \
            { \
                const float lg = ln_g[hc], lb = ln_b[hc]; \
_Pragma("unroll") \
                for (int u = 0; u < 8; ++u) { \
                    const int t = 8 * tq + u; \
                    const float y = Yf[t * 68 + c]; const float mean = wave_sum(y) * (1.f / 64.f); const float dv = y - mean; const float var = wave_sum(dv * dv) * (1.f / 64.f); \
                    const float yn = dv * rsqrtf(var + 64e-5f) * lg + lb; \
                    const float bonus = bon[u] * vs[u]; \
                    YR[(size_t)(row0 + t) * RW + hc] = (bf16)f2bf((yn + bonus) * Gf32[t * 68 + c]); \
                } \
            } \
            __syncthreads(); \
} while (0)
#define RWKV_C_DEFS const float* mu = ka->in[5]; const float* ln_g = ka->in[14]; const float* ln_b = ka->in[15]; \
        LAS unsigned char* SG = ldsl; float* Yf = (float*)(lds + 17408); float* Gf32 = Yf + 64 * 68; \
        const int ty = wave >> 1, txb = 2 * (wave & 1), lj = lane & 15, lq = lane >> 4, y0 = 16 * ty, yy = y0 + lj;
#define PHASE_PTRS KArgsP ka = kargs(); unsigned char* ws = ka->ws; \
    const float* x = ka->in[0]; const float* meta = ka->in[1]; \
    bf16* WIN_T = (bf16*)(ws + WO_WIN); bf16* WBR_T = (bf16*)(ws + WO_WBR); bf16* WGLU_T = (bf16*)(ws + WO_WGLU); bf16* WOUT_T = (bf16*)(ws + WO_WOUT); \
    bf16* WUP_T = (bf16*)(ws + WO_WUP); bf16* WDN_T = (bf16*)(ws + WO_WDN); \
    bf16* HN = (bf16*)(ws + WS_HN); bf16* PROJ = (bf16*)(ws + WS_PROJ); \
    bf16* GF = (bf16*)(ws + WS_GF); bf16* HF = (bf16*)(ws + WS_HF); bf16* YR = (bf16*)(ws + WS_YR); bf16* QT = (bf16*)(ws + WS_QT); float* BON = (float*)(ws + WS_BON); \
    bf16* BRT = (bf16*)(ws + WO_BRT); bf16* CRT = (bf16*)(ws + WO_CRT); float* LAM = (float*)(ws + WO_LAM); float* LAM64 = (float*)(ws + WO_LAM64); float* ZB = (float*)(ws + WS_Z); float* X0B = (float*)(ws + WS_X0); bf16* S0B = (bf16*)(ws + WS_S0); float* YBm = (float*)(ws + 65536); float* MIXINm = YBm + 2048; float* MIXm = YBm + 4096; float* HN2m = YBm + 6144; \
    bf16* WUPT = (bf16*)(ws + WO_WUPT); bf16* AUPT = (bf16*)(ws + WO_AUPT); bf16* GUPT = (bf16*)(ws + WO_GUPT); \
    bf16* YB = (bf16*)(ws + WS_YB); bf16* MIXIN = (bf16*)(ws + WS_MIXIN); bf16* MIX = (bf16*)(ws + WS_MIX); bf16* HN2 = (bf16*)(ws + WS_HN2); bf16* UP = (bf16*)(ws + WS_UP); bf16* FB = (bf16*)(ws + WS_F);
__global__ void __launch_bounds__(512, 2) mega(Args a_unused) {
    extern __shared__ __attribute__((aligned(16))) unsigned char lds[];
    cg::grid_group grid = cg::this_grid();
    const int tid = threadIdx.x, lane = tid & 63, wave = __builtin_amdgcn_readfirstlane(tid >> 6);
    const int G = gridDim.x, gw = blockIdx.x * 8 + wave, NGW = G * 8;
    LAS unsigned char* ldsl = (LAS unsigned char*)lds;
    if (tid < 2) *(volatile LAS unsigned*)(ldsl + XB_LDS_OFF + 4 * tid) = 0u;
    if (blockIdx.x == 0) { unsigned* bw = (unsigned*)kargs()->ws; for (int i = tid; i < XCD_BAR_WORDS; i += 512) bw[i] = 0u; }

    { PHASE_PTRS
    {
        float* scr = (float*)(lds + wave * 16384);
        constexpr int I0 = 16 * 136, I1 = 8 * 32, I2 = 8 * 64, I3 = 16 * 32, I4 = 16 * 176, I5 = 44 * 32, I6 = 16, I7 = 16, I8 = 32;
        for (int rep_ = 0; rep_ < REP0; ++rep_)
        for (int it = gw; it < I0 + I1 + I2 + I3 + I4 + I5 + I6 + I7 + I8; it += NGW) {
            int r = it;
            if (r < I0) { transpose_item(ka->in[4], D, PROJW, WIN_T, 0, scr, r, lane); continue; } r -= I0;
            if (r < I1) { transpose_item(ka->in[16], RW, D, WBR_T, 0, scr, r, lane); continue; } r -= I1;
            if (r < I2) { transpose_item(ka->in[25], RW, 2 * D, WGLU_T, 1, scr, r, lane); continue; } r -= I2;
            if (r < I3) { transpose_item(ka->in[26], D, D, WOUT_T, 0, scr, r, lane); continue; } r -= I3;
            if (r < I4) { transpose_item(ka->in[29], D, UPW, WUP_T, 0, scr, r, lane); continue; } r -= I4;
            if (r < I5) { transpose_item(ka->in[32], DFF, D, WDN_T, 0, scr, r, lane); continue; } r -= I5;
            if (r < I6) { transpose_item(ka->in[7], 64, RW, WUPT, 0, scr, r, lane); continue; } r -= I6;
            if (r < I7) { transpose_item(ka->in[9], 64, RW, AUPT, 0, scr, r, lane); continue; } r -= I7;
            transpose_item(ka->in[10], 128, RW, GUPT, 0, scr, r, lane);
        }
        {
            const int gt = blockIdx.x * 512 + tid;
            if (gt < 2048) {
                const int g = gt >> 6, n = gt & 63;
                const float lre = fminf(ka->in[17][gt], -1e-4f), lim = ka->in[18][gt], dt = __expf(ka->in[19][g]);
                const float mag = __expf(lre * dt); float sn, cs; sincosf(lim * dt, &sn, &cs);
                const float lbr = mag * cs, lbi = mag * sn;
                LAM[gt * 2] = lbr; LAM[gt * 2 + 1] = lbi;
                const float m64 = __expf(64.f * lre * dt); float s64, c64; sincosf(64.f * lim * dt, &s64, &c64);
                LAM64[gt * 2] = m64 * c64; LAM64[gt * 2 + 1] = m64 * s64;
                const float den = lre * lre + lim * lim, nr = lbr - 1.f, ni = lbi;
                const float cr = (nr * lre + ni * lim) / den, ci = (ni * lre - nr * lim) / den;
                for (int i = 0; i < 16; ++i) { const float br = ka->in[20][gt * 16 + i], bi = ka->in[21][gt * 16 + i];
                    BRT[(size_t)(g * 128 + n) * 16 + i] = (bf16)f2bf(cr * br - ci * bi); BRT[(size_t)(g * 128 + 64 + n) * 16 + i] = (bf16)f2bf(cr * bi + ci * br); }
            }
            for (int idx = gt; idx < 32 * 16 * 128; idx += G * 512) { const int n2 = idx & 127, gh = idx >> 7;
                CRT[idx] = (bf16)f2bf(n2 < 64 ? ka->in[22][gh * 64 + n2] : -ka->in[23][gh * 64 + n2 - 64]); }
        }
        const float* g = ka->in[2];
        for (int rep_ = 0; rep_ < REP0; ++rep_)
        for (int row = gw; row < MP; row += NGW) {
            const int j = row < NREAL ? 64 : ((row - NREAL) & 63);
            v2u* o = (v2u*)(HN + (size_t)row * D) + lane;
            if (j < PADR) {
#pragma unroll
                for (int jj = 0; jj < 4; ++jj) o[64 * jj] = (v2u){0u, 0u};
                continue; }
            const float* src = j < 64 ? meta + (size_t)(j - PADR) * D : x + (size_t)row * D;
            f32x4 v[4]; float ss = 0.f;
#pragma unroll
            for (int jj = 0; jj < 4; ++jj) { v[jj] = ((const f32x4*)src)[lane + 64 * jj]; ss += (v[jj].x * v[jj].x + v[jj].y * v[jj].y) + (v[jj].z * v[jj].z + v[jj].w * v[jj].w); }
            const float rstd = rsqrtf(wave_sum(ss) * (1.f / D) + 1e-6f);
#pragma unroll
            for (int jj = 0; jj < 4; ++jj) { const f32x4 g4 = ((const f32x4*)g)[lane + 64 * jj];
                o[64 * jj] = (v2u){pk2(v[jj].x * rstd * g4.x, v[jj].y * rstd * g4.y), pk2(v[jj].z * rstd * g4.z, v[jj].w * rstd * g4.w)}; }
        }
    }
    }
    grid.sync();
    const XcdBarrier xb = xcd_barrier_post((unsigned*)kargs()->ws, (volatile LAS unsigned*)(ldsl + XB_LDS_OFF));
    { PHASE_PTRS
    { pg8::Gemm g{HN, WIN_T, MP, PROJW, D, D, D}; pg8::StaticOrder S; S.init(MP, PROJW, G, (int)blockIdx.x);
      pg8::EpiF<FStoreBf16> E{{PROJ, PROJW}};
      pg8::gemm_phase<pg8::EpiF<FStoreBf16>, pg8::StaticOrder, true, true>(ldsl, g, S, E); }
    }
    xcd_barrier(xb);
    { PHASE_PTRS
    {
        const float* mu = ka->in[5]; const float* w0 = ka->in[6]; const float* a0 = ka->in[8]; const float* k_k = ka->in[11]; const float* k_a = ka->in[12]; const float* r_k = ka->in[13];
        float* tot = (float*)(lds + MISC_OFF); float* WCs = tot + 512;
        float* WLf = (float*)(lds + 13 * OPB); float* ALf = WLf + 64 * 68;
        const int ty = wave >> 1, txb = 2 * (wave & 1), lj = lane & 15, lq = lane >> 4, y0 = 16 * ty, yy = y0 + lj;
        RawA raw;
        if ((int)blockIdx.x < NUNIT) a0_load(raw, PROJ, blockIdx.x, wave, lane);
        for (int unit = blockIdx.x; unit < NUNIT; unit += G) {
            const int c0 = unit % NCH, bh = unit / NCH, b = bh >> 3, h = bh & 7, row0 = chunk_row0(b, c0), tq = wave, c = lane, hc = h * 64 + c;
            float rs[8], ks[8], vs[8];
            {
                float rv[9], kv[9], vv[9], wdv[9], adv[9];
#pragma unroll
                for (int i = 0; i < 9; ++i) { rv[i] = bf2f(raw.r[i]); kv[i] = bf2f(raw.k[i]); vv[i] = bf2f(raw.v[i]); wdv[i] = bf2f(raw.w[i]); adv[i] = bf2f(raw.a[i]); }
                const float mur = mu[hc], muk = mu[C_K + hc], muv = mu[C_V + hc], muw = mu[C_WD + c], mua = mu[C_AD + c];
#pragma unroll
                for (int u = 0; u < 8; ++u) {
                    rs[u] = rv[u + 1] + (rv[u] - rv[u + 1]) * mur; ks[u] = kv[u + 1] + (kv[u] - kv[u + 1]) * muk; vs[u] = vv[u + 1] + (vv[u] - vv[u + 1]) * muv;
                    const float wd = wdv[u + 1] + (wdv[u] - wdv[u + 1]) * muw, ad = adv[u + 1] + (adv[u] - adv[u + 1]) * mua;
                    *(LAS bf16*)(SLOT(11) + ((8 * tq + u) * OP + c) * 2) = (bf16)f2bf(tanh_fast(wd));
                    *(LAS bf16*)(SLOT(12) + ((8 * tq + u) * OP + c) * 2) = (bf16)f2bf(ad);
                }
            }
            if (unit + G < NUNIT) a0_load(raw, PROJ, unit + G, wave, lane);
            __syncthreads();
#pragma unroll
            for (int e = 0; e < 2; ++e) {
                const int x0 = 16 * (txb + e), xs = x0 + 4 * lq;
                f32x4 aw = {0.f, 0.f, 0.f, 0.f}, aa = {0.f, 0.f, 0.f, 0.f};
#pragma unroll
                for (int kq = 0; kq < 2; ++kq) {
                    const bf16x8 fw = *(const bf16x8*)(WUPT + (size_t)(h * 64 + x0 + lj) * 64 + 32 * kq + 8 * lq);
                    const bf16x8 fa = *(const bf16x8*)(AUPT + (size_t)(h * 64 + x0 + lj) * 64 + 32 * kq + 8 * lq);
                    aw = __builtin_amdgcn_mfma_f32_16x16x32_bf16(fw, ldfrag(SLOT(11), y0, kq, lane), aw, 0, 0, 0);
                    aa = __builtin_amdgcn_mfma_f32_16x16x32_bf16(fa, ldfrag(SLOT(12), y0, kq, lane), aa, 0, 0, 0);
                }
                *(f32x4*)(WLf + yy * 68 + xs) = aw; *(f32x4*)(ALf + yy * 68 + xs) = aa;
            }
            __syncthreads();
            {
                float lw[8], av[8], cum[8];
                const float w0c = w0[hc], a0c = a0[hc], kkc = k_k[hc], kac = k_a[hc], rkc = r_k[hc];
#pragma unroll
                for (int u = 0; u < 8; ++u) { const int t = 8 * tq + u; lw[u] = -0.60653066f * sigm(w0c + WLf[t * 68 + c]); av[u] = sigm(a0c + ALf[t * 68 + c]); }
                cum[0] = lw[0];
#pragma unroll
                for (int u = 1; u < 8; ++u) cum[u] = cum[u - 1] + lw[u];
                tot[tq * 64 + c] = cum[7];
                __syncthreads();
                float off = 0.f, all = 0.f;
#pragma unroll
                for (int w = 0; w < 8; ++w) { const float tv = tot[w * 64 + c]; all += tv; off += (w < tq) ? tv : 0.f; }
                float kkdT[8], bdT[8], kdT[8];
#pragma unroll
                for (int u = 0; u < 8; ++u) {
                    const int t = 8 * tq + u; const float ci = off + cum[u], cx = ci - lw[u];
                    const float kkv = ks[u] * kkc; const float n2 = wave_sum(kkv * kkv); const float kk = kkv / fmaxf(sqrtf(n2), 1e-12f);
                    const float k2 = ks[u] * (1.f + (av[u] - 1.f) * kac), bb = kk * av[u];
                    const float em = __expf(-ci), ed = __expf(all - ci);
                    kkdT[u] = kk * __expf(cx); bdT[u] = bb * ed; kdT[u] = k2 * ed;
                    *(LAS bf16*)(SLOT(0) + (t * OP + c) * 2) = (bf16)f2bf(kkdT[u]);
                    *(LAS bf16*)(SLOT(1) + (t * OP + c) * 2) = (bf16)f2bf(bb * em);
                    *(LAS bf16*)(SLOT(2) + (t * OP + c) * 2) = (bf16)f2bf(k2 * em);
                    *(LAS bf16*)(SLOT(3) + (t * OP + c) * 2) = (bf16)f2bf(rs[u] * __expf(ci));
                    const float rk = wave_sum(rs[u] * k2 * rkc);
                    if (lane == 0) BON[(size_t)(row0 + t) * 8 + h] = rk;
                }
                *(LAS v4u*)(SLOT(4) + (c * OP + 8 * tq) * 2) = pack8(kkdT);
                *(LAS v4u*)(SLOT(5) + (c * OP + 8 * tq) * 2) = pack8(bdT);
                *(LAS v4u*)(SLOT(6) + (c * OP + 8 * tq) * 2) = pack8(kdT);
                *(LAS v4u*)(SLOT(7) + (c * OP + 8 * tq) * 2) = pack8(vs);
                if (tq == 0) WCs[c] = __expf(all);
            }
            __syncthreads();
            f32x4 Pacc[2];
#pragma unroll
            for (int e = 0; e < 2; ++e) {
                const int tx = txb + e, x0 = 16 * tx, xs = x0 + 4 * lq; const f32x4 z = {0.f, 0.f, 0.f, 0.f};
                const bool lo = tx <= ty, up = ty <= tx;
                f32x4 v = lo ? tmm(SLOT(1), x0, SLOT(0), y0, z, lane) : z;
#pragma unroll
                for (int r = 0; r < 4; ++r) { v[r] = (xs + r < yy) ? v[r] : 0.f; Pacc[e][r] = ((xs + r == yy) ? 1.f : 0.f) - v[r]; }
                st4(SLOT(11), yy, xs, v); st4(SLOT(15), yy, xs, Pacc[e]);
                v = up ? tmm(SLOT(0), x0, SLOT(1), y0, z, lane) : z;
#pragma unroll
                for (int r = 0; r < 4; ++r) v[r] = (yy < xs + r) ? v[r] : 0.f;
                st4(SLOT(12), yy, xs, v);
                v = lo ? tmm(SLOT(2), x0, SLOT(0), y0, z, lane) : z;
#pragma unroll
                for (int r = 0; r < 4; ++r) v[r] = (xs + r < yy) ? v[r] : 0.f;
                st4(SLOT(8), yy, xs, v);
                v = lo ? tmm(SLOT(1), x0, SLOT(3), y0, z, lane) : z;
#pragma unroll
                for (int r = 0; r < 4; ++r) v[r] = (xs + r <= yy) ? v[r] : 0.f;
                st4(SLOT(9), yy, xs, v);
                v = lo ? tmm(SLOT(2), x0, SLOT(3), y0, z, lane) : z;
#pragma unroll
                for (int r = 0; r < 4; ++r) v[r] = (xs + r <= yy) ? v[r] : 0.f;
                st4(SLOT(10), yy, xs, v);
            }
            __syncthreads();
#pragma unroll
            for (int e = 0; e < 2; ++e) {
                const int tx = txb + e, x0 = 16 * tx, xs = x0 + 4 * lq; const f32x4 z = {0.f, 0.f, 0.f, 0.f};
                st4(SLOT(13), yy, xs, tx <= ty ? tmmk(SLOT(12), x0, SLOT(11), y0, z, lane, tx <= 1, ty >= 2) : z);
                st4(SLOT(14), yy, xs, ty <= tx ? tmmk(SLOT(11), x0, SLOT(12), y0, z, lane, ty <= 1, tx >= 2) : z);
                st4(SLOT(1), yy, xs, tmmk(SLOT(8), x0, SLOT(7), y0, z, lane, true, tx >= 2));
            }
            __syncthreads();
#define NEUMANN_STAGE(LT_cur, L_cur, P_cur, P_nxt, L_nxt, LT_nxt, DO_SQ, DO_SQ_L) \
            _Pragma("unroll") for (int e = 0; e < 2; ++e) { \
                const int tx = txb + e, x0 = 16 * tx, xs = x0 + 4 * lq; const f32x4 z = {0.f, 0.f, 0.f, 0.f}; \
                if (tx <= ty) Pacc[e] = tmmk(SLOT(LT_cur), x0, SLOT(P_cur), y0, Pacc[e], lane, tx <= 1, ty >= 2); \
                st4(SLOT(P_nxt), yy, xs, Pacc[e]); \
                if (DO_SQ_L) st4(SLOT(L_nxt), yy, xs, tx <= ty ? tmmk(SLOT(LT_cur), x0, SLOT(L_cur), y0, z, lane, tx <= 1, ty >= 2) : z); \
                if (DO_SQ) st4(SLOT(LT_nxt), yy, xs, ty <= tx ? tmmk(SLOT(L_cur), x0, SLOT(LT_cur), y0, z, lane, ty <= 1, tx >= 2) : z); \
            } __syncthreads();
            NEUMANN_STAGE(14, 13, 15, 16, 11, 12, true, true)
            NEUMANN_STAGE(12, 11, 16, 15, 13, 14, true, true)
            NEUMANN_STAGE(14, 13, 15, 16, 11, 12, true, true)
            NEUMANN_STAGE(12, 11, 16, 15, 13, 14, true, false)
            NEUMANN_STAGE(14, 13, 15, 16, 11, 12, false, false)
#pragma unroll
            for (int e = 0; e < 2; ++e) {
                const int tx = txb + e, x0 = 16 * tx, xs = x0 + 4 * lq; const f32x4 z = {0.f, 0.f, 0.f, 0.f};
                st4(SLOT(0), yy, xs, tmmk(SLOT(16), x0, SLOT(4), y0, z, lane, true, tx >= 2));
                f32x4 v = tmmk(SLOT(16), x0, SLOT(1), y0, z, lane, true, tx >= 2);
                st4(SLOT(2), yy, xs, -v);
            }
            __syncthreads();
#pragma unroll
            for (int e = 0; e < 2; ++e) {
                const int tx = txb + e, x0 = 16 * tx, xs = x0 + 4 * lq; const f32x4 z = {0.f, 0.f, 0.f, 0.f};
                f32x4 v = tmm(SLOT(0), x0, SLOT(5), y0, z, lane);
                const float wc = WCs[yy];
#pragma unroll
                for (int r = 0; r < 4; ++r) v[r] = ((xs + r == yy) ? wc : 0.f) - v[r];
                *(v2u*)(GF + (size_t)unit * 4096 + ((ty * 2 + (tx >> 1)) * 64 + lane) * 8 + 4 * (tx & 1)) = (v2u){pk2(v[0], v[1]), pk2(v[2], v[3])};
                v = tmm(SLOT(5), x0, SLOT(2), y0, z, lane); v = tmm(SLOT(6), x0, SLOT(7), y0, v, lane);
                *(v2u*)(HF + (size_t)unit * 4096 + ((ty * 4 + tx) * 64 + lane) * 4) = (v2u){pk2(v[0], v[1]), pk2(v[2], v[3])};
                v = tmmk(SLOT(0), x0, SLOT(9), y0, z, lane, true, ty >= 2);
                { const v2u rd = *(const LAS v2u*)(SLOT(3) + (yy * OP + xs) * 2);
                  v[0] = __uint_as_float(rd.x << 16) - v[0]; v[1] = __uint_as_float(rd.x & 0xffff0000u) - v[1]; v[2] = __uint_as_float(rd.y << 16) - v[2]; v[3] = __uint_as_float(rd.y & 0xffff0000u) - v[3]; }
                *(v2u*)(QT + (size_t)unit * 4096 + yy * 64 + xs) = (v2u){pk2(v[0], v[1]), pk2(v[2], v[3])};
                v = tmmk(SLOT(2), x0, SLOT(9), y0, z, lane, true, ty >= 2); v = tmmk(SLOT(7), x0, SLOT(10), y0, v, lane, true, ty >= 2);
                *(v2u*)(YR + (size_t)(row0 + yy) * RW + h * 64 + xs) = (v2u){pk2(v[0], v[1]), pk2(v[2], v[3])};
            }
            __syncthreads();
        }
        for (int rep_ = 0; rep_ < REP2S; ++rep_)
        for (int wu = gw; wu < S5UNITS; wu += NGW) s5_unit<false>(wu, PROJ, BRT, CRT, LAM, ka->in[24], ZB, X0B, ldsl + wave * 14592, lane);
    }
    }
    xcd_barrier(xb);
    { PHASE_PTRS
    for (int rep_ = 0; rep_ < REP3; ++rep_)
    for (int unit = blockIdx.x; unit < 48; unit += G) {
        if (unit < 32) {
            const int bh = unit;
            const bf16* gsrc = GF + (size_t)bh * NCH * 4096; const bf16* hsrc = HF + (size_t)bh * NCH * 4096;
            constexpr int DEPTH = 7;
            if (wave >= 4) {
                const int lt = tid - 256;
#define CH_ISSUE(step) do { const int st_ = (step) < NCH ? (step) : NCH - 1; const unsigned so_ = (unsigned)((step) & 7) * 16384u + (unsigned)(wave - 4) * 1024u; \
                    __builtin_amdgcn_global_load_lds((const unsigned*)(gsrc + (size_t)st_ * 4096 + lt * 8), (LAS unsigned*)(ldsl + so_), 16, 0, 0); \
                    __builtin_amdgcn_global_load_lds((const unsigned*)(gsrc + (size_t)st_ * 4096 + 2048 + lt * 8), (LAS unsigned*)(ldsl + so_ + 4096), 16, 0, 0); \
                    __builtin_amdgcn_global_load_lds((const unsigned*)(hsrc + (size_t)st_ * 4096 + lt * 8), (LAS unsigned*)(ldsl + so_ + 8192), 16, 0, 0); \
                    __builtin_amdgcn_global_load_lds((const unsigned*)(hsrc + (size_t)st_ * 4096 + 2048 + lt * 8), (LAS unsigned*)(ldsl + so_ + 12288), 16, 0, 0); } while (0)
                for (int s = 0; s < DEPTH; ++s) CH_ISSUE(s);
                for (int cidx = 0; cidx < NCH; ++cidx) {
                    asm volatile("s_waitcnt vmcnt(24)" ::: "memory");
                    __builtin_amdgcn_s_barrier();
                    CH_ISSUE(cidx + DEPTH);
                }
                asm volatile("s_waitcnt vmcnt(0)" ::: "memory");
            } else {
                const int vq = wave;
                f32x4 acc[4];
#pragma unroll
                for (int i = 0; i < 4; ++i) acc[i] = (f32x4){0.f, 0.f, 0.f, 0.f};
                for (int cidx = 0; cidx < NCH; ++cidx) {
                    __builtin_amdgcn_s_barrier();
                    const LAS unsigned char* base = ldsl + (cidx & 7) * 16384;
                    bf16x8 bfr[2];
#pragma unroll
                    for (int s = 0; s < 2; ++s) { v4u w; w.x = pk2(acc[2 * s][0], acc[2 * s][1]); w.y = pk2(acc[2 * s][2], acc[2 * s][3]); w.z = pk2(acc[2 * s + 1][0], acc[2 * s + 1][1]); w.w = pk2(acc[2 * s + 1][2], acc[2 * s + 1][3]);
                        bfr[s] = __builtin_bit_cast(bf16x8, w); }
                    f32x4 nacc[4];
#pragma unroll
                    for (int tk = 0; tk < 4; ++tk) {
                        const v2u hv = *(const LAS v2u*)(base + 8192 + ((vq * 4 + tk) * 64 + lane) * 8);
                        nacc[tk] = (f32x4){__uint_as_float(hv.x << 16), __uint_as_float(hv.x & 0xffff0000u), __uint_as_float(hv.y << 16), __uint_as_float(hv.y & 0xffff0000u)};
#pragma unroll
                        for (int s = 0; s < 2; ++s) nacc[tk] = __builtin_amdgcn_mfma_f32_16x16x32_bf16(*(const LAS bf16x8*)(base + ((tk * 2 + s) * 64 + lane) * 16), bfr[s], nacc[tk], 0, 0, 0);
                    }
#pragma unroll
                    for (int tk = 0; tk < 4; ++tk) { acc[tk] = nacc[tk];
                        *(v2u*)(S0B + ((size_t)bh * NCH + cidx) * 4096 + ((vq * 4 + tk) * 64 + lane) * 4) = (v2u){pk2(acc[tk][0], acc[tk][1]), pk2(acc[tk][2], acc[tk][3])}; }
                }
            }
            __syncthreads();
        } else {
            const int ch = (unit - 32) * 512 + tid, b = ch >> 11, gn = ch & 2047;
            const float l64r = LAM64[gn * 2], l64i = LAM64[gn * 2 + 1];
            const size_t cb = (size_t)b * NCH * 4096 + (gn >> 6) * 128 + (gn & 63);
            float xr = 0.f, xi = 0.f;
            for (int c0 = 0; c0 < NCH; c0 += 8) {
                float zr[8], zi[8];
#pragma unroll
                for (int u = 0; u < 8; ++u) { const int cc = c0 + u < NCH ? c0 + u : NCH - 1; zr[u] = ZB[cb + (size_t)cc * 4096]; zi[u] = ZB[cb + (size_t)cc * 4096 + 64]; }
#pragma unroll
                for (int u = 0; u < 8; ++u) if (c0 + u < NCH) {
                    X0B[cb + (size_t)(c0 + u) * 4096] = xr; X0B[cb + (size_t)(c0 + u) * 4096 + 64] = xi;
                    const float nxr = l64r * xr - l64i * xi + zr[u], nxi = l64r * xi + l64i * xr + zi[u]; xr = nxr; xi = nxi; }
            }
        }
    }
    if (blockIdx.x >= 48 && blockIdx.x < 56) { RWKV_C_DEFS const int munit = ((int)blockIdx.x - 48) * NCH; RawC rawc; c_load(rawc, PROJ, S0B, QT, YR, BON, munit, wave, lane); RWKV_C_UNIT(munit, -1); }
    if (blockIdx.x >= 56 && blockIdx.x < 60) s5_unit<true>((((int)blockIdx.x - 56) * 8 + wave) * NCH, PROJ, BRT, CRT, LAM, ka->in[24], ZB, X0B, ldsl + wave * 14592, lane);
    }
    xcd_barrier(xb);
    { PHASE_PTRS
    {
        RWKV_C_DEFS
        RawC rawc; if ((int)blockIdx.x < NB * 8 * (NCH - 1)) c_load(rawc, PROJ, S0B, QT, YR, BON, ((int)blockIdx.x >> 7) * NCH + ((int)blockIdx.x & 127) + 1, wave, lane);
        for (int u4 = blockIdx.x; u4 < NB * 8 * (NCH - 1); u4 += G) { const int unit = (u4 >> 7) * NCH + (u4 & 127) + 1, un = u4 + G, nxt = un < NB * 8 * (NCH - 1) ? (un >> 7) * NCH + (un & 127) + 1 : -1; RWKV_C_UNIT(unit, nxt); }
        for (int wu = gw; wu < S5UNITS; wu += NGW) if (wu % NCH != 0) s5_unit<true>(wu, PROJ, BRT, CRT, LAM, ka->in[24], ZB, X0B, ldsl + wave * 14592, lane);
        for (int n = gw; n < D; n += NGW) {
            const int d = 256 * (n >> 7) + (n & 127); const bf16* y0p = PROJ + (size_t)(NREAL + 62) * PROJW + C_U; float a0, a1, b0, b1;
            dot2b<512>(WGLU_T + (size_t)d * RW, y0p, y0p + PROJW, lane, a0, a1); dot2b<512>(WGLU_T + (size_t)(d + 128) * RW, y0p, y0p + PROJW, lane, b0, b1);
            if (lane == 0) { YBm[n] = a0 * sigm(b0); YBm[D + n] = a1 * sigm(b1); } }
    }
    }
    xcd_barrier(xb);
    { PHASE_PTRS
    { for (int n = gw; n < D; n += NGW) {
          const bf16* y0p = YR + (size_t)(NREAL + 62) * RW; float a0, a1; dot2b<512>(WBR_T + (size_t)n * RW, y0p, y0p + RW, lane, a0, a1);
          if (lane == 0) {
#pragma unroll
              for (int r = 0; r < 2; ++r) { const bf16* pg = PROJ + (size_t)(NREAL + 62 + r) * PROJW; MIXINm[r * D + n] = sigm(bf2f(pg[C_GA + n])) * (r ? a1 : a0) + sigm(bf2f(pg[C_GB + n])) * YBm[r * D + n]; } } }
      pg8::Gemm g{PROJ + C_U, WGLU_T, NREAL, 2 * D, RW, PROJW, RW}; pg8::StaticOrder S; S.init(NREAL, 2 * D, G, (int)blockIdx.x);
      pg8::EpiF<FGlu> E{{YB}};
      pg8::gemm_phase<pg8::EpiF<FGlu>, pg8::StaticOrder, true, true>(ldsl, g, S, E); }
    }
    xcd_barrier(xb);
    { PHASE_PTRS
    { for (int n = gw; n < D; n += NGW) { float a0, a1; dot2f<1024>(WOUT_T + (size_t)n * D, MIXINm, MIXINm + D, lane, a0, a1); if (lane == 0) { MIXm[n] = a0; MIXm[D + n] = a1; } }
      pg8::Gemm g{YR, WBR_T, NREAL, D, RW, RW, RW}; pg8::StaticOrder S; S.init(NREAL, D, G, (int)blockIdx.x);
      pg8::EpiF<FMixin> E{{PROJ, YB, MIXIN}};
      pg8::gemm_phase<pg8::EpiF<FMixin>, pg8::StaticOrder, true, true>(ldsl, g, S, E); }
    }
    xcd_barrier(xb);
    { PHASE_PTRS
    { if (gw < 2) {
          const float* mrw = MIXm + gw * D; const float* hsrc = meta + (size_t)(14 + gw) * D; const float* gp = ka->in[3]; const float* gf = ka->in[27];
          f32x4 m[4], hv[4]; float ss = 0.f;
#pragma unroll
          for (int jj = 0; jj < 4; ++jj) { m[jj] = ((const f32x4*)mrw)[lane + 64 * jj]; hv[jj] = ((const f32x4*)hsrc)[lane + 64 * jj]; ss += (m[jj].x * m[jj].x + m[jj].y * m[jj].y) + (m[jj].z * m[jj].z + m[jj].w * m[jj].w); }
          const float rstd = rsqrtf(wave_sum(ss) * (1.f / D) + 1e-6f); float s2 = 0.f;
#pragma unroll
          for (int jj = 0; jj < 4; ++jj) { const f32x4 g4 = ((const f32x4*)gp)[lane + 64 * jj]; hv[jj] = hv[jj] + m[jj] * rstd * g4; s2 += (hv[jj].x * hv[jj].x + hv[jj].y * hv[jj].y) + (hv[jj].z * hv[jj].z + hv[jj].w * hv[jj].w); }
          const float rstd2 = rsqrtf(wave_sum(s2) * (1.f / D) + 1e-6f);
#pragma unroll
          for (int jj = 0; jj < 4; ++jj) { const f32x4 g4 = ((const f32x4*)gf)[lane + 64 * jj]; ((f32x4*)(HN2m + gw * D))[lane + 64 * jj] = hv[jj] * rstd2 * g4; } }
      pg8::Gemm g{MIXIN, WOUT_T, NREAL, D, D, D, D}; pg8::StaticOrder S; S.init(NREAL, D, G, (int)blockIdx.x);
      pg8::EpiF<FStoreBf16> E{{MIX, D}};
      pg8::gemm_phase<pg8::EpiF<FStoreBf16>, pg8::StaticOrder, true, true>(ldsl, g, S, E); }
    }
    xcd_barrier(xb);
    { PHASE_PTRS
    {
        const float* gp = ka->in[3]; const float* gf = ka->in[27];
        for (int n = gw; n < DFF; n += NGW) { float a0, a1; dot2f<1024>(WUP_T + (size_t)n * D, HN2m, HN2m + D, lane, a0, a1);
            if (lane == 0) { UP[(size_t)(NREAL + 62) * UPW + n] = (bf16)f2bf(a0); UP[(size_t)(NREAL + 63) * UPW + n] = (bf16)f2bf(a1); } }
        for (int row = gw; row < NREAL; row += NGW) {
            const int j = 64;
            v2u* o = (v2u*)(HN2 + (size_t)row * D) + lane;
            if (j < PADR) {
#pragma unroll
                for (int jj = 0; jj < 4; ++jj) o[64 * jj] = (v2u){0u, 0u};
                continue; }
            const float* src = j < 64 ? meta + (size_t)(j - PADR) * D : x + (size_t)row * D;
            const v2u* mr = (const v2u*)(MIX + (size_t)row * D);
            f32x4 m[4], hv[4]; float ss = 0.f;
#pragma unroll
            for (int jj = 0; jj < 4; ++jj) { { const v2u q = mr[lane + 64 * jj]; m[jj] = (f32x4){__uint_as_float(q.x << 16), __uint_as_float(q.x & 0xffff0000u), __uint_as_float(q.y << 16), __uint_as_float(q.y & 0xffff0000u)}; } hv[jj] = ((const f32x4*)src)[lane + 64 * jj]; ss += (m[jj].x * m[jj].x + m[jj].y * m[jj].y) + (m[jj].z * m[jj].z + m[jj].w * m[jj].w); }
            const float rstd = rsqrtf(wave_sum(ss) * (1.f / D) + 1e-6f); float s2 = 0.f;
#pragma unroll
            for (int jj = 0; jj < 4; ++jj) { const f32x4 g4 = ((const f32x4*)gp)[lane + 64 * jj]; hv[jj] = hv[jj] + m[jj] * rstd * g4;
                s2 += (hv[jj].x * hv[jj].x + hv[jj].y * hv[jj].y) + (hv[jj].z * hv[jj].z + hv[jj].w * hv[jj].w); }
            const float rstd2 = rsqrtf(wave_sum(s2) * (1.f / D) + 1e-6f);
            if (j >= 64) { f32x4* od = (f32x4*)(ka->out + (size_t)row * D);
#pragma unroll
                for (int jj = 0; jj < 4; ++jj) od[lane + 64 * jj] = hv[jj]; }
#pragma unroll
            for (int jj = 0; jj < 4; ++jj) { const f32x4 g4 = ((const f32x4*)gf)[lane + 64 * jj];
                o[64 * jj] = (v2u){pk2(hv[jj].x * rstd2 * g4.x, hv[jj].y * rstd2 * g4.y), pk2(hv[jj].z * rstd2 * g4.z, hv[jj].w * rstd2 * g4.w)}; }
        }
    }
    }
    xcd_barrier(xb);
    { PHASE_PTRS
    { pg8::Gemm g{HN2, WUP_T, NREAL, UPW, D, D, D}; pg8::StaticOrder S; S.init(NREAL, UPW, G, (int)blockIdx.x);
      pg8::EpiF<FStoreBf16> E{{UP, UPW}};
      pg8::gemm_phase<pg8::EpiF<FStoreBf16>, pg8::StaticOrder, true, true>(ldsl, g, S, E); }
    }
    xcd_barrier(xb);
    { PHASE_PTRS
    {
        const float* cw = ka->in[30]; const float* cb = ka->in[31];
        const unsigned total = (unsigned)NREAL * (DFF / 8);
        for (unsigned idx = blockIdx.x * 512u + tid; idx < total; idx += (unsigned)G * 512u) {
            const int row = (int)(idx / (unsigned)(DFF / 8)), c = (int)(idx % (unsigned)(DFF / 8)) * 8, j = row & (SEQ - 1), mrow = NREAL + 63;
            const bf16* p = UP + (size_t)row * UPW + c;
            float a0[8], a1[8], a2[8], gt[8], o[8];
            unpack8(*(const v4u*)p, a0); unpack8(*(const v4u*)(p + DFF), gt);
            unpack8(*(const v4u*)(j >= 1 ? p - UPW : UP + (size_t)mrow * UPW + c), a1);
            unpack8(*(const v4u*)(j >= 2 ? p - 2 * UPW : UP + (size_t)(mrow - 1 + j) * UPW + c), a2);
#pragma unroll
            for (int e = 0; e < 8; ++e) { const float cv = cw[c + e] * a2[e] + cw[DFF + c + e] * a1[e] + cw[2 * DFF + c + e] * a0[e] + cb[c + e]; o[e] = gelu_t(cv) * gt[e]; }
            *(v4u*)(UP + (size_t)row * UPW + DFF + c) = pack8(o);
        }
    }
    }
    xcd_barrier(xb);
    { PHASE_PTRS
    { pg8::Gemm g{UP + DFF, WDN_T, NREAL, D, DFF, UPW, DFF}; pg8::StaticOrder S; S.init(NREAL, D, G, (int)blockIdx.x);
      pg8::EpiF<FStoreBf16> E{{FB, D}};
      pg8::gemm_phase<pg8::EpiF<FStoreBf16>, pg8::StaticOrder, true, true>(ldsl, g, S, E); }
    }
    xcd_barrier(xb);
    { PHASE_PTRS
    {
        const float* gq = ka->in[28];
        for (int r = gw; r < NB * SEQ; r += NGW) {
            const int row = r;
            const v2u* fr = (const v2u*)(FB + (size_t)row * D);
            f32x4 fv[4]; float ss = 0.f;
#pragma unroll
            for (int jj = 0; jj < 4; ++jj) { const v2u q = fr[lane + 64 * jj]; fv[jj] = (f32x4){__uint_as_float(q.x << 16), __uint_as_float(q.x & 0xffff0000u), __uint_as_float(q.y << 16), __uint_as_float(q.y & 0xffff0000u)};
                ss += (fv[jj].x * fv[jj].x + fv[jj].y * fv[jj].y) + (fv[jj].z * fv[jj].z + fv[jj].w * fv[jj].w); }
            const float rstd = rsqrtf(wave_sum(ss) * (1.f / D) + 1e-6f);
            f32x4* od = (f32x4*)(ka->out + (size_t)r * D);
#pragma unroll
            for (int jj = 0; jj < 4; ++jj) { const f32x4 g4 = ((const f32x4*)gq)[lane + 64 * jj]; od[lane + 64 * jj] = od[lane + 64 * jj] + fv[jj] * rstd * g4; }
        }
    }
    }
}

extern "C" void kernel_launch(void* const* d_in, const int* in_sizes, int n_in, void* d_out, int out_size, void* d_ws, size_t ws_size, hipStream_t stream) {
    static int grid = 0;
    if (grid == 0) {
        if (n_in != 33 || ws_size < WS_END) { fprintf(stderr, "kernel_launch: unexpected n_in %d / ws_size %zu\n", n_in, ws_size); grid = -1; return; }
        int dev = 0, cus = 0, per_cu = 0;
        (void)hipGetDevice(&dev); (void)hipDeviceGetAttribute(&cus, hipDeviceAttributeMultiprocessorCount, dev);
        (void)hipFuncSetAttribute((const void*)mega, hipFuncAttributeMaxDynamicSharedMemorySize, LDS_BYTES);
        (void)hipOccupancyMaxActiveBlocksPerMultiprocessor(&per_cu, (const void*)mega, 512, LDS_BYTES);
        if (per_cu < 1) { fprintf(stderr, "kernel_launch: occupancy query says %d blocks/CU\n", per_cu); per_cu = 1; }
        (void)hipGetLastError();
        grid = cus * per_cu;
    }
    if (grid < 0) return;
    Args a{};
    for (int i = 0; i < 33; ++i) a.in[i] = (const float*)d_in[i];
    a.out = (float*)d_out; a.ws = (unsigned char*)d_ws;
    void* args[] = {&a};
    hipError_t e = hipLaunchCooperativeKernel((const void*)mega, dim3(grid), dim3(512), args, LDS_BYTES, stream);
    if (e != hipSuccess) fprintf(stderr, "cooperative launch failed: %s (grid %d)\n", hipGetErrorString(e), grid);
}
```

```cpp
#include <hip/hip_runtime.h>
#include <hip/hip_cooperative_groups.h>
#include <cstdio>
#include <cstdint>
namespace cg = cooperative_groups;
#ifndef REPG
#define REPG 1
#endif
namespace pg8 {
#define PG8_LAS __attribute__((address_space(3)))
typedef unsigned short bf16_t;
typedef short bf16x8 __attribute__((ext_vector_type(8)));
typedef float f32x4 __attribute__((ext_vector_type(4)));
typedef unsigned u32x4 __attribute__((ext_vector_type(4)));
constexpr int BM = 256, BK = 64, HALF = 128, HTB = HALF * BK * 2  , STAGE_BYTES = 8 * HTB, NXCD = 8, WGM = 8;

__host__ __device__ __forceinline__ int lds_byte(int r, int c) { const int st = (r >> 4) * 2 + (c >> 5), rr = r & 15, cc = c & 31, ob = rr * 64 + cc * 2; return st * 1024 + (ob ^ (((ob >> 9) & 1) << 5)); }
__host__ __device__ __forceinline__ void stage_rc(int b, int& R, int& C) { const int st = b / 1024, sb = b % 1024, swz = sb ^ (((sb >> 9) & 1) << 5); R = (st >> 1) * 16 + swz / 64; C = (st & 1) * 32 + (swz % 64) / 2; }
__host__ __device__ __forceinline__ int perm32(int rho) { const int n = rho >> 4, i = rho & 15; return 8 * (i >> 2) + 4 * n + (i & 3); }

struct Unit { int pm, pn; };
struct Gemm { const bf16_t* A; const bf16_t* Bt; int M, N, K, lda, ldb; };

struct StaticOrder {
    int nM, nN, nwg, G, c;
    __host__ __device__ void init(int M, int N, int G_, int c_) { nM = M / BM; nN = N / BM; nwg = nM * nN; G = G_; c = c_; }
    __host__ __device__ bool next(int i, Unit& u) const {
        const long L = (long)i * G + c; if (L >= (long)nwg * REPG) return false;
        int wgid = (int)(L % nwg); { const int q = nwg / NXCD, r = nwg % NXCD, xcd = wgid % NXCD, off = wgid / NXCD; wgid = (xcd < r ? xcd * (q + 1) : r * (q + 1) + (xcd - r) * q) + off; }
        const int nig = WGM * nN, gid = wgid / nig, fm = gid * WGM, gsz = (nM - fm) < WGM ? (nM - fm) : WGM;
        u.pm = fm + ((wgid % nig) % gsz); u.pn = (wgid % nig) / gsz; return true;
    }
    __device__ __forceinline__ void a_ready(const Unit&) const {}
    __device__ __forceinline__ void done(const Unit&) const {}
};


template <class F> struct EpiF {
    static constexpr bool PERM = true, AFTER_DRAIN = false; F f;
    __device__ __forceinline__ void operator()(const f32x4 (&acc)[2][2][4][2], const Unit& u, int wr, int wc, int fr, int fq) const {
        const int cw = wc * 32 + 8 * fq;
#pragma unroll
        for (int ai = 0; ai < 2; ++ai)
#pragma unroll
            for (int m = 0; m < 4; ++m) {
                const int row = u.pm * BM + ai * HALF + wr * 64 + m * 16 + fr;
                f(row, u.pn, cw, acc[ai][0][m][0], acc[ai][0][m][1], acc[ai][1][m][0], acc[ai][1][m][1]);
            }
    }
};
template <class Epi, class Sched, bool ALIGN_EPI = false, bool SP2 = false>
__device__ __forceinline__ void gemm_phase(PG8_LAS unsigned char* lds, const Gemm g, const Sched& S, const Epi& E) {
    const int tid = threadIdx.x, wid = __builtin_amdgcn_readfirstlane(tid >> 6), lane = tid & 63, wr = wid >> 2, wc = wid & 3, fr = lane & 15, fq = lane >> 4;
    const int K = g.K, nt = K / BK;
    unsigned voffA[2], voffB[2];
#pragma unroll
    for (int i = 0; i < 2; ++i) { int R, C; stage_rc(tid * 16 + i * 8192, R, C); const int Rb = Epi::PERM ? ((R & ~31) + perm32(R & 31)) : R;
        voffA[i] = (unsigned)(R * g.lda + C) * 2u; voffB[i] = (unsigned)(Rb * g.ldb + C) * 2u; }
    const size_t kstep = (size_t)(BK * 2);
    const size_t hstepA = (size_t)HALF * g.lda * 2, hstepB = (size_t)HALF * g.ldb * 2;
    const size_t tstepA = 2 * hstepA, tstepB = 2 * hstepB;
    const unsigned ldsw = (unsigned)wid * 1024u;
    const int aoff = lds_byte(wr * 64 + fr, fq * 8), boff = lds_byte(wc * 32 + fr, fq * 8);
#define PG8_SA(b, h) (((b) * 2 + (h)) * HTB)
#define PG8_SB(b, h) ((4 + (b) * 2 + (h)) * HTB)
#define PG8_STAGE(bufoff, gbase, voff) do { _Pragma("unroll") for (int _i = 0; _i < 2; ++_i) \
        __builtin_amdgcn_global_load_lds((const unsigned*)((const char*)(gbase) + (voff)[_i]), (PG8_LAS unsigned*)(lds + (bufoff) + ldsw + _i * 8192), 16, 0, 0); } while (0)
#define PG8_LDA(dst, b, h) do { _Pragma("unroll") for (int m = 0; m < 4; ++m) _Pragma("unroll") for (int k = 0; k < 2; ++k) dst[m][k] = *(const PG8_LAS bf16x8*)(lds + PG8_SA(b, h) + aoff + m * 2048 + k * 1024); } while (0)
#define PG8_LDB(dst, b, h) do { _Pragma("unroll") for (int n = 0; n < 2; ++n) _Pragma("unroll") for (int k = 0; k < 2; ++k) dst[n][k] = *(const PG8_LAS bf16x8*)(lds + PG8_SB(b, h) + boff + n * 2048 + k * 1024); } while (0)
#define PG8_MMA(ai, bj, At, Bt) do { __builtin_amdgcn_s_setprio(1); _Pragma("unroll") for (int m = 0; m < 4; ++m) _Pragma("unroll") for (int n = 0; n < 2; ++n) _Pragma("unroll") for (int k = 0; k < 2; ++k) \
        acc[ai][bj][m][n] = __builtin_amdgcn_mfma_f32_16x16x32_bf16(Bt[n][k], At[m][k], acc[ai][bj][m][n], 0, 0, 0); __builtin_amdgcn_s_setprio(0); } while (0)
#define PG8_WAIT_V(n) asm volatile("s_waitcnt vmcnt(" #n ")" ::: "memory")
#define PG8_WAIT_L(n) asm volatile("s_waitcnt lgkmcnt(" #n ")" ::: "memory")
#define PG8_BAR __builtin_amdgcn_s_barrier()
#define PG8_SCHED __builtin_amdgcn_sched_barrier(0)
    Unit cur, nxt; int ui = 0;
    if (!S.next(0, cur)) return;
    f32x4 acc[2][2][4][2];
#pragma unroll
    for (int a = 0; a < 2; ++a)
#pragma unroll
        for (int b = 0; b < 2; ++b)
#pragma unroll
            for (int m = 0; m < 4; ++m)
#pragma unroll
                for (int n = 0; n < 2; ++n) acc[a][b][m][n] = (f32x4){0.f, 0.f, 0.f, 0.f};
    bf16x8 At[4][2], B0[2][2], B1[2][2];
    const char* cA = (const char*)g.A + (size_t)cur.pm * tstepA; const char* cB = (const char*)g.Bt + (size_t)cur.pn * tstepB;
    S.a_ready(cur);
    if constexpr (SP2) {
        PG8_STAGE(PG8_SB(0, 0), cB, voffB); PG8_STAGE(PG8_SB(0, 1), cB + hstepB, voffB); PG8_STAGE(PG8_SA(0, 0), cA, voffA); PG8_STAGE(PG8_SA(0, 1), cA + hstepA, voffA);
        if (wr == 1) PG8_BAR;
        PG8_WAIT_V(2); PG8_BAR;
        PG8_STAGE(PG8_SB(1, 0), cB + kstep, voffB); PG8_STAGE(PG8_SA(1, 0), cA + kstep, voffA); PG8_STAGE(PG8_SB(1, 1), cB + hstepB + kstep, voffB);
        PG8_WAIT_V(6); PG8_BAR;
    } else {
        PG8_STAGE(PG8_SB(0, 0), cB, voffB); PG8_STAGE(PG8_SA(0, 0), cA, voffA); PG8_STAGE(PG8_SB(0, 1), cB + hstepB, voffB); PG8_STAGE(PG8_SA(0, 1), cA + hstepA, voffA);
        if (wr == 1) PG8_BAR;
        PG8_WAIT_V(4); PG8_BAR;
        PG8_STAGE(PG8_SB(1, 0), cB + kstep, voffB); PG8_STAGE(PG8_SA(1, 0), cA + kstep, voffA); PG8_STAGE(PG8_SB(1, 1), cB + hstepB + kstep, voffB);
        PG8_WAIT_V(6); PG8_BAR;
    }
    for (;;) {
        const bool has_next = S.next(ui + 1, nxt);
        const char* nA = has_next ? (const char*)g.A + (size_t)nxt.pm * tstepA : cA; const char* nB = has_next ? (const char*)g.Bt + (size_t)nxt.pn * tstepB : cB;
        for (int t = 0; t < nt; t += 2) {
            const bool last = (t == nt - 2);
            const char* a1 = cA + (size_t)(t + 1) * kstep;
            const char* a2 = last ? nA : cA + (size_t)(t + 2) * kstep; const char* b2 = last ? nB : cB + (size_t)(t + 2) * kstep;
            const char* a3 = a2 + kstep; const char* b3 = b2 + kstep;
            if (last && has_next) S.a_ready(nxt);
            if constexpr (SP2) {
            PG8_LDB(B0, 0, 0); PG8_LDB(B1, 0, 1); PG8_SCHED; PG8_LDA(At, 0, 0); PG8_STAGE(PG8_SA(1, 1), a1 + hstepA, voffA);
            PG8_WAIT_V(8); PG8_WAIT_L(0); PG8_BAR; PG8_MMA(0, 0, At, B0); PG8_MMA(0, 1, At, B1); PG8_BAR; PG8_SCHED;
            PG8_LDA(At, 0, 1); PG8_STAGE(PG8_SB(0, 0), b2, voffB); PG8_STAGE(PG8_SB(0, 1), b2 + hstepB, voffB); PG8_STAGE(PG8_SA(0, 0), a2, voffA);
            PG8_WAIT_V(8); PG8_WAIT_L(0); PG8_BAR; PG8_MMA(1, 0, At, B0); PG8_MMA(1, 1, At, B1); PG8_BAR; PG8_SCHED;
            PG8_LDB(B0, 1, 0); PG8_LDB(B1, 1, 1); PG8_SCHED; PG8_LDA(At, 1, 0); PG8_STAGE(PG8_SA(0, 1), a2 + hstepA, voffA);
            PG8_WAIT_V(8); PG8_WAIT_L(0); PG8_BAR; PG8_MMA(0, 0, At, B0); PG8_MMA(0, 1, At, B1); PG8_BAR; PG8_SCHED;
            PG8_LDA(At, 1, 1); PG8_STAGE(PG8_SB(1, 0), b3, voffB); PG8_STAGE(PG8_SB(1, 1), b3 + hstepB, voffB); PG8_STAGE(PG8_SA(1, 0), a3, voffA);
            PG8_WAIT_V(8); PG8_WAIT_L(0); PG8_BAR; PG8_MMA(1, 0, At, B0); PG8_MMA(1, 1, At, B1); PG8_BAR; PG8_SCHED;
            } else {
            PG8_LDB(B0, 0, 0); PG8_SCHED; PG8_LDA(At, 0, 0); PG8_STAGE(PG8_SA(1, 1), a1 + hstepA, voffA);
            PG8_WAIT_L(8); PG8_BAR; PG8_WAIT_L(0); PG8_MMA(0, 0, At, B0); PG8_BAR; PG8_SCHED;
            PG8_LDB(B1, 0, 1); PG8_STAGE(PG8_SB(0, 0), b2, voffB);
            PG8_BAR; PG8_WAIT_L(0); PG8_MMA(0, 1, At, B1); PG8_BAR;
            PG8_LDA(At, 0, 1); PG8_STAGE(PG8_SA(0, 0), a2, voffA);
            PG8_BAR; PG8_WAIT_L(0); PG8_MMA(1, 0, At, B0); PG8_BAR; PG8_SCHED;
            PG8_STAGE(PG8_SB(0, 1), b2 + hstepB, voffB);
            PG8_WAIT_V(6); PG8_BAR; PG8_MMA(1, 1, At, B1); PG8_BAR;
            PG8_LDB(B0, 1, 0); PG8_SCHED; PG8_LDA(At, 1, 0); PG8_STAGE(PG8_SA(0, 1), a2 + hstepA, voffA);
            PG8_WAIT_L(8); PG8_BAR; PG8_WAIT_L(0); PG8_MMA(0, 0, At, B0); PG8_BAR; PG8_SCHED;
            PG8_LDB(B1, 1, 1); PG8_STAGE(PG8_SB(1, 0), b3, voffB);
            PG8_BAR; PG8_WAIT_L(0); PG8_MMA(0, 1, At, B1); PG8_BAR;
            PG8_LDA(At, 1, 1); PG8_STAGE(PG8_SA(1, 0), a3, voffA);
            PG8_BAR; PG8_WAIT_L(0); PG8_MMA(1, 0, At, B0); PG8_BAR; PG8_SCHED;
            PG8_STAGE(PG8_SB(1, 1), b3 + hstepB, voffB);
            PG8_WAIT_V(6); PG8_BAR; PG8_MMA(1, 1, At, B1); PG8_BAR;
            }
        }
        if constexpr (ALIGN_EPI) { if (wr == 0) PG8_BAR; }
        if constexpr (!Epi::AFTER_DRAIN) { E(acc, cur, wr, wc, fr, fq); S.done(cur); }
        if (!has_next) break;
#pragma unroll
        for (int a = 0; a < 2; ++a)
#pragma unroll
            for (int b = 0; b < 2; ++b)
#pragma unroll
                for (int m = 0; m < 4; ++m)
#pragma unroll
                    for (int n = 0; n < 2; ++n) acc[a][b][m][n] = (f32x4){0.f, 0.f, 0.f, 0.f};
        cur = nxt; cA = nA; cB = nB; ++ui;
        if constexpr (ALIGN_EPI) { if (wr == 1) PG8_BAR; }
    }
    PG8_WAIT_V(0);
    if constexpr (!ALIGN_EPI) { if (wr == 0) PG8_BAR; }
    PG8_BAR;
    if constexpr (Epi::AFTER_DRAIN) { E.fused(acc, cur, wr, wc, fr, fq, lds, wid, lane); S.done(cur); }
#undef PG8_SA
#undef PG8_SB
#undef PG8_STAGE
#undef PG8_LDA
#undef PG8_LDB
#undef PG8_MMA
#undef PG8_WAIT_V
#undef PG8_WAIT_L
#undef PG8_BAR
#undef PG8_SCHED
}
}

#ifndef REP0
#define REP0 1
#endif
#ifndef REP3
#define REP3 1
#endif
#ifndef REP8
#define REP8 1
#endif
#ifndef REP4
#define REP4 1
#endif
#ifndef REP4S
#define REP4S 1
#endif
#ifndef REP2
#define REP2 1
#endif
#ifndef REP2S
#define REP2S 1
#endif
#define LAS __attribute__((address_space(3)))
typedef unsigned short bf16;
typedef float f32x4 __attribute__((ext_vector_type(4)));
typedef unsigned v4u __attribute__((ext_vector_type(4)));
typedef unsigned v2u __attribute__((ext_vector_type(2)));

constexpr int NB = 4, SEQ = 8192, D = 1024, PADR = 48, NREAL = NB * SEQ, MP = NREAL + NB * 64;
__device__ __forceinline__ int chunk_row0(int b, int c0) { return c0 == 0 ? NREAL + 64 * b : b * SEQ + 64 * (c0 - 1); }
constexpr int RW = 512, PROJW = 4352, DFF = 2816, UPW = 2 * DFF;
constexpr int C_K = 512, C_V = 1024, C_WD = 1536, C_AD = 1600, C_GD = 1664, C_U = 1792, C_GA = 2304, C_GB = 3328;
constexpr size_t QB = (size_t)MP * 512 * 2;
constexpr size_t WO_WIN = 1u << 20, WO_WBR = WO_WIN + (size_t)PROJW * D * 2, WO_WGLU = WO_WBR + (size_t)D * RW * 2, WO_WOUT = WO_WGLU + (size_t)2 * D * RW * 2,
                 WO_WUP = WO_WOUT + (size_t)D * D * 2, WO_WDN = WO_WUP + (size_t)UPW * D * 2, WO_END = WO_WDN + (size_t)D * DFF * 2;
static_assert(WO_END <= QB, "weights fit in the first quantum");
constexpr size_t WO_WUPT = WO_END, WO_AUPT = WO_WUPT + 65536, WO_GUPT = WO_AUPT + 65536, WO_END2 = WO_GUPT + 131072;
static_assert(WO_END2 <= QB, "small tables fit in the first quantum");
constexpr size_t WS_HN = QB, WS_GF = QB, WS_HF = 2 * QB, WS_PROJ = 3 * QB, WS_YR = 11 * QB + QB / 2, WS_QT = WS_YR + QB, WS_YB = WS_QT + QB, WS_BON = WS_YB + 2 * QB, WS_END = WS_BON + (size_t)MP * 8 * 4;
constexpr size_t WS_MIXIN = QB, WS_MIX = WS_YR, WS_HN2 = QB, WS_UP = 3 * QB, WS_F = QB;
constexpr int NCH = 129, NUNIT = NB * 8 * NCH, S5UNITS = NB * 32 * NCH;
constexpr size_t WO_BRT = WO_END2, WO_CRT = WO_BRT + 131072, WO_LAM = WO_CRT + 131072, WO_LAM64 = WO_LAM + 16384, WO_END3 = WO_LAM64 + 16384;
static_assert(WO_END3 <= QB, "S5 tables fit in the first quantum");
constexpr size_t WS_Z = WS_YB, WS_X0 = WS_Z + (size_t)NB * NCH * 4096 * 4, WS_S0 = WS_X0 + (size_t)NB * NCH * 4096 * 4;
static_assert(WS_S0 + QB <= WS_YB + 2 * QB, "S0 fits in the YB region");
static_assert(WS_END <= 536870912ull, "workspace");
constexpr int OP = 72, OPB = 64 * OP * 2, MISC_OFF = 17 * OPB;
constexpr int LDS_BYTES = 159744, XB_LDS_OFF = 159488;
typedef short bf16x8 __attribute__((ext_vector_type(8)));

__device__ __forceinline__ float bf2f(unsigned h) { return __uint_as_float(h << 16); }
typedef float f32x2_t __attribute__((ext_vector_type(2))); typedef __bf16 bf16x2_t __attribute__((ext_vector_type(2)));
__device__ __forceinline__ unsigned pk2(float lo, float hi) { const f32x2_t v = {lo, hi}; const bf16x2_t b = __builtin_convertvector(v, bf16x2_t); return __builtin_bit_cast(unsigned, b); }
__device__ __forceinline__ unsigned f2bf(float f) { return pk2(f, 0.f) & 0xffffu; }
__device__ __forceinline__ void unpack8(const v4u q, float (&o)[8]) {
    o[0] = __uint_as_float(q.x << 16); o[1] = __uint_as_float(q.x & 0xffff0000u); o[2] = __uint_as_float(q.y << 16); o[3] = __uint_as_float(q.y & 0xffff0000u);
    o[4] = __uint_as_float(q.z << 16); o[5] = __uint_as_float(q.z & 0xffff0000u); o[6] = __uint_as_float(q.w << 16); o[7] = __uint_as_float(q.w & 0xffff0000u);
}
__device__ __forceinline__ v4u pack8(const float (&o)[8]) { v4u w; w.x = pk2(o[0], o[1]); w.y = pk2(o[2], o[3]); w.z = pk2(o[4], o[5]); w.w = pk2(o[6], o[7]); return w; }
template <int CTRL> __device__ __forceinline__ float dppf(float v) { return __int_as_float(__builtin_amdgcn_update_dpp(0, __float_as_int(v), CTRL, 0xf, 0xf, true)); }
__device__ __forceinline__ float wave_sum(float v) {
    v += dppf<0xB1>(v); v += dppf<0x4E>(v); v += dppf<0x141>(v); v += dppf<0x140>(v);
    const int iv = __float_as_int(v);
    return (__int_as_float(__builtin_amdgcn_readlane(iv, 0)) + __int_as_float(__builtin_amdgcn_readlane(iv, 16))) + (__int_as_float(__builtin_amdgcn_readlane(iv, 32)) + __int_as_float(__builtin_amdgcn_readlane(iv, 48)));
}
__device__ __forceinline__ float tanh_fast(float x) { return 1.f - 2.f / (__expf(2.f * x) + 1.f); }
__device__ __forceinline__ float sigm(float x) { return 1.f / (1.f + __expf(-x)); }
__device__ __forceinline__ float gelu_t(float x) { const float z = 0.7978845608f * (x + 0.044715f * x * x * x); const float t = 1.f - 2.f / (__expf(2.f * z) + 1.f); return 0.5f * x * (1.f + t); }

#define SLOT(i) (ldsl + (i) * OPB)
__device__ __forceinline__ bf16x8 ldfrag(const LAS unsigned char* buf, int r0, int ks, int lane) { return *(const LAS bf16x8*)(buf + ((r0 + (lane & 15)) * OP + 32 * ks + 8 * (lane >> 4)) * 2); }
__device__ __forceinline__ f32x4 tmm(const LAS unsigned char* X, int x0, const LAS unsigned char* Y, int y0, f32x4 acc, int lane) {
#pragma unroll
    for (int ks = 0; ks < 2; ++ks) acc = __builtin_amdgcn_mfma_f32_16x16x32_bf16(ldfrag(X, x0, ks, lane), ldfrag(Y, y0, ks, lane), acc, 0, 0, 0);
    return acc; }
__device__ __forceinline__ f32x4 tmmk(const LAS unsigned char* X, int x0, const LAS unsigned char* Y, int y0, f32x4 acc, int lane, bool k0, bool k1) {
    if (k0) acc = __builtin_amdgcn_mfma_f32_16x16x32_bf16(ldfrag(X, x0, 0, lane), ldfrag(Y, y0, 0, lane), acc, 0, 0, 0);
    if (k1) acc = __builtin_amdgcn_mfma_f32_16x16x32_bf16(ldfrag(X, x0, 1, lane), ldfrag(Y, y0, 1, lane), acc, 0, 0, 0);
    return acc; }
struct RawA { unsigned r[9], k[9], v[9], w[9], a[9]; };
__device__ __forceinline__ void a0_load(RawA& R, const unsigned short* PROJ, int unit, int tq, int c) {
    const int c0 = unit % 129, bh = unit / 129, b = bh >> 3, h = bh & 7, hc = h * 64 + c;
    const int row0 = c0 == 0 ? 32768 + 64 * b : b * 8192 + 64 * (c0 - 1), prow = (c0 == 1) ? 32768 + 64 * b + 63 : row0 - 1;
#pragma unroll
    for (int i = 0; i < 9; ++i) {
        const int rr_ = 8 * tq + i - 1; const bool valid = (c0 > 0) || (rr_ >= 0);
        const unsigned short* p = PROJ + (size_t)(rr_ >= 0 ? row0 + rr_ : (valid ? prow : row0)) * 4352;
        R.r[i] = valid ? p[hc] : 0u; R.k[i] = valid ? p[512 + hc] : 0u; R.v[i] = valid ? p[1024 + hc] : 0u; R.w[i] = valid ? p[1536 + c] : 0u; R.a[i] = valid ? p[1600 + c] : 0u;
    }
}
__device__ __forceinline__ void st4(LAS unsigned char* buf, int y, int x, f32x4 v) { *(LAS v2u*)(buf + (y * OP + x) * 2) = (v2u){pk2(v[0], v[1]), pk2(v[2], v[3])}; }
struct FStoreBf16 { bf16* O; int ldc;
    __device__ __forceinline__ void operator()(int row, int pn, int cw, f32x4 a00, f32x4 a01, f32x4 a10, f32x4 a11) const {
        bf16* p = O + (size_t)row * ldc + pn * 256 + cw;
        v4u w; w.x = pk2(a00[0], a00[1]); w.y = pk2(a00[2], a00[3]); w.z = pk2(a01[0], a01[1]); w.w = pk2(a01[2], a01[3]); *(v4u*)p = w;
        w.x = pk2(a10[0], a10[1]); w.y = pk2(a10[2], a10[3]); w.z = pk2(a11[0], a11[1]); w.w = pk2(a11[2], a11[3]); *(v4u*)(p + 128) = w; } };
struct FStoreF32 { float* O; int ldc;
    __device__ __forceinline__ void operator()(int row, int pn, int cw, f32x4 a00, f32x4 a01, f32x4 a10, f32x4 a11) const {
        float* p = O + (size_t)row * ldc + pn * 256 + cw;
        *(f32x4*)p = a00; *(f32x4*)(p + 4) = a01; *(f32x4*)(p + 128) = a10; *(f32x4*)(p + 132) = a11; } };
struct FGlu { bf16* YB;
    __device__ __forceinline__ void operator()(int row, int pn, int cw, f32x4 a00, f32x4 a01, f32x4 a10, f32x4 a11) const {
        float y[8];
#pragma unroll
        for (int e = 0; e < 4; ++e) { y[e] = a00[e] * sigm(a10[e]); y[4 + e] = a01[e] * sigm(a11[e]); }
        *(v4u*)(YB + (size_t)row * D + pn * 128 + cw) = pack8(y); } };
struct FMixin { const bf16* PROJ; const bf16* YB; bf16* MIXIN;
    __device__ __forceinline__ void one(int row, int col, f32x4 a0, f32x4 a1) const {
        float ga[8], gb[8], yb[8], o[8];
        unpack8(*(const v4u*)(PROJ + (size_t)row * PROJW + C_GA + col), ga); unpack8(*(const v4u*)(PROJ + (size_t)row * PROJW + C_GB + col), gb);
        unpack8(*(const v4u*)(YB + (size_t)row * D + col), yb);
#pragma unroll
        for (int e = 0; e < 4; ++e) { o[e] = sigm(ga[e]) * a0[e] + sigm(gb[e]) * yb[e]; o[4 + e] = sigm(ga[4 + e]) * a1[e] + sigm(gb[4 + e]) * yb[4 + e]; }
        *(v4u*)(MIXIN + (size_t)row * D + col) = pack8(o); }
    __device__ __forceinline__ void operator()(int row, int pn, int cw, f32x4 a00, f32x4 a01, f32x4 a10, f32x4 a11) const {
        one(row, pn * 256 + cw, a00, a01); one(row, pn * 256 + 128 + cw, a10, a11); } };

template <bool OUT> __device__ __forceinline__ void s5_unit(int id, bf16* PROJ, const bf16* BRT, const bf16* CRT, const float* LAM, const float* dvec, float* Z, const float* X0, LAS unsigned char* wl, int lane) {
    const int b = id / (32 * NCH), rem = id % (32 * NCH), g = rem / NCH, c0 = rem % NCH, row0 = chunk_row0(b, c0), lj = lane & 15, lq = lane >> 4, n = lane;
    LAS float* BU = (LAS float*)wl; LAS unsigned char* Xs = wl + 10240;
    const bf16x8 zf = {0, 0, 0, 0, 0, 0, 0, 0};
    bf16x8 bfrag[8];
#pragma unroll
    for (int nt = 0; nt < 8; ++nt) bfrag[nt] = lq < 2 ? *(const bf16x8*)(BRT + ((size_t)(g * 128 + 16 * nt + lj) * 16 + 8 * lq)) : zf;
    bf16x8 cfrag[4]; float dd[4];
    if (OUT) {
#pragma unroll
        for (int ks = 0; ks < 4; ++ks) cfrag[ks] = *(const bf16x8*)(CRT + ((size_t)(g * 16 + lj) * 128 + 32 * ks + 8 * lq));
#pragma unroll
        for (int r = 0; r < 4; ++r) dd[r] = dvec[g * 16 + 4 * lq + r];
    }
    const float lr = LAM[(g * 64 + n) * 2], li = LAM[(g * 64 + n) * 2 + 1];
    const size_t zi = ((size_t)(b * NCH + c0)) * 4096 + g * 128 + n;
    float xr = 0.f, xi = 0.f;
    if (OUT && c0 > 0) { xr = X0[zi]; xi = X0[zi + 64]; }
    bf16* up0 = PROJ + (size_t)(row0 + lj) * PROJW + C_U + g * 16;
    bf16x8 ufn = lq < 2 ? *(const bf16x8*)(up0 + 8 * lq) : zf; v2u u4n = {0u, 0u}; if (OUT) u4n = *(const v2u*)(up0 + 4 * lq);
#pragma unroll 1
    for (int rd = 0; rd < 4; ++rd) { const bool lastrep = true;
        bf16* up = PROJ + (size_t)(row0 + 16 * rd + lj) * PROJW + C_U + g * 16;
        const bf16x8 ufrag = ufn; const v2u u4 = u4n;
        if (rd < 3) { const bf16* upn = up + (size_t)16 * PROJW; ufn = lq < 2 ? *(const bf16x8*)(upn + 8 * lq) : zf; if (OUT) u4n = *(const v2u*)(upn + 4 * lq); }
#pragma unroll
        for (int nt = 0; nt < 8; ++nt) { const f32x4 d = __builtin_amdgcn_mfma_f32_16x16x32_bf16(ufrag, bfrag[nt], (f32x4){0.f, 0.f, 0.f, 0.f}, 0, 0, 0);
            *(LAS f32x4*)(BU + (16 * nt + lj) * 20 + 4 * lq) = d; }
        asm volatile("s_waitcnt lgkmcnt(0)" ::: "memory");
#pragma unroll
        for (int t4 = 0; t4 < 4; ++t4) {
            const f32x4 br = *(const LAS f32x4*)(BU + n * 20 + 4 * t4), bi = *(const LAS f32x4*)(BU + (64 + n) * 20 + 4 * t4);
#pragma unroll
            for (int r = 0; r < 4; ++r) {
                const float nxr = lr * xr - li * xi + br[r], nxi = lr * xi + li * xr + bi[r]; xr = nxr; xi = nxi;
                if (OUT) { *(LAS bf16*)(Xs + ((4 * t4 + r) * 136 + n) * 2) = (bf16)f2bf(xr); *(LAS bf16*)(Xs + ((4 * t4 + r) * 136 + 64 + n) * 2) = (bf16)f2bf(xi); }
            }
        }
        if (OUT) {
            asm volatile("s_waitcnt lgkmcnt(0)" ::: "memory");
            f32x4 y = {0.f, 0.f, 0.f, 0.f};
#pragma unroll
            for (int ks = 0; ks < 4; ++ks) y = __builtin_amdgcn_mfma_f32_16x16x32_bf16(cfrag[ks], *(const LAS bf16x8*)(Xs + (lj * 136 + 32 * ks + 8 * lq) * 2), y, 0, 0, 0);
            const float u0 = __uint_as_float(u4.x << 16), u1 = __uint_as_float(u4.x & 0xffff0000u), u2 = __uint_as_float(u4.y << 16), u3 = __uint_as_float(u4.y & 0xffff0000u);
            if (lastrep) *(v2u*)(up + 4 * lq) = (v2u){pk2(gelu_t(y[0] + dd[0] * u0), gelu_t(y[1] + dd[1] * u1)), pk2(gelu_t(y[2] + dd[2] * u2), gelu_t(y[3] + dd[3] * u3))};
        }
        asm volatile("s_waitcnt lgkmcnt(0)" ::: "memory");
    }
    if (!OUT) { Z[zi] = xr; Z[zi + 64] = xi; }
}

template <int K> __device__ __forceinline__ void dot2b(const bf16* wrow, const bf16* a0, const bf16* a1, int lane, float& s0, float& s1) {
    float p0 = 0.f, p1 = 0.f;
#pragma unroll
    for (int kk = 0; kk < K / 512; ++kk) { float wf[8], x0[8], x1[8]; unpack8(*(const v4u*)(wrow + kk * 512 + lane * 8), wf); unpack8(*(const v4u*)(a0 + kk * 512 + lane * 8), x0); unpack8(*(const v4u*)(a1 + kk * 512 + lane * 8), x1);
#pragma unroll
        for (int e = 0; e < 8; ++e) { p0 += wf[e] * x0[e]; p1 += wf[e] * x1[e]; } }
    s0 = wave_sum(p0); s1 = wave_sum(p1);
}
template <int K> __device__ __forceinline__ void dot2f(const bf16* wrow, const float* a0, const float* a1, int lane, float& s0, float& s1) {
    float p0 = 0.f, p1 = 0.f;
#pragma unroll
    for (int kk = 0; kk < K / 512; ++kk) { float wf[8]; unpack8(*(const v4u*)(wrow + kk * 512 + lane * 8), wf);
        const f32x4 xa = *(const f32x4*)(a0 + kk * 512 + lane * 8), xb = *(const f32x4*)(a0 + kk * 512 + lane * 8 + 4), ya = *(const f32x4*)(a1 + kk * 512 + lane * 8), yb = *(const f32x4*)(a1 + kk * 512 + lane * 8 + 4);
#pragma unroll
        for (int e = 0; e < 4; ++e) { p0 += wf[e] * xa[e] + wf[4 + e] * xb[e]; p1 += wf[e] * ya[e] + wf[4 + e] * yb[e]; } }
    s0 = wave_sum(p0); s1 = wave_sum(p1);
}

struct Args { const float* in[33]; float* out; unsigned char* ws; };

__device__ __forceinline__ void transpose_item(const float* W, int K, int N, bf16* WT, int glu, float* scr, int item, int lane) {
    const int nblk = N / 32, kb = item / nblk, nb = item % nblk, k0 = 64 * kb, n0 = 32 * nb;
#pragma unroll 8
    for (int i = 0; i < 32; ++i) { const int kk = 2 * i + (lane >> 5); scr[kk * 33 + (lane & 31)] = W[(size_t)(k0 + kk) * N + n0 + (lane & 31)]; }
    asm volatile("s_waitcnt lgkmcnt(0)" ::: "memory");
    int d0 = n0; if (glu) { const int bj = n0 / 1024, rem = n0 % 1024; d0 = 256 * (rem / 128) + 128 * bj + (rem % 128); }
    const int c = lane & 7;
#pragma unroll
    for (int j = 0; j < 4; ++j) { const int n = (lane >> 3) + 8 * j; const float* s = scr + (8 * c) * 33 + n;
        v4u o; o.x = pk2(s[0 * 33], s[1 * 33]); o.y = pk2(s[2 * 33], s[3 * 33]); o.z = pk2(s[4 * 33], s[5 * 33]); o.w = pk2(s[6 * 33], s[7 * 33]);
        *(v4u*)(WT + (size_t)(d0 + n) * K + k0 + 8 * c) = o; }
    asm volatile("s_waitcnt lgkmcnt(0)" ::: "memory");
}

__device__ __forceinline__ float shiftv(const bf16* PROJ, int row, int j, int col, float mu) {
    const float cur = bf2f(PROJ[(size_t)row * PROJW + col]); const float prev = j > 0 ? bf2f(PROJ[(size_t)(row - 1) * PROJW + col]) : 0.f;
    return cur + (prev - cur) * mu;
}

#define XB_TMO      128
#define XB_XCNT(j)  (256  + 64 * (j))
#define XB_XSUB(j)  (1280 + 64 * (j))
#define XB_XGEN(j)  (2304 + 64 * (j))
#define XB_TOP      3328
#define XB_TOPGEN   3392
#define XCD_BAR_WORDS 3456
#define XB_SPIN_CAP (1u << 18)

__device__ __forceinline__ unsigned xb_ld(unsigned* p)              { return __hip_atomic_load(p, __ATOMIC_RELAXED, __HIP_MEMORY_SCOPE_AGENT); }
__device__ __forceinline__ unsigned xb_add(unsigned* p, unsigned v) { return __hip_atomic_fetch_add(p, v, __ATOMIC_RELAXED, __HIP_MEMORY_SCOPE_AGENT); }
__device__ __forceinline__ unsigned xb_xcc_id() { return (unsigned)__builtin_amdgcn_s_getreg((3 << 11) | 20) & 0xFu; }
#define XB_SPIN(cond, bar) do { unsigned _sp = 0; while (cond) { __builtin_amdgcn_s_sleep(1); \
    if ((++_sp & 255u) == 0u) { if (xb_ld(&(bar)[XB_TMO])) break; if (_sp > XB_SPIN_CAP) { atomicAdd(&(bar)[XB_TMO], 1u); break; } } } } while (0)

struct XcdBarrier {
    unsigned* bar; unsigned x;
    volatile LAS unsigned* st;
};

__device__ __forceinline__ XcdBarrier xcd_barrier_post(unsigned* bar, volatile LAS unsigned* st) {
    XcdBarrier b; b.bar = bar; b.x = xb_xcc_id(); b.st = st;
    if (threadIdx.x == 0) (void)xb_add(&bar[XB_XCNT(b.x)], 1u);
    return b;
}
__device__ __forceinline__ void xcd_barrier_complete(unsigned* bar, unsigned x, unsigned& nloc, unsigned& nx) {
    const unsigned G = gridDim.x * gridDim.y * gridDim.z;
    unsigned sum, cnt, mine, sp = 0u;
    for (;;) {
        sum = 0u; cnt = 0u; mine = 0u;
#pragma unroll
        for (unsigned j = 0; j < 16; ++j) { const unsigned c = xb_ld(&bar[XB_XCNT(j)]); sum += c; cnt += (c > 0u) ? 1u : 0u; mine = (j == x) ? c : mine; }
        if (sum == G) break;
        __builtin_amdgcn_s_sleep(1);
        if ((++sp & 255u) == 0u) { if (xb_ld(&bar[XB_TMO])) break; if (sp > XB_SPIN_CAP) { atomicAdd(&bar[XB_TMO], 1u); break; } }
    }
    nloc = mine > 0u ? mine : 1u; nx = cnt > 0u ? cnt : 1u;
}

__device__ __forceinline__ void xcd_barrier(const XcdBarrier& b) {
    asm volatile("s_waitcnt vmcnt(0)" ::: "memory");
    __syncthreads();
    if (threadIdx.x == 0) {
        unsigned* bar = b.bar;
        __builtin_amdgcn_s_waitcnt(0);
        unsigned nloc = b.st[0], nx = b.st[1];
        if (nloc == 0u) { xcd_barrier_complete(bar, b.x, nloc, nx); b.st[0] = nloc; b.st[1] = nx; }
        const unsigned old = xb_add(&bar[XB_XSUB(b.x)], 1u);
        const unsigned gen = old / nloc;
        if (old + 1u == (gen + 1u) * nloc) {
            __builtin_amdgcn_fence(__ATOMIC_RELEASE, "agent");
            asm volatile("s_waitcnt vmcnt(0)" ::: "memory");
            const unsigned og = xb_add(&bar[XB_TOP], 1u);
            const unsigned tg = og / nx;
            if (og + 1u == (tg + 1u) * nx) xb_add(&bar[XB_TOPGEN], 1u);
            else XB_SPIN(xb_ld(&bar[XB_TOPGEN]) == tg, bar);
            __builtin_amdgcn_fence(__ATOMIC_ACQUIRE, "agent");
            xb_add(&bar[XB_XGEN(b.x)], 1u);
            asm volatile("s_waitcnt vmcnt(0)" ::: "memory");
        } else {
            XB_SPIN(xb_ld(&bar[XB_XGEN(b.x)]) == gen, bar);
            __builtin_amdgcn_fence(__ATOMIC_ACQUIRE, "agent");
            asm volatile("s_waitcnt vmcnt(0)" ::: "memory");
        }
    }
    __syncthreads();
}

typedef const __attribute__((address_space(4))) Args* KArgsP;
__device__ __forceinline__ KArgsP kargs() { KArgsP p = (KArgsP)__builtin_amdgcn_kernarg_segment_ptr(); asm volatile("" : "+s"(p)); return p; }
struct RawC { unsigned vv[9], g0[9], g1[9]; v2u s[2][2][2]; bf16x8 q[2]; v2u yl[2]; float bon[8]; };
__device__ __forceinline__ void c_load(RawC& R, const bf16* PROJ, const bf16* S0B, const bf16* QT, const bf16* YR, const float* BON, int unit, int wave, int lane) {
    const int c0 = unit % NCH, bh = unit / NCH, b = bh >> 3, h = bh & 7, row0 = chunk_row0(b, c0), prow = (c0 == 1) ? NREAL + 64 * b + 63 : row0 - 1, tq = wave, c = lane, hc = h * 64 + c;
    const int ty = wave >> 1, txb = 2 * (wave & 1), lj = lane & 15, lq = lane >> 4, yy = 16 * ty + lj;
#pragma unroll
    for (int i = 0; i < 9; ++i) {
        const bool valid = (c0 > 0) || (8 * tq + i > 0);
        const int rr_ = 8 * tq + i - 1; const bf16* p = PROJ + (size_t)(rr_ >= 0 ? row0 + rr_ : (valid ? prow : row0)) * PROJW;
        R.vv[i] = valid ? p[C_V + hc] : 0u; R.g0[i] = valid ? p[C_GD + c] : 0u; R.g1[i] = valid ? p[C_GD + 64 + c] : 0u;
    }
    const bf16* sp = S0B + (size_t)(c0 > 0 ? unit - 1 : unit) * 4096; const bf16* qp = QT + (size_t)unit * 4096;
#pragma unroll
    for (int kq = 0; kq < 2; ++kq) {
        const bf16x8 zq = {0, 0, 0, 0, 0, 0, 0, 0};
        R.q[kq] = c0 > 0 ? *(const bf16x8*)(qp + yy * 64 + 32 * kq + 8 * lq) : zq;
#pragma unroll
        for (int e = 0; e < 2; ++e) { const int tx = txb + e;
            const v2u z2 = {0u, 0u};
            R.s[e][kq][0] = c0 > 0 ? *(const v2u*)(sp + ((tx * 4 + 2 * kq + (lq >> 1)) * 64 + 16 * (2 * (lq & 1)) + lj) * 4) : z2;
            R.s[e][kq][1] = c0 > 0 ? *(const v2u*)(sp + ((tx * 4 + 2 * kq + (lq >> 1)) * 64 + 16 * (2 * (lq & 1) + 1) + lj) * 4) : z2; }
    }
#pragma unroll
    for (int e = 0; e < 2; ++e) R.yl[e] = *(const v2u*)(YR + (size_t)(row0 + yy) * RW + h * 64 + 16 * (txb + e) + 4 * lq);
#pragma unroll
    for (int u = 0; u < 8; ++u) R.bon[u] = BON[(size_t)(row0 + 8 * tq + u) * 8 + h];
}
#define RWKV_C_UNIT(unit, nxt) do { \
            const int c0 = unit % NCH, bh = unit / NCH, b = bh >> 3, h = bh & 7, row0 = chunk_row0(b, c0), tq = wave, c = lane, hc = h * 64 + c; \
            float vs[8], bon[8]; \
            { \
                float vv[9], g0[9], g1[9]; \
_Pragma("unroll") \
                for (int i = 0; i < 9; ++i) { vv[i] = bf2f(rawc.vv[i]); g0[i] = bf2f(rawc.g0[i]); g1[i] = bf2f(rawc.g1[i]); } \
_Pragma("unroll") \
                for (int u = 0; u < 8; ++u) bon[u] = rawc.bon[u]; \
                const float muv = mu[C_V + hc], mg0 = mu[C_GD + c], mg1 = mu[C_GD + 64 + c]; \
_Pragma("unroll") \
                for (int u = 0; u < 8; ++u) { \
                    vs[u] = vv[u + 1] + (vv[u] - vv[u + 1]) * muv; \
                    *(LAS bf16*)(SG + ((8 * tq + u) * 136 + c) * 2) = (bf16)f2bf(sigm(g0[u + 1] + (g0[u] - g0[u + 1]) * mg0)); \
                    *(LAS bf16*)(SG + ((8 * tq + u) * 136 + 64 + c) * 2) = (bf16)f2bf(sigm(g1[u + 1] + (g1[u] - g1[u + 1]) * mg1)); \
                } \
            } \
 \
_Pragma("unroll") \
            for (int e = 0; e < 2; ++e) { \
                const int tx = txb + e, xs = 16 * tx + 4 * lq; \
                f32x4 v = {0.f, 0.f, 0.f, 0.f}; \
_Pragma("unroll") \
                for (int kq = 0; kq < 2; ++kq) { \
                    const v4u sw = {rawc.s[e][kq][0].x, rawc.s[e][kq][0].y, rawc.s[e][kq][1].x, rawc.s[e][kq][1].y}; \
                    v = __builtin_amdgcn_mfma_f32_16x16x32_bf16(__builtin_bit_cast(bf16x8, sw), rawc.q[kq], v, 0, 0, 0); \
                } \
                const v2u yl = rawc.yl[e]; \
                v[0] += __uint_as_float(yl.x << 16); v[1] += __uint_as_float(yl.x & 0xffff0000u); v[2] += __uint_as_float(yl.y << 16); v[3] += __uint_as_float(yl.y & 0xffff0000u); \
                *(f32x4*)(Yf + yy * 68 + xs) = v; \
            } \
            if ((nxt) >= 0) c_load(rawc, PROJ, S0B, QT, YR, BON, (nxt), wave, lane); \
            __syncthreads(); \
 \
_Pragma("unroll") \
            for (int e = 0; e < 2; ++e) { \
                const int x0 = 16 * (txb + e), xs = x0 + 4 * lq; \
                f32x4 v = {0.f, 0.f, 0.f, 0.f}; \
_Pragma("unroll") \
                for (int kq = 0; kq < 4; ++kq) { \
                    const bf16x8 fg = *(const bf16x8*)(GUPT + (size_t)(h * 64 + x0 + lj) * 128 + 32 * kq + 8 * lq); \
                    const bf16x8 fs = *(const LAS bf16x8*)(SG + ((y0 + lj) * 136 + 32 * kq + 8 * lq) * 2); \
                    v = __builtin_amdgcn_mfma_f32_16x16x32_bf16(fg, fs, v, 0, 0, 0); \
                } \
                *(f32x4*)(Gf32 + yy * 68 + xs) = v; \
            } \
            __syncthreads(); \
            { \
                const float lg = ln_g[hc], lb = ln_b[hc]; \
_Pragma("unroll") \
                for (int u = 0; u < 8; ++u) { \
                    const int t = 8 * tq + u; \
                    const float y = Yf[t * 68 + c]; const float mean = wave_sum(y) * (1.f / 64.f); const float dv = y - mean; const float var = wave_sum(dv * dv) * (1.f / 64.f); \
                    const float yn = dv * rsqrtf(var + 64e-5f) * lg + lb; \
                    const float bonus = bon[u] * vs[u]; \
                    YR[(size_t)(row0 + t) * RW + hc] = (bf16)f2bf((yn + bonus) * Gf32[t * 68 + c]); \
                } \
            } \
            __syncthreads(); \
} while (0)
#define RWKV_C_DEFS const float* mu = ka->in[5]; const float* ln_g = ka->in[14]; const float* ln_b = ka->in[15]; \
        LAS unsigned char* SG = ldsl; float* Yf = (float*)(lds + 17408); float* Gf32 = Yf + 64 * 68; \
        const int ty = wave >> 1, txb = 2 * (wave & 1), lj = lane & 15, lq = lane >> 4, y0 = 16 * ty, yy = y0 + lj;
#define PHASE_PTRS KArgsP ka = kargs(); unsigned char* ws = ka->ws; \
    const float* x = ka->in[0]; const float* meta = ka->in[1]; \
    bf16* WIN_T = (bf16*)(ws + WO_WIN); bf16* WBR_T = (bf16*)(ws + WO_WBR); bf16* WGLU_T = (bf16*)(ws + WO_WGLU); bf16* WOUT_T = (bf16*)(ws + WO_WOUT); \
    bf16* WUP_T = (bf16*)(ws + WO_WUP); bf16* WDN_T = (bf16*)(ws + WO_WDN); \
    bf16* HN = (bf16*)(ws + WS_HN); bf16* PROJ = (bf16*)(ws + WS_PROJ); \
    bf16* GF = (bf16*)(ws + WS_GF); bf16* HF = (bf16*)(ws + WS_HF); bf16* YR = (bf16*)(ws + WS_YR); bf16* QT = (bf16*)(ws + WS_QT); float* BON = (float*)(ws + WS_BON); \
    bf16* BRT = (bf16*)(ws + WO_BRT); bf16* CRT = (bf16*)(ws + WO_CRT); float* LAM = (float*)(ws + WO_LAM); float* LAM64 = (float*)(ws + WO_LAM64); float* ZB = (float*)(ws + WS_Z); float* X0B = (float*)(ws + WS_X0); bf16* S0B = (bf16*)(ws + WS_S0); float* YBm = (float*)(ws + 65536); float* MIXINm = YBm + 2048; float* MIXm = YBm + 4096; float* HN2m = YBm + 6144; \
    bf16* WUPT = (bf16*)(ws + WO_WUPT); bf16* AUPT = (bf16*)(ws + WO_AUPT); bf16* GUPT = (bf16*)(ws + WO_GUPT); \
    bf16* YB = (bf16*)(ws + WS_YB); bf16* MIXIN = (bf16*)(ws + WS_MIXIN); bf16* MIX = (bf16*)(ws + WS_MIX); bf16* HN2 = (bf16*)(ws + WS_HN2); bf16* UP = (bf16*)(ws + WS_UP); bf16* FB = (bf16*)(ws + WS_F);
__global__ void __launch_bounds__(512, 2) mega(Args a_unused) {
    extern __shared__ __attribute__((aligned(16))) unsigned char lds[];
    cg::grid_group grid = cg::this_grid();
    const int tid = threadIdx.x, lane = tid & 63, wave = __builtin_amdgcn_readfirstlane(tid >> 6);
    const int G = gridDim.x, gw = blockIdx.x * 8 + wave, NGW = G * 8;
    LAS unsigned char* ldsl = (LAS unsigned char*)lds;
    if (tid < 2) *(volatile LAS unsigned*)(ldsl + XB_LDS_OFF + 4 * tid) = 0u;
    if (blockIdx.x == 0) { unsigned* bw = (unsigned*)kargs()->ws; for (int i = tid; i < XCD_BAR_WORDS; i += 512) bw[i] = 0u; }

    { PHASE_PTRS
    {
        float* scr = (float*)(lds + wave * 16384);
        constexpr int I0 = 16 * 136, I1 = 8 * 32, I2 = 8 * 64, I3 = 16 * 32, I4 = 16 * 176, I5 = 44 * 32, I6 = 16, I7 = 16, I8 = 32;
        for (int rep_ = 0; rep_ < REP0; ++rep_)
        for (int it = gw; it < I0 + I1 + I2 + I3 + I4 + I5 + I6 + I7 + I8; it += NGW) {
            int r = it;
            if (r < I0) { transpose_item(ka->in[4], D, PROJW, WIN_T, 0, scr, r, lane); continue; } r -= I0;
            if (r < I1) { transpose_item(ka->in[16], RW, D, WBR_T, 0, scr, r, lane); continue; } r -= I1;
            if (r < I2) { transpose_item(ka->in[25], RW, 2 * D, WGLU_T, 1, scr, r, lane); continue; } r -= I2;
            if (r < I3) { transpose_item(ka->in[26], D, D, WOUT_T, 0, scr, r, lane); continue; } r -= I3;
            if (r < I4) { transpose_item(ka->in[29], D, UPW, WUP_T, 0, scr, r, lane); continue; } r -= I4;
            if (r < I5) { transpose_item(ka->in[32], DFF, D, WDN_T, 0, scr, r, lane); continue; } r -= I5;
            if (r < I6) { transpose_item(ka->in[7], 64, RW, WUPT, 0, scr, r, lane); continue; } r -= I6;
            if (r < I7) { transpose_item(ka->in[9], 64, RW, AUPT, 0, scr, r, lane); continue; } r -= I7;
            transpose_item(ka->in[10], 128, RW, GUPT, 0, scr, r, lane);
        }
        {
            const int gt = blockIdx.x * 512 + tid;
            if (gt < 2048) {
                const int g = gt >> 6, n = gt & 63;
                const float lre = fminf(ka->in[17][gt], -1e-4f), lim = ka->in[18][gt], dt = __expf(ka->in[19][g]);
                const float mag = __expf(lre * dt); float sn, cs; sincosf(lim * dt, &sn, &cs);
                const float lbr = mag * cs, lbi = mag * sn;
                LAM[gt * 2] = lbr; LAM[gt * 2 + 1] = lbi;
                const float m64 = __expf(64.f * lre * dt); float s64, c64; sincosf(64.f * lim * dt, &s64, &c64);
                LAM64[gt * 2] = m64 * c64; LAM64[gt * 2 + 1] = m64 * s64;
                const float den = lre * lre + lim * lim, nr = lbr - 1.f, ni = lbi;
                const float cr = (nr * lre + ni * lim) / den, ci = (ni * lre - nr * lim) / den;
                for (int i = 0; i < 16; ++i) { const float br = ka->in[20][gt * 16 + i], bi = ka->in[21][gt * 16 + i];
                    BRT[(size_t)(g * 128 + n) * 16 + i] = (bf16)f2bf(cr * br - ci * bi); BRT[(size_t)(g * 128 + 64 + n) * 16 + i] = (bf16)f2bf(cr * bi + ci * br); }
            }
            for (int idx = gt; idx < 32 * 16 * 128; idx += G * 512) { const int n2 = idx & 127, gh = idx >> 7;
                CRT[idx] = (bf16)f2bf(n2 < 64 ? ka->in[22][gh * 64 + n2] : -ka->in[23][gh * 64 + n2 - 64]); }
        }
        const float* g = ka->in[2];
        for (int rep_ = 0; rep_ < REP0; ++rep_)
        for (int row = gw; row < MP; row += NGW) {
            const int j = row < NREAL ? 64 : ((row - NREAL) & 63);
            v2u* o = (v2u*)(HN + (size_t)row * D) + lane;
            if (j < PADR) {
#pragma unroll
                for (int jj = 0; jj < 4; ++jj) o[64 * jj] = (v2u){0u, 0u};
                continue; }
            const float* src = j < 64 ? meta + (size_t)(j - PADR) * D : x + (size_t)row * D;
            f32x4 v[4]; float ss = 0.f;
#pragma unroll
            for (int jj = 0; jj < 4; ++jj) { v[jj] = ((const f32x4*)src)[lane + 64 * jj]; ss += (v[jj].x * v[jj].x + v[jj].y * v[jj].y) + (v[jj].z * v[jj].z + v[jj].w * v[jj].w); }
            const float rstd = rsqrtf(wave_sum(ss) * (1.f / D) + 1e-6f);
#pragma unroll
            for (int jj = 0; jj < 4; ++jj) { const f32x4 g4 = ((const f32x4*)g)[lane + 64 * jj];
                o[64 * jj] = (v2u){pk2(v[jj].x * rstd * g4.x, v[jj].y * rstd * g4.y), pk2(v[jj].z * rstd * g4.z, v[jj].w * rstd * g4.w)}; }
        }
    }
    }
    grid.sync();
    const XcdBarrier xb = xcd_barrier_post((unsigned*)kargs()->ws, (volatile LAS unsigned*)(ldsl + XB_LDS_OFF));
    { PHASE_PTRS
    { pg8::Gemm g{HN, WIN_T, MP, PROJW, D, D, D}; pg8::StaticOrder S; S.init(MP, PROJW, G, (int)blockIdx.x);
      pg8::EpiF<FStoreBf16> E{{PROJ, PROJW}};
      pg8::gemm_phase<pg8::EpiF<FStoreBf16>, pg8::StaticOrder, true, true>(ldsl, g, S, E); }
    }
    xcd_barrier(xb);
    { PHASE_PTRS
    {
        const float* mu = ka->in[5]; const float* w0 = ka->in[6]; const float* a0 = ka->in[8]; const float* k_k = ka->in[11]; const float* k_a = ka->in[12]; const float* r_k = ka->in[13];
        float* tot = (float*)(lds + MISC_OFF); float* WCs = tot + 512;
        float* WLf = (float*)(lds + 13 * OPB); float* ALf = WLf + 64 * 68;
        const int ty = wave >> 1, txb = 2 * (wave & 1), lj = lane & 15, lq = lane >> 4, y0 = 16 * ty, yy = y0 + lj;
        RawA raw;
        if ((int)blockIdx.x < NUNIT) a0_load(raw, PROJ, blockIdx.x, wave, lane);
        for (int unit = blockIdx.x; unit < NUNIT; unit += G) {
            const int c0 = unit % NCH, bh = unit / NCH, b = bh >> 3, h = bh & 7, row0 = chunk_row0(b, c0), tq = wave, c = lane, hc = h * 64 + c;
            float rs[8], ks[8], vs[8];
            {
                float rv[9], kv[9], vv[9], wdv[9], adv[9];
#pragma unroll
                for (int i = 0; i < 9; ++i) { rv[i] = bf2f(raw.r[i]); kv[i] = bf2f(raw.k[i]); vv[i] = bf2f(raw.v[i]); wdv[i] = bf2f(raw.w[i]); adv[i] = bf2f(raw.a[i]); }
                const float mur = mu[hc], muk = mu[C_K + hc], muv = mu[C_V + hc], muw = mu[C_WD + c], mua = mu[C_AD + c];
#pragma unroll
                for (int u = 0; u < 8; ++u) {
                    rs[u] = rv[u + 1] + (rv[u] - rv[u + 1]) * mur; ks[u] = kv[u + 1] + (kv[u] - kv[u + 1]) * muk; vs[u] = vv[u + 1] + (vv[u] - vv[u + 1]) * muv;
                    const float wd = wdv[u + 1] + (wdv[u] - wdv[u + 1]) * muw, ad = adv[u + 1] + (adv[u] - adv[u + 1]) * mua;
                    *(LAS bf16*)(SLOT(11) + ((8 * tq + u) * OP + c) * 2) = (bf16)f2bf(tanh_fast(wd));
                    *(LAS bf16*)(SLOT(12) + ((8 * tq + u) * OP + c) * 2) = (bf16)f2bf(ad);
                }
            }
            if (unit + G < NUNIT) a0_load(raw, PROJ, unit + G, wave, lane);
            __syncthreads();
#pragma unroll
            for (int e = 0; e < 2; ++e) {
                const int x0 = 16 * (txb + e), xs = x0 + 4 * lq;
                f32x4 aw = {0.f, 0.f, 0.f, 0.f}, aa = {0.f, 0.f, 0.f, 0.f};
#pragma unroll
                for (int kq = 0; kq < 2; ++kq) {
                    const bf16x8 fw = *(const bf16x8*)(WUPT + (size_t)(h * 64 + x0 + lj) * 64 + 32 * kq + 8 * lq);
                    const bf16x8 fa = *(const bf16x8*)(AUPT + (size_t)(h * 64 + x0 + lj) * 64 + 32 * kq + 8 * lq);
                    aw = __builtin_amdgcn_mfma_f32_16x16x32_bf16(fw, ldfrag(SLOT(11), y0, kq, lane), aw, 0, 0, 0);
                    aa = __builtin_amdgcn_mfma_f32_16x16x32_bf16(fa, ldfrag(SLOT(12), y0, kq, lane), aa, 0, 0, 0);
                }
                *(f32x4*)(WLf + yy * 68 + xs) = aw; *(f32x4*)(ALf + yy * 68 + xs) = aa;
            }
            __syncthreads();
            {
                float lw[8], av[8], cum[8];
                const float w0c = w0[hc], a0c = a0[hc], kkc = k_k[hc], kac = k_a[hc], rkc = r_k[hc];
#pragma unroll
                for (int u = 0; u < 8; ++u) { const int t = 8 * tq + u; lw[u] = -0.60653066f * sigm(w0c + WLf[t * 68 + c]); av[u] = sigm(a0c + ALf[t * 68 + c]); }
                cum[0] = lw[0];
#pragma unroll
                for (int u = 1; u < 8; ++u) cum[u] = cum[u - 1] + lw[u];
                tot[tq * 64 + c] = cum[7];
                __syncthreads();
                float off = 0.f, all = 0.f;
#pragma unroll
                for (int w = 0; w < 8; ++w) { const float tv = tot[w * 64 + c]; all += tv; off += (w < tq) ? tv : 0.f; }
                float kkdT[8], bdT[8], kdT[8];
#pragma unroll
                for (int u = 0; u < 8; ++u) {
                    const int t = 8 * tq + u; const float ci = off + cum[u], cx = ci - lw[u];
                    const float kkv = ks[u] * kkc; const float n2 = wave_sum(kkv * kkv); const float kk = kkv / fmaxf(sqrtf(n2), 1e-12f);
                    const float k2 = ks[u] * (1.f + (av[u] - 1.f) * kac), bb = kk * av[u];
                    const float em = __expf(-ci), ed = __expf(all - ci);
                    kkdT[u] = kk * __expf(cx); bdT[u] = bb * ed; kdT[u] = k2 * ed;
                    *(LAS bf16*)(SLOT(0) + (t * OP + c) * 2) = (bf16)f2bf(kkdT[u]);
                    *(LAS bf16*)(SLOT(1) + (t * OP + c) * 2) = (bf16)f2bf(bb * em);
                    *(LAS bf16*)(SLOT(2) + (t * OP + c) * 2) = (bf16)f2bf(k2 * em);
                    *(LAS bf16*)(SLOT(3) + (t * OP + c) * 2) = (bf16)f2bf(rs[u] * __expf(ci));
                    const float rk = wave_sum(rs[u] * k2 * rkc);
                    if (lane == 0) BON[(size_t)(row0 + t) * 8 + h] = rk;
                }
                *(LAS v4u*)(SLOT(4) + (c * OP + 8 * tq) * 2) = pack8(kkdT);
                *(LAS v4u*)(SLOT(5) + (c * OP + 8 * tq) * 2) = pack8(bdT);
                *(LAS v4u*)(SLOT(6) + (c * OP + 8 * tq) * 2) = pack8(kdT);
                *(LAS v4u*)(SLOT(7) + (c * OP + 8 * tq) * 2) = pack8(vs);
                if (tq == 0) WCs[c] = __expf(all);
            }
            __syncthreads();
            f32x4 Pacc[2];
#pragma unroll
            for (int e = 0; e < 2; ++e) {
                const int tx = txb + e, x0 = 16 * tx, xs = x0 + 4 * lq; const f32x4 z = {0.f, 0.f, 0.f, 0.f};
                const bool lo = tx <= ty, up = ty <= tx;
                f32x4 v = lo ? tmm(SLOT(1), x0, SLOT(0), y0, z, lane) : z;
#pragma unroll
                for (int r = 0; r < 4; ++r) { v[r] = (xs + r < yy) ? v[r] : 0.f; Pacc[e][r] = ((xs + r == yy) ? 1.f : 0.f) - v[r]; }
                st4(SLOT(11), yy, xs, v); st4(SLOT(15), yy, xs, Pacc[e]);
                v = up ? tmm(SLOT(0), x0, SLOT(1), y0, z, lane) : z;
#pragma unroll
                for (int r = 0; r < 4; ++r) v[r] = (yy < xs + r) ? v[r] : 0.f;
                st4(SLOT(12), yy, xs, v);
                v = lo ? tmm(SLOT(2), x0, SLOT(0), y0, z, lane) : z;
#pragma unroll
                for (int r = 0; r < 4; ++r) v[r] = (xs + r < yy) ? v[r] : 0.f;
                st4(SLOT(8), yy, xs, v);
                v = lo ? tmm(SLOT(1), x0, SLOT(3), y0, z, lane) : z;
#pragma unroll
                for (int r = 0; r < 4; ++r) v[r] = (xs + r <= yy) ? v[r] : 0.f;
                st4(SLOT(9), yy, xs, v);
                v = lo ? tmm(SLOT(2), x0, SLOT(3), y0, z, lane) : z;
#pragma unroll
                for (int r = 0; r < 4; ++r) v[r] = (xs + r <= yy) ? v[r] : 0.f;
                st4(SLOT(10), yy, xs, v);
            }
            __syncthreads();
#pragma unroll
            for (int e = 0; e < 2; ++e) {
                const int tx = txb + e, x0 = 16 * tx, xs = x0 + 4 * lq; const f32x4 z = {0.f, 0.f, 0.f, 0.f};
                st4(SLOT(13), yy, xs, tx <= ty ? tmmk(SLOT(12), x0, SLOT(11), y0, z, lane, tx <= 1, ty >= 2) : z);
                st4(SLOT(14), yy, xs, ty <= tx ? tmmk(SLOT(11), x0, SLOT(12), y0, z, lane, ty <= 1, tx >= 2) : z);
                st4(SLOT(1), yy, xs, tmmk(SLOT(8), x0, SLOT(7), y0, z, lane, true, tx >= 2));
            }
            __syncthreads();
#define NEUMANN_STAGE(LT_cur, L_cur, P_cur, P_nxt, L_nxt, LT_nxt, DO_SQ, DO_SQ_L) \
            _Pragma("unroll") for (int e = 0; e < 2; ++e) { \
                const int tx = txb + e, x0 = 16 * tx, xs = x0 + 4 * lq; const f32x4 z = {0.f, 0.f, 0.f, 0.f}; \
                if (tx <= ty) Pacc[e] = tmmk(SLOT(LT_cur), x0, SLOT(P_cur), y0, Pacc[e], lane, tx <= 1, ty >= 2); \
                st4(SLOT(P_nxt), yy, xs, Pacc[e]); \
                if (DO_SQ_L) st4(SLOT(L_nxt), yy, xs, tx <= ty ? tmmk(SLOT(LT_cur), x0, SLOT(L_cur), y0, z, lane, tx <= 1, ty >= 2) : z); \
                if (DO_SQ) st4(SLOT(LT_nxt), yy, xs, ty <= tx ? tmmk(SLOT(L_cur), x0, SLOT(LT_cur), y0, z, lane, ty <= 1, tx >= 2) : z); \
            } __syncthreads();
            NEUMANN_STAGE(14, 13, 15, 16, 11, 12, true, true)
            NEUMANN_STAGE(12, 11, 16, 15, 13, 14, true, true)
            NEUMANN_STAGE(14, 13, 15, 16, 11, 12, true, true)
            NEUMANN_STAGE(12, 11, 16, 15, 13, 14, true, false)
            NEUMANN_STAGE(14, 13, 15, 16, 11, 12, false, false)
#pragma unroll
            for (int e = 0; e < 2; ++e) {
                const int tx = txb + e, x0 = 16 * tx, xs = x0 + 4 * lq; const f32x4 z = {0.f, 0.f, 0.f, 0.f};
                st4(SLOT(0), yy, xs, tmmk(SLOT(16), x0, SLOT(4), y0, z, lane, true, tx >= 2));
                f32x4 v = tmmk(SLOT(16), x0, SLOT(1), y0, z, lane, true, tx >= 2);
                st4(SLOT(2), yy, xs, -v);
            }
            __syncthreads();
#pragma unroll
            for (int e = 0; e < 2; ++e) {
                const int tx = txb + e, x0 = 16 * tx, xs = x0 + 4 * lq; const f32x4 z = {0.f, 0.f, 0.f, 0.f};
                f32x4 v = tmm(SLOT(0), x0, SLOT(5), y0, z, lane);
                const float wc = WCs[yy];
#pragma unroll
                for (int r = 0; r < 4; ++r) v[r] = ((xs + r == yy) ? wc : 0.f) - v[r];
                *(v2u*)(GF + (size_t)unit * 4096 + ((ty * 2 + (tx >> 1)) * 64 + lane) * 8 + 4 * (tx & 1)) = (v2u){pk2(v[0], v[1]), pk2(v[2], v[3])};
                v = tmm(SLOT(5), x0, SLOT(2), y0, z, lane); v = tmm(SLOT(6), x0, SLOT(7), y0, v, lane);
                *(v2u*)(HF + (size_t)unit * 4096 + ((ty * 4 + tx) * 64 + lane) * 4) = (v2u){pk2(v[0], v[1]), pk2(v[2], v[3])};
                v = tmmk(SLOT(0), x0, SLOT(9), y0, z, lane, true, ty >= 2);
                { const v2u rd = *(const LAS v2u*)(SLOT(3) + (yy * OP + xs) * 2);
                  v[0] = __uint_as_float(rd.x << 16) - v[0]; v[1] = __uint_as_float(rd.x & 0xffff0000u) - v[1]; v[2] = __uint_as_float(rd.y << 16) - v[2]; v[3] = __uint_as_float(rd.y & 0xffff0000u) - v[3]; }
                *(v2u*)(QT + (size_t)unit * 4096 + yy * 64 + xs) = (v2u){pk2(v[0], v[1]), pk2(v[2], v[3])};
                v = tmmk(SLOT(2), x0, SLOT(9), y0, z, lane, true, ty >= 2); v = tmmk(SLOT(7), x0, SLOT(10), y0, v, lane, true, ty >= 2);
                *(v2u*)(YR + (size_t)(row0 + yy) * RW + h * 64 + xs) = (v2u){pk2(v[0], v[1]), pk2(v[2], v[3])};
            }
            __syncthreads();
        }
        if ((int)blockIdx.x >= NUNIT - 16 * G || G <= 64)
        for (int wu = G > 64 ? ((int)blockIdx.x - (NUNIT - 16 * G)) * 8 + wave : gw; wu < S5UNITS; wu += G > 64 ? (G - (NUNIT - 16 * G)) * 8 : NGW) s5_unit<false>(wu, PROJ, BRT, CRT, LAM, ka->in[24], ZB, X0B, ldsl + wave * 14592, lane);
    }
    }
    xcd_barrier(xb);
    { PHASE_PTRS
    for (int rep_ = 0; rep_ < REP3; ++rep_)
    for (int unit = blockIdx.x; unit < 48; unit += G) {
        if (unit < 32) {
            const int bh = unit;
            const bf16* gsrc = GF + (size_t)bh * NCH * 4096; const bf16* hsrc = HF + (size_t)bh * NCH * 4096;
            constexpr int DEPTH = 7;
            if (wave >= 4) {
                const int lt = tid - 256;
#define CH_ISSUE(step) do { const int st_ = (step) < NCH ? (step) : NCH - 1; const unsigned so_ = (unsigned)((step) & 7) * 16384u + (unsigned)(wave - 4) * 1024u; \
                    __builtin_amdgcn_global_load_lds((const unsigned*)(gsrc + (size_t)st_ * 4096 + lt * 8), (LAS unsigned*)(ldsl + so_), 16, 0, 0); \
                    __builtin_amdgcn_global_load_lds((const unsigned*)(gsrc + (size_t)st_ * 4096 + 2048 + lt * 8), (LAS unsigned*)(ldsl + so_ + 4096), 16, 0, 0); \
                    __builtin_amdgcn_global_load_lds((const unsigned*)(hsrc + (size_t)st_ * 4096 + lt * 8), (LAS unsigned*)(ldsl + so_ + 8192), 16, 0, 0); \
                    __builtin_amdgcn_global_load_lds((const unsigned*)(hsrc + (size_t)st_ * 4096 + 2048 + lt * 8), (LAS unsigned*)(ldsl + so_ + 12288), 16, 0, 0); } while (0)
                for (int s = 0; s < DEPTH; ++s) CH_ISSUE(s);
                for (int cidx = 0; cidx < NCH; ++cidx) {
                    asm volatile("s_waitcnt vmcnt(24)" ::: "memory");
                    __builtin_amdgcn_s_barrier();
                    CH_ISSUE(cidx + DEPTH);
                }
                asm volatile("s_waitcnt vmcnt(0)" ::: "memory");
            } else {
                const int vq = wave;
                f32x4 acc[4];
#pragma unroll
                for (int i = 0; i < 4; ++i) acc[i] = (f32x4){0.f, 0.f, 0.f, 0.f};
                for (int cidx = 0; cidx < NCH; ++cidx) {
                    __builtin_amdgcn_s_barrier();
                    const LAS unsigned char* base = ldsl + (cidx & 7) * 16384;
                    bf16x8 bfr[2];
#pragma unroll
                    for (int s = 0; s < 2; ++s) { v4u w; w.x = pk2(acc[2 * s][0], acc[2 * s][1]); w.y = pk2(acc[2 * s][2], acc[2 * s][3]); w.z = pk2(acc[2 * s + 1][0], acc[2 * s + 1][1]); w.w = pk2(acc[2 * s + 1][2], acc[2 * s + 1][3]);
                        bfr[s] = __builtin_bit_cast(bf16x8, w); }
                    f32x4 nacc[4];
#pragma unroll
                    for (int tk = 0; tk < 4; ++tk) {
                        const v2u hv = *(const LAS v2u*)(base + 8192 + ((vq * 4 + tk) * 64 + lane) * 8);
                        nacc[tk] = (f32x4){__uint_as_float(hv.x << 16), __uint_as_float(hv.x & 0xffff0000u), __uint_as_float(hv.y << 16), __uint_as_float(hv.y & 0xffff0000u)};
#pragma unroll
                        for (int s = 0; s < 2; ++s) nacc[tk] = __builtin_amdgcn_mfma_f32_16x16x32_bf16(*(const LAS bf16x8*)(base + ((tk * 2 + s) * 64 + lane) * 16), bfr[s], nacc[tk], 0, 0, 0);
                    }
#pragma unroll
                    for (int tk = 0; tk < 4; ++tk) { acc[tk] = nacc[tk];
                        *(v2u*)(S0B + ((size_t)bh * NCH + cidx) * 4096 + ((vq * 4 + tk) * 64 + lane) * 4) = (v2u){pk2(acc[tk][0], acc[tk][1]), pk2(acc[tk][2], acc[tk][3])}; }
                }
            }
            __syncthreads();
        } else {
            const int ch = (unit - 32) * 512 + tid, b = ch >> 11, gn = ch & 2047;
            const float l64r = LAM64[gn * 2], l64i = LAM64[gn * 2 + 1];
            const size_t cb = (size_t)b * NCH * 4096 + (gn >> 6) * 128 + (gn & 63);
            float xr = 0.f, xi = 0.f;
            for (int c0 = 0; c0 < NCH; c0 += 8) {
                float zr[8], zi[8];
#pragma unroll
                for (int u = 0; u < 8; ++u) { const int cc = c0 + u < NCH ? c0 + u : NCH - 1; zr[u] = ZB[cb + (size_t)cc * 4096]; zi[u] = ZB[cb + (size_t)cc * 4096 + 64]; }
#pragma unroll
                for (int u = 0; u < 8; ++u) if (c0 + u < NCH) {
                    X0B[cb + (size_t)(c0 + u) * 4096] = xr; X0B[cb + (size_t)(c0 + u) * 4096 + 64] = xi;
                    const float nxr = l64r * xr - l64i * xi + zr[u], nxi = l64r * xi + l64i * xr + zi[u]; xr = nxr; xi = nxi; }
            }
        }
    }
    if (blockIdx.x >= 48 && blockIdx.x < 56) { RWKV_C_DEFS const int munit = ((int)blockIdx.x - 48) * NCH; RawC rawc; c_load(rawc, PROJ, S0B, QT, YR, BON, munit, wave, lane); RWKV_C_UNIT(munit, -1); }
    if (blockIdx.x >= 56 && blockIdx.x < 60) s5_unit<true>((((int)blockIdx.x - 56) * 8 + wave) * NCH, PROJ, BRT, CRT, LAM, ka->in[24], ZB, X0B, ldsl + wave * 14592, lane);
    }
    xcd_barrier(xb);
    { PHASE_PTRS
    {
        RWKV_C_DEFS
        RawC rawc; if ((int)blockIdx.x < NB * 8 * (NCH - 1)) c_load(rawc, PROJ, S0B, QT, YR, BON, ((int)blockIdx.x >> 7) * NCH + ((int)blockIdx.x & 127) + 1, wave, lane);
        for (int u4 = blockIdx.x; u4 < NB * 8 * (NCH - 1); u4 += G) { const int unit = (u4 >> 7) * NCH + (u4 & 127) + 1, un = u4 + G, nxt = un < NB * 8 * (NCH - 1) ? (un >> 7) * NCH + (un & 127) + 1 : -1; RWKV_C_UNIT(unit, nxt); }
        for (int wu = gw; wu < S5UNITS; wu += NGW) if (wu % NCH != 0) s5_unit<true>(wu, PROJ, BRT, CRT, LAM, ka->in[24], ZB, X0B, ldsl + wave * 14592, lane);
        for (int n = gw; n < D; n += NGW) {
            const int d = 256 * (n >> 7) + (n & 127); const bf16* y0p = PROJ + (size_t)(NREAL + 62) * PROJW + C_U; float a0, a1, b0, b1;
            dot2b<512>(WGLU_T + (size_t)d * RW, y0p, y0p + PROJW, lane, a0, a1); dot2b<512>(WGLU_T + (size_t)(d + 128) * RW, y0p, y0p + PROJW, lane, b0, b1);
            if (lane == 0) { YBm[n] = a0 * sigm(b0); YBm[D + n] = a1 * sigm(b1); } }
    }
    }
    xcd_barrier(xb);
    { PHASE_PTRS
    { for (int n = gw; n < D; n += NGW) {
          const bf16* y0p = YR + (size_t)(NREAL + 62) * RW; float a0, a1; dot2b<512>(WBR_T + (size_t)n * RW, y0p, y0p + RW, lane, a0, a1);
          if (lane == 0) {
#pragma unroll
              for (int r = 0; r < 2; ++r) { const bf16* pg = PROJ + (size_t)(NREAL + 62 + r) * PROJW; MIXINm[r * D + n] = sigm(bf2f(pg[C_GA + n])) * (r ? a1 : a0) + sigm(bf2f(pg[C_GB + n])) * YBm[r * D + n]; } } }
      pg8::Gemm g{PROJ + C_U, WGLU_T, NREAL, 2 * D, RW, PROJW, RW}; pg8::StaticOrder S; S.init(NREAL, 2 * D, G, (int)blockIdx.x);
      pg8::EpiF<FGlu> E{{YB}};
      pg8::gemm_phase<pg8::EpiF<FGlu>, pg8::StaticOrder, true, true>(ldsl, g, S, E); }
    }
    xcd_barrier(xb);
    { PHASE_PTRS
    { for (int n = gw; n < D; n += NGW) { float a0, a1; dot2f<1024>(WOUT_T + (size_t)n * D, MIXINm, MIXINm + D, lane, a0, a1); if (lane == 0) { MIXm[n] = a0; MIXm[D + n] = a1; } }
      pg8::Gemm g{YR, WBR_T, NREAL, D, RW, RW, RW}; pg8::StaticOrder S; S.init(NREAL, D, G, (int)blockIdx.x);
      pg8::EpiF<FMixin> E{{PROJ, YB, MIXIN}};
      pg8::gemm_phase<pg8::EpiF<FMixin>, pg8::StaticOrder, true, true>(ldsl, g, S, E); }
    }
    xcd_barrier(xb);
    { PHASE_PTRS
    { if (gw < 2) {
          const float* mrw = MIXm + gw * D; const float* hsrc = meta + (size_t)(14 + gw) * D; const float* gp = ka->in[3]; const float* gf = ka->in[27];
          f32x4 m[4], hv[4]; float ss = 0.f;
#pragma unroll
          for (int jj = 0; jj < 4; ++jj) { m[jj] = ((const f32x4*)mrw)[lane + 64 * jj]; hv[jj] = ((const f32x4*)hsrc)[lane + 64 * jj]; ss += (m[jj].x * m[jj].x + m[jj].y * m[jj].y) + (m[jj].z * m[jj].z + m[jj].w * m[jj].w); }
          const float rstd = rsqrtf(wave_sum(ss) * (1.f / D) + 1e-6f); float s2 = 0.f;
#pragma unroll
          for (int jj = 0; jj < 4; ++jj) { const f32x4 g4 = ((const f32x4*)gp)[lane + 64 * jj]; hv[jj] = hv[jj] + m[jj] * rstd * g4; s2 += (hv[jj].x * hv[jj].x + hv[jj].y * hv[jj].y) + (hv[jj].z * hv[jj].z + hv[jj].w * hv[jj].w); }
          const float rstd2 = rsqrtf(wave_sum(s2) * (1.f / D) + 1e-6f);
#pragma unroll
          for (int jj = 0; jj < 4; ++jj) { const f32x4 g4 = ((const f32x4*)gf)[lane + 64 * jj]; ((f32x4*)(HN2m + gw * D))[lane + 64 * jj] = hv[jj] * rstd2 * g4; } }
      pg8::Gemm g{MIXIN, WOUT_T, NREAL, D, D, D, D}; pg8::StaticOrder S; S.init(NREAL, D, G, (int)blockIdx.x);
      pg8::EpiF<FStoreBf16> E{{MIX, D}};
      pg8::gemm_phase<pg8::EpiF<FStoreBf16>, pg8::StaticOrder, true, true>(ldsl, g, S, E); }
    }
    xcd_barrier(xb);
    { PHASE_PTRS
    {
        const float* gp = ka->in[3]; const float* gf = ka->in[27];
        for (int n = gw; n < DFF; n += NGW) { float a0, a1; dot2f<1024>(WUP_T + (size_t)n * D, HN2m, HN2m + D, lane, a0, a1);
            if (lane == 0) { UP[(size_t)(NREAL + 62) * UPW + n] = (bf16)f2bf(a0); UP[(size_t)(NREAL + 63) * UPW + n] = (bf16)f2bf(a1); } }
        for (int row = gw; row < NREAL; row += NGW) {
            const int j = 64;
            v2u* o = (v2u*)(HN2 + (size_t)row * D) + lane;
            if (j < PADR) {
#pragma unroll
                for (int jj = 0; jj < 4; ++jj) o[64 * jj] = (v2u){0u, 0u};
                continue; }
            const float* src = j < 64 ? meta + (size_t)(j - PADR) * D : x + (size_t)row * D;
            const v2u* mr = (const v2u*)(MIX + (size_t)row * D);
            f32x4 m[4], hv[4]; float ss = 0.f;
#pragma unroll
            for (int jj = 0; jj < 4; ++jj) { { const v2u q = mr[lane + 64 * jj]; m[jj] = (f32x4){__uint_as_float(q.x << 16), __uint_as_float(q.x & 0xffff0000u), __uint_as_float(q.y << 16), __uint_as_float(q.y & 0xffff0000u)}; } hv[jj] = ((const f32x4*)src)[lane + 64 * jj]; ss += (m[jj].x * m[jj].x + m[jj].y * m[jj].y) + (m[jj].z * m[jj].z + m[jj].w * m[jj].w); }
            const float rstd = rsqrtf(wave_sum(ss) * (1.f / D) + 1e-6f); float s2 = 0.f;
#pragma unroll
            for (int jj = 0; jj < 4; ++jj) { const f32x4 g4 = ((const f32x4*)gp)[lane + 64 * jj]; hv[jj] = hv[jj] + m[jj] * rstd * g4;
                s2 += (hv[jj].x * hv[jj].x + hv[jj].y * hv[jj].y) + (hv[jj].z * hv[jj].z + hv[jj].w * hv[jj].w); }
            const float rstd2 = rsqrtf(wave_sum(s2) * (1.f / D) + 1e-6f);
            if (j >= 64) { f32x4* od = (f32x4*)(ka->out + (size_t)row * D);
#pragma unroll
                for (int jj = 0; jj < 4; ++jj) od[lane + 64 * jj] = hv[jj]; }
#pragma unroll
            for (int jj = 0; jj < 4; ++jj) { const f32x4 g4 = ((const f32x4*)gf)[lane + 64 * jj];
                o[64 * jj] = (v2u){pk2(hv[jj].x * rstd2 * g4.x, hv[jj].y * rstd2 * g4.y), pk2(hv[jj].z * rstd2 * g4.z, hv[jj].w * rstd2 * g4.w)}; }
        }
    }
    }
    xcd_barrier(xb);
    { PHASE_PTRS
    { pg8::Gemm g{HN2, WUP_T, NREAL, UPW, D, D, D}; pg8::StaticOrder S; S.init(NREAL, UPW, G, (int)blockIdx.x);
      pg8::EpiF<FStoreBf16> E{{UP, UPW}};
      pg8::gemm_phase<pg8::EpiF<FStoreBf16>, pg8::StaticOrder, true, true>(ldsl, g, S, E); }
    }
    xcd_barrier(xb);
    { PHASE_PTRS
    {
        const float* cw = ka->in[30]; const float* cb = ka->in[31];
        const unsigned total = (unsigned)NREAL * (DFF / 8);
        for (unsigned idx = blockIdx.x * 512u + tid; idx < total; idx += (unsigned)G * 512u) {
            const int row = (int)(idx / (unsigned)(DFF / 8)), c = (int)(idx % (unsigned)(DFF / 8)) * 8, j = row & (SEQ - 1), mrow = NREAL + 63;
            const bf16* p = UP + (size_t)row * UPW + c;
            float a0[8], a1[8], a2[8], gt[8], o[8];
            unpack8(*(const v4u*)p, a0); unpack8(*(const v4u*)(p + DFF), gt);
            unpack8(*(const v4u*)(j >= 1 ? p - UPW : UP + (size_t)mrow * UPW + c), a1);
            unpack8(*(const v4u*)(j >= 2 ? p - 2 * UPW : UP + (size_t)(mrow - 1 + j) * UPW + c), a2);
#pragma unroll
            for (int e = 0; e < 8; ++e) { const float cv = cw[c + e] * a2[e] + cw[DFF + c + e] * a1[e] + cw[2 * DFF + c + e] * a0[e] + cb[c + e]; o[e] = gelu_t(cv) * gt[e]; }
            *(v4u*)(UP + (size_t)row * UPW + DFF + c) = pack8(o);
        }
    }
    }
    xcd_barrier(xb);
    { PHASE_PTRS
    { pg8::Gemm g{UP + DFF, WDN_T, NREAL, D, DFF, UPW, DFF}; pg8::StaticOrder S; S.init(NREAL, D, G, (int)blockIdx.x);
      pg8::EpiF<FStoreBf16> E{{FB, D}};
      pg8::gemm_phase<pg8::EpiF<FStoreBf16>, pg8::StaticOrder, true, true>(ldsl, g, S, E); }
    }
    xcd_barrier(xb);
    { PHASE_PTRS
    {
        const float* gq = ka->in[28];
        for (int r = gw; r < NB * SEQ; r += NGW) {
            const int row = r;
            const v2u* fr = (const v2u*)(FB + (size_t)row * D);
            f32x4 fv[4]; float ss = 0.f;
#pragma unroll
            for (int jj = 0; jj < 4; ++jj) { const v2u q = fr[lane + 64 * jj]; fv[jj] = (f32x4){__uint_as_float(q.x << 16), __uint_as_float(q.x & 0xffff0000u), __uint_as_float(q.y << 16), __uint_as_float(q.y & 0xffff0000u)};
                ss += (fv[jj].x * fv[jj].x + fv[jj].y * fv[jj].y) + (fv[jj].z * fv[jj].z + fv[jj].w * fv[jj].w); }
            const float rstd = rsqrtf(wave_sum(ss) * (1.f / D) + 1e-6f);
            f32x4* od = (f32x4*)(ka->out + (size_t)r * D);
#pragma unroll
            for (int jj = 0; jj < 4; ++jj) { const f32x4 g4 = ((const f32x4*)gq)[lane + 64 * jj]; od[lane + 64 * jj] = od[lane + 64 * jj] + fv[jj] * rstd * g4; }
        }
    }
    }
}

extern "C" void kernel_launch(void* const* d_in, const int* in_sizes, int n_in, void* d_out, int out_size, void* d_ws, size_t ws_size, hipStream_t stream) {
    static int grid = 0;
    if (grid == 0) {
        if (n_in != 33 || ws_size < WS_END) { fprintf(stderr, "kernel_launch: unexpected n_in %d / ws_size %zu\n", n_in, ws_size); grid = -1; return; }
        int dev = 0, cus = 0, per_cu = 0;
        (void)hipGetDevice(&dev); (void)hipDeviceGetAttribute(&cus, hipDeviceAttributeMultiprocessorCount, dev);
        (void)hipFuncSetAttribute((const void*)mega, hipFuncAttributeMaxDynamicSharedMemorySize, LDS_BYTES);
        (void)hipOccupancyMaxActiveBlocksPerMultiprocessor(&per_cu, (const void*)mega, 512, LDS_BYTES);
        if (per_cu < 1) { fprintf(stderr, "kernel_launch: occupancy query says %d blocks/CU\n", per_cu); per_cu = 1; }
        (void)hipGetLastError();
        grid = cus * per_cu;
    }
    if (grid < 0) return;
    Args a{};
    for (int i = 0; i < 33; ++i) a.in[i] = (const float*)d_in[i];
    a.out = (float*)d_out; a.ws = (unsigned char*)d_ws;
    void* args[] = {&a};
    hipError_t e = hipLaunchCooperativeKernel((const void*)mega, dim3(grid), dim3(512), args, LDS_BYTES, stream);
    if (e != hipSuccess) fprintf(stderr, "cooperative launch failed: %s (grid %d)\n", hipGetErrorString(e), grid);
}
```

```cpp
#include <hip/hip_runtime.h>
#include <hip/hip_cooperative_groups.h>
#include <cstdio>
#include <cstdint>
namespace cg = cooperative_groups;
#ifndef REPG
#define REPG 1
#endif
namespace pg8 {
#define PG8_LAS __attribute__((address_space(3)))
typedef unsigned short bf16_t;
typedef short bf16x8 __attribute__((ext_vector_type(8)));
typedef float f32x4 __attribute__((ext_vector_type(4)));
typedef unsigned u32x4 __attribute__((ext_vector_type(4)));
constexpr int BM = 256, BK = 64, HALF = 128, HTB = HALF * BK * 2  , STAGE_BYTES = 8 * HTB, NXCD = 8, WGM = 8;

__host__ __device__ __forceinline__ int lds_byte(int r, int c) { const int st = (r >> 4) * 2 + (c >> 5), rr = r & 15, cc = c & 31, ob = rr * 64 + cc * 2; return st * 1024 + (ob ^ (((ob >> 9) & 1) << 5)); }
__host__ __device__ __forceinline__ void stage_rc(int b, int& R, int& C) { const int st = b / 1024, sb = b % 1024, swz = sb ^ (((sb >> 9) & 1) << 5); R = (st >> 1) * 16 + swz / 64; C = (st & 1) * 32 + (swz % 64) / 2; }
__host__ __device__ __forceinline__ int perm32(int rho) { const int n = rho >> 4, i = rho & 15; return 8 * (i >> 2) + 4 * n + (i & 3); }

struct Unit { int pm, pn; };
struct Gemm { const bf16_t* A; const bf16_t* Bt; int M, N, K, lda, ldb; };

struct StaticOrder {
    int nM, nN, nwg, G, c;
    __host__ __device__ void init(int M, int N, int G_, int c_) { nM = M / BM; nN = N / BM; nwg = nM * nN; G = G_; c = c_; }
    __host__ __device__ bool next(int i, Unit& u) const {
        const long L = (long)i * G + c; if (L >= (long)nwg * REPG) return false;
        int wgid = (int)(L % nwg); { const int q = nwg / NXCD, r = nwg % NXCD, xcd = wgid % NXCD, off = wgid / NXCD; wgid = (xcd < r ? xcd * (q + 1) : r * (q + 1) + (xcd - r) * q) + off; }
        const int nig = WGM * nN, gid = wgid / nig, fm = gid * WGM, gsz = (nM - fm) < WGM ? (nM - fm) : WGM;
        u.pm = fm + ((wgid % nig) % gsz); u.pn = (wgid % nig) / gsz; return true;
    }
    __device__ __forceinline__ void a_ready(const Unit&) const {}
    __device__ __forceinline__ void done(const Unit&) const {}
};


template <class F> struct EpiF {
    static constexpr bool PERM = true, AFTER_DRAIN = false; F f;
    __device__ __forceinline__ void operator()(const f32x4 (&acc)[2][2][4][2], const Unit& u, int wr, int wc, int fr, int fq) const {
        const int cw = wc * 32 + 8 * fq;
#pragma unroll
        for (int ai = 0; ai < 2; ++ai)
#pragma unroll
            for (int m = 0; m < 4; ++m) {
                const int row = u.pm * BM + ai * HALF + wr * 64 + m * 16 + fr;
                f(row, u.pn, cw, acc[ai][0][m][0], acc[ai][0][m][1], acc[ai][1][m][0], acc[ai][1][m][1]);
            }
    }
};
template <class Epi, class Sched, bool ALIGN_EPI = false, bool SP2 = false>
__device__ __forceinline__ void gemm_phase(PG8_LAS unsigned char* lds, const Gemm g, const Sched& S, const Epi& E) {
    const int tid = threadIdx.x, wid = __builtin_amdgcn_readfirstlane(tid >> 6), lane = tid & 63, wr = wid >> 2, wc = wid & 3, fr = lane & 15, fq = lane >> 4;
    const int K = g.K, nt = K / BK;
    unsigned voffA[2], voffB[2];
#pragma unroll
    for (int i = 0; i < 2; ++i) { int R, C; stage_rc(tid * 16 + i * 8192, R, C); const int Rb = Epi::PERM ? ((R & ~31) + perm32(R & 31)) : R;
        voffA[i] = (unsigned)(R * g.lda + C) * 2u; voffB[i] = (unsigned)(Rb * g.ldb + C) * 2u; }
    const size_t kstep = (size_t)(BK * 2);
    const size_t hstepA = (size_t)HALF * g.lda * 2, hstepB = (size_t)HALF * g.ldb * 2;
    const size_t tstepA = 2 * hstepA, tstepB = 2 * hstepB;
    const unsigned ldsw = (unsigned)wid * 1024u;
    const int aoff = lds_byte(wr * 64 + fr, fq * 8), boff = lds_byte(wc * 32 + fr, fq * 8);
#define PG8_SA(b, h) (((b) * 2 + (h)) * HTB)
#define PG8_SB(b, h) ((4 + (b) * 2 + (h)) * HTB)
#define PG8_STAGE(bufoff, gbase, voff) do { _Pragma("unroll") for (int _i = 0; _i < 2; ++_i) \
        __builtin_amdgcn_global_load_lds((const unsigned*)((const char*)(gbase) + (voff)[_i]), (PG8_LAS unsigned*)(lds + (bufoff) + ldsw + _i * 8192), 16, 0, 0); } while (0)
#define PG8_LDA(dst, b, h) do { _Pragma("unroll") for (int m = 0; m < 4; ++m) _Pragma("unroll") for (int k = 0; k < 2; ++k) dst[m][k] = *(const PG8_LAS bf16x8*)(lds + PG8_SA(b, h) + aoff + m * 2048 + k * 1024); } while (0)
#define PG8_LDB(dst, b, h) do { _Pragma("unroll") for (int n = 0; n < 2; ++n) _Pragma("unroll") for (int k = 0; k < 2; ++k) dst[n][k] = *(const PG8_LAS bf16x8*)(lds + PG8_SB(b, h) + boff + n * 2048 + k * 1024); } while (0)
#define PG8_MMA(ai, bj, At, Bt) do { __builtin_amdgcn_s_setprio(1); _Pragma("unroll") for (int m = 0; m < 4; ++m) _Pragma("unroll") for (int n = 0; n < 2; ++n) _Pragma("unroll") for (int k = 0; k < 2; ++k) \
        acc[ai][bj][m][n] = __builtin_amdgcn_mfma_f32_16x16x32_bf16(Bt[n][k], At[m][k], acc[ai][bj][m][n], 0, 0, 0); __builtin_amdgcn_s_setprio(0); } while (0)
#define PG8_WAIT_V(n) asm volatile("s_waitcnt vmcnt(" #n ")" ::: "memory")
#define PG8_WAIT_L(n) asm volatile("s_waitcnt lgkmcnt(" #n ")" ::: "memory")
#define PG8_BAR __builtin_amdgcn_s_barrier()
#define PG8_SCHED __builtin_amdgcn_sched_barrier(0)
    Unit cur, nxt; int ui = 0;
    if (!S.next(0, cur)) return;
    f32x4 acc[2][2][4][2];
#pragma unroll
    for (int a = 0; a < 2; ++a)
#pragma unroll
        for (int b = 0; b < 2; ++b)
#pragma unroll
            for (int m = 0; m < 4; ++m)
#pragma unroll
                for (int n = 0; n < 2; ++n) acc[a][b][m][n] = (f32x4){0.f, 0.f, 0.f, 0.f};
    bf16x8 At[4][2], B0[2][2], B1[2][2];
    const char* cA = (const char*)g.A + (size_t)cur.pm * tstepA; const char* cB = (const char*)g.Bt + (size_t)cur.pn * tstepB;
    S.a_ready(cur);
    if constexpr (SP2) {
        PG8_STAGE(PG8_SB(0, 0), cB, voffB); PG8_STAGE(PG8_SB(0, 1), cB + hstepB, voffB); PG8_STAGE(PG8_SA(0, 0), cA, voffA); PG8_STAGE(PG8_SA(0, 1), cA + hstepA, voffA);
        if (wr == 1) PG8_BAR;
        PG8_WAIT_V(2); PG8_BAR;
        PG8_STAGE(PG8_SB(1, 0), cB + kstep, voffB); PG8_STAGE(PG8_SA(1, 0), cA + kstep, voffA); PG8_STAGE(PG8_SB(1, 1), cB + hstepB + kstep, voffB);
        PG8_WAIT_V(6); PG8_BAR;
    } else {
        PG8_STAGE(PG8_SB(0, 0), cB, voffB); PG8_STAGE(PG8_SA(0, 0), cA, voffA); PG8_STAGE(PG8_SB(0, 1), cB + hstepB, voffB); PG8_STAGE(PG8_SA(0, 1), cA + hstepA, voffA);
        if (wr == 1) PG8_BAR;
        PG8_WAIT_V(4); PG8_BAR;
        PG8_STAGE(PG8_SB(1, 0), cB + kstep, voffB); PG8_STAGE(PG8_SA(1, 0), cA + kstep, voffA); PG8_STAGE(PG8_SB(1, 1), cB + hstepB + kstep, voffB);
        PG8_WAIT_V(6); PG8_BAR;
    }
    for (;;) {
        const bool has_next = S.next(ui + 1, nxt);
        const char* nA = has_next ? (const char*)g.A + (size_t)nxt.pm * tstepA : cA; const char* nB = has_next ? (const char*)g.Bt + (size_t)nxt.pn * tstepB : cB;
        for (int t = 0; t < nt; t += 2) {
            const bool last = (t == nt - 2);
            const char* a1 = cA + (size_t)(t + 1) * kstep;
            const char* a2 = last ? nA : cA + (size_t)(t + 2) * kstep; const char* b2 = last ? nB : cB + (size_t)(t + 2) * kstep;
            const char* a3 = a2 + kstep; const char* b3 = b2 + kstep;
            if (last && has_next) S.a_ready(nxt);
            if constexpr (SP2) {
            PG8_LDB(B0, 0, 0); PG8_LDB(B1, 0, 1); PG8_SCHED; PG8_LDA(At, 0, 0); PG8_STAGE(PG8_SA(1, 1), a1 + hstepA, voffA);
            PG8_WAIT_V(8); PG8_WAIT_L(0); PG8_BAR; PG8_MMA(0, 0, At, B0); PG8_MMA(0, 1, At, B1); PG8_BAR; PG8_SCHED;
            PG8_LDA(At, 0, 1); PG8_STAGE(PG8_SB(0, 0), b2, voffB); PG8_STAGE(PG8_SB(0, 1), b2 + hstepB, voffB); PG8_STAGE(PG8_SA(0, 0), a2, voffA);
            PG8_WAIT_V(8); PG8_WAIT_L(0); PG8_BAR; PG8_MMA(1, 0, At, B0); PG8_MMA(1, 1, At, B1); PG8_BAR; PG8_SCHED;
            PG8_LDB(B0, 1, 0); PG8_LDB(B1, 1, 1); PG8_SCHED; PG8_LDA(At, 1, 0); PG8_STAGE(PG8_SA(0, 1), a2 + hstepA, voffA);
            PG8_WAIT_V(8); PG8_WAIT_L(0); PG8_BAR; PG8_MMA(0, 0, At, B0); PG8_MMA(0, 1, At, B1); PG8_BAR; PG8_SCHED;
            PG8_LDA(At, 1, 1); PG8_STAGE(PG8_SB(1, 0), b3, voffB); PG8_STAGE(PG8_SB(1, 1), b3 + hstepB, voffB); PG8_STAGE(PG8_SA(1, 0), a3, voffA);
            PG8_WAIT_V(8); PG8_WAIT_L(0); PG8_BAR; PG8_MMA(1, 0, At, B0); PG8_MMA(1, 1, At, B1); PG8_BAR; PG8_SCHED;
            } else {
            PG8_LDB(B0, 0, 0); PG8_SCHED; PG8_LDA(At, 0, 0); PG8_STAGE(PG8_SA(1, 1), a1 + hstepA, voffA);
            PG8_WAIT_L(8); PG8_BAR; PG8_WAIT_L(0); PG8_MMA(0, 0, At, B0); PG8_BAR; PG8_SCHED;
            PG8_LDB(B1, 0, 1); PG8_STAGE(PG8_SB(0, 0), b2, voffB);
            PG8_BAR; PG8_WAIT_L(0); PG8_MMA(0, 1, At, B1); PG8_BAR;
            PG8_LDA(At, 0, 1); PG8_STAGE(PG8_SA(0, 0), a2, voffA);
            PG8_BAR; PG8_WAIT_L(0); PG8_MMA(1, 0, At, B0); PG8_BAR; PG8_SCHED;
            PG8_STAGE(PG8_SB(0, 1), b2 + hstepB, voffB);
            PG8_WAIT_V(6); PG8_BAR; PG8_MMA(1, 1, At, B1); PG8_BAR;
            PG8_LDB(B0, 1, 0); PG8_SCHED; PG8_LDA(At, 1, 0); PG8_STAGE(PG8_SA(0, 1), a2 + hstepA, voffA);
            PG8_WAIT_L(8); PG8_BAR; PG8_WAIT_L(0); PG8_MMA(0, 0, At, B0); PG8_BAR; PG8_SCHED;
            PG8_LDB(B1, 1, 1); PG8_STAGE(PG8_SB(1, 0), b3, voffB);
            PG8_BAR; PG8_WAIT_L(0); PG8_MMA(0, 1, At, B1); PG8_BAR;
            PG8_LDA(At, 1, 1); PG8_STAGE(PG8_SA(1, 0), a3, voffA);
            PG8_BAR; PG8_WAIT_L(0); PG8_MMA(1, 0, At, B0); PG8_BAR; PG8_SCHED;
            PG8_STAGE(PG8_SB(1, 1), b3 + hstepB, voffB);
            PG8_WAIT_V(6); PG8_BAR; PG8_MMA(1, 1, At, B1); PG8_BAR;
            }
        }
        if constexpr (ALIGN_EPI) { if (wr == 0) PG8_BAR; }
        if constexpr (!Epi::AFTER_DRAIN) { E(acc, cur, wr, wc, fr, fq); S.done(cur); }
        if (!has_next) break;
#pragma unroll
        for (int a = 0; a < 2; ++a)
#pragma unroll
            for (int b = 0; b < 2; ++b)
#pragma unroll
                for (int m = 0; m < 4; ++m)
#pragma unroll
                    for (int n = 0; n < 2; ++n) acc[a][b][m][n] = (f32x4){0.f, 0.f, 0.f, 0.f};
        cur = nxt; cA = nA; cB = nB; ++ui;
        if constexpr (ALIGN_EPI) { if (wr == 1) PG8_BAR; }
    }
    PG8_WAIT_V(0);
    if constexpr (!ALIGN_EPI) { if (wr == 0) PG8_BAR; }
    PG8_BAR;
    if constexpr (Epi::AFTER_DRAIN) { E.fused(acc, cur, wr, wc, fr, fq, lds, wid, lane); S.done(cur); }
#undef PG8_SA
#undef PG8_SB
#undef PG8_STAGE
#undef PG8_LDA
#undef PG8_LDB
#undef PG8_MMA
#undef PG8_WAIT_V
#undef PG8_WAIT_L
#undef PG8_BAR
#undef PG8_SCHED
}
}

#ifndef REP0
#define REP0 1
#endif
#ifndef REP3
#define REP3 1
#endif
#ifndef REP8
#define REP8 1
#endif
#ifndef REP4
#define REP4 1
#endif
#ifndef REP4S
#define REP4S 1
#endif
#ifndef REP2
#define REP2 1
#endif
#ifndef REP2S
#define REP2S 1
#endif
#define LAS __attribute__((address_space(3)))
typedef unsigned short bf16;
typedef float f32x4 __attribute__((ext_vector_type(4)));
typedef unsigned v4u __attribute__((ext_vector_type(4)));
typedef unsigned v2u __attribute__((ext_vector_type(2)));

constexpr int NB = 4, SEQ = 8192, D = 1024, PADR = 48, NREAL = NB * SEQ, MP = NREAL + NB * 64;
__device__ __forceinline__ int chunk_row0(int b, int c0) { return c0 == 0 ? NREAL + 64 * b : b * SEQ + 64 * (c0 - 1); }
constexpr int RW = 512, PROJW = 4352, DFF = 2816, UPW = 2 * DFF;
constexpr int C_K = 512, C_V = 1024, C_WD = 1536, C_AD = 1600, C_GD = 1664, C_U = 1792, C_GA = 2304, C_GB = 3328;
constexpr size_t QB = (size_t)MP * 512 * 2;
constexpr size_t WO_WIN = 1u << 20, WO_WBR = WO_WIN + (size_t)PROJW * D * 2, WO_WGLU = WO_WBR + (size_t)D * RW * 2, WO_WOUT = WO_WGLU + (size_t)2 * D * RW * 2,
                 WO_WUP = WO_WOUT + (size_t)D * D * 2, WO_WDN = WO_WUP + (size_t)UPW * D * 2, WO_END = WO_WDN + (size_t)D * DFF * 2;
static_assert(WO_END <= QB, "weights fit in the first quantum");
constexpr size_t WO_WUPT = WO_END, WO_AUPT = WO_WUPT + 65536, WO_GUPT = WO_AUPT + 65536, WO_END2 = WO_GUPT + 131072;
static_assert(WO_END2 <= QB, "small tables fit in the first quantum");
constexpr size_t WS_HN = QB, WS_GF = QB, WS_HF = 2 * QB, WS_PROJ = 3 * QB, WS_YR = 11 * QB + QB / 2, WS_QT = WS_YR + QB, WS_YB = WS_QT + QB, WS_BON = WS_YB + 2 * QB, WS_END = WS_BON + (size_t)MP * 8 * 4;
constexpr size_t WS_MIXIN = QB, WS_MIX = WS_YR, WS_HN2 = QB, WS_UP = 3 * QB, WS_F = QB;
constexpr int NCH = 129, NUNIT = NB * 8 * NCH, S5UNITS = NB * 32 * NCH;
constexpr size_t WO_BRT = WO_END2, WO_CRT = WO_BRT + 131072, WO_LAM = WO_CRT + 131072, WO_LAM64 = WO_LAM + 16384, WO_END3 = WO_LAM64 + 16384;
static_assert(WO_END3 <= QB, "S5 tables fit in the first quantum");
constexpr size_t WS_Z = WS_YB, WS_X0 = WS_Z + (size_t)NB * NCH * 4096 * 4, WS_S0 = WS_X0 + (size_t)NB * NCH * 4096 * 4;
static_assert(WS_S0 + QB <= WS_YB + 2 * QB, "S0 fits in the YB region");
static_assert(WS_END <= 536870912ull, "workspace");
constexpr int OP = 72, OPB = 64 * OP * 2, MISC_OFF = 17 * OPB;
constexpr int LDS_BYTES = 159744, XB_LDS_OFF = 159488;
typedef short bf16x8 __attribute__((ext_vector_type(8)));

__device__ __forceinline__ float bf2f(unsigned h) { return __uint_as_float(h << 16); }
typedef float f32x2_t __attribute__((ext_vector_type(2))); typedef __bf16 bf16x2_t __attribute__((ext_vector_type(2)));
__device__ __forceinline__ unsigned pk2(float lo, float hi) { const f32x2_t v = {lo, hi}; const bf16x2_t b = __builtin_convertvector(v, bf16x2_t); return __builtin_bit_cast(unsigned, b); }
__device__ __forceinline__ unsigned f2bf(float f) { return pk2(f, 0.f) & 0xffffu; }
__device__ __forceinline__ void unpack8(const v4u q, float (&o)[8]) {
    o[0] = __uint_as_float(q.x << 16); o[1] = __uint_as_float(q.x & 0xffff0000u); o[2] = __uint_as_float(q.y << 16); o[3] = __uint_as_float(q.y & 0xffff0000u);
    o[4] = __uint_as_float(q.z << 16); o[5] = __uint_as_float(q.z & 0xffff0000u); o[6] = __uint_as_float(q.w << 16); o[7] = __uint_as_float(q.w & 0xffff0000u);
}
__device__ __forceinline__ v4u pack8(const float (&o)[8]) { v4u w; w.x = pk2(o[0], o[1]); w.y = pk2(o[2], o[3]); w.z = pk2(o[4], o[5]); w.w = pk2(o[6], o[7]); return w; }
template <int CTRL> __device__ __forceinline__ float dppf(float v) { return __int_as_float(__builtin_amdgcn_update_dpp(0, __float_as_int(v), CTRL, 0xf, 0xf, true)); }
__device__ __forceinline__ float wave_sum(float v) {
    v += dppf<0xB1>(v); v += dppf<0x4E>(v); v += dppf<0x141>(v); v += dppf<0x140>(v);
    const int iv = __float_as_int(v);
    return (__int_as_float(__builtin_amdgcn_readlane(iv, 0)) + __int_as_float(__builtin_amdgcn_readlane(iv, 16))) + (__int_as_float(__builtin_amdgcn_readlane(iv, 32)) + __int_as_float(__builtin_amdgcn_readlane(iv, 48)));
}
__device__ __forceinline__ float tanh_fast(float x) { return 1.f - 2.f / (__expf(2.f * x) + 1.f); }
__device__ __forceinline__ float sigm(float x) { return 1.f / (1.f + __expf(-x)); }
__device__ __forceinline__ float gelu_t(float x) { const float z = 0.7978845608f * (x + 0.044715f * x * x * x); const float t = 1.f - 2.f / (__expf(2.f * z) + 1.f); return 0.5f * x * (1.f + t); }

#define SLOT(i) (ldsl + (i) * OPB)
__device__ __forceinline__ bf16x8 ldfrag(const LAS unsigned char* buf, int r0, int ks, int lane) { return *(const LAS bf16x8*)(buf + ((r0 + (lane & 15)) * OP + 32 * ks + 8 * (lane >> 4)) * 2); }
__device__ __forceinline__ f32x4 tmm(const LAS unsigned char* X, int x0, const LAS unsigned char* Y, int y0, f32x4 acc, int lane) {
#pragma unroll
    for (int ks = 0; ks < 2; ++ks) acc = __builtin_amdgcn_mfma_f32_16x16x32_bf16(ldfrag(X, x0, ks, lane), ldfrag(Y, y0, ks, lane), acc, 0, 0, 0);
    return acc; }
__device__ __forceinline__ f32x4 tmmk(const LAS unsigned char* X, int x0, const LAS unsigned char* Y, int y0, f32x4 acc, int lane, bool k0, bool k1) {
    if (k0) acc = __builtin_amdgcn_mfma_f32_16x16x32_bf16(ldfrag(X, x0, 0, lane), ldfrag(Y, y0, 0, lane), acc, 0, 0, 0);
    if (k1) acc = __builtin_amdgcn_mfma_f32_16x16x32_bf16(ldfrag(X, x0, 1, lane), ldfrag(Y, y0, 1, lane), acc, 0, 0, 0);
    return acc; }
struct RawA { unsigned r[9], k[9], v[9], w[9], a[9]; };
__device__ __forceinline__ void a0_load(RawA& R, const unsigned short* PROJ, int unit, int tq, int c) {
    const int c0 = unit % 129, bh = unit / 129, b = bh >> 3, h = bh & 7, hc = h * 64 + c;
    const int row0 = c0 == 0 ? 32768 + 64 * b : b * 8192 + 64 * (c0 - 1), prow = (c0 == 1) ? 32768 + 64 * b + 63 : row0 - 1;
#pragma unroll
    for (int i = 0; i < 9; ++i) {
        const int rr_ = 8 * tq + i - 1; const bool valid = (c0 > 0) || (rr_ >= 0);
        const unsigned short* p = PROJ + (size_t)(rr_ >= 0 ? row0 + rr_ : (valid ? prow : row0)) * 4352;
        R.r[i] = valid ? p[hc] : 0u; R.k[i] = valid ? p[512 + hc] : 0u; R.v[i] = valid ? p[1024 + hc] : 0u; R.w[i] = valid ? p[1536 + c] : 0u; R.a[i] = valid ? p[1600 + c] : 0u;
    }
}
__device__ __forceinline__ void st4(LAS unsigned char* buf, int y, int x, f32x4 v) { *(LAS v2u*)(buf + (y * OP + x) * 2) = (v2u){pk2(v[0], v[1]), pk2(v[2], v[3])}; }
struct FStoreBf16 { bf16* O; int ldc;
    __device__ __forceinline__ void operator()(int row, int pn, int cw, f32x4 a00, f32x4 a01, f32x4 a10, f32x4 a11) const {
        bf16* p = O + (size_t)row * ldc + pn * 256 + cw;
        v4u w; w.x = pk2(a00[0], a00[1]); w.y = pk2(a00[2], a00[3]); w.z = pk2(a01[0], a01[1]); w.w = pk2(a01[2], a01[3]); *(v4u*)p = w;
        w.x = pk2(a10[0], a10[1]); w.y = pk2(a10[2], a10[3]); w.z = pk2(a11[0], a11[1]); w.w = pk2(a11[2], a11[3]); *(v4u*)(p + 128) = w; } };
struct FStoreF32 { float* O; int ldc;
    __device__ __forceinline__ void operator()(int row, int pn, int cw, f32x4 a00, f32x4 a01, f32x4 a10, f32x4 a11) const {
        float* p = O + (size_t)row * ldc + pn * 256 + cw;
        *(f32x4*)p = a00; *(f32x4*)(p + 4) = a01; *(f32x4*)(p + 128) = a10; *(f32x4*)(p + 132) = a11; } };
struct FGlu { bf16* YB;
    __device__ __forceinline__ void operator()(int row, int pn, int cw, f32x4 a00, f32x4 a01, f32x4 a10, f32x4 a11) const {
        float y[8];
#pragma unroll
        for (int e = 0; e < 4; ++e) { y[e] = a00[e] * sigm(a10[e]); y[4 + e] = a01[e] * sigm(a11[e]); }
        *(v4u*)(YB + (size_t)row * D + pn * 128 + cw) = pack8(y); } };
struct FMixin { const bf16* PROJ; const bf16* YB; bf16* MIXIN;
    __device__ __forceinline__ void one(int row, int col, f32x4 a0, f32x4 a1) const {
        float ga[8], gb[8], yb[8], o[8];
        unpack8(*(const v4u*)(PROJ + (size_t)row * PROJW + C_GA + col), ga); unpack8(*(const v4u*)(PROJ + (size_t)row * PROJW + C_GB + col), gb);
        unpack8(*(const v4u*)(YB + (size_t)row * D + col), yb);
#pragma unroll
        for (int e = 0; e < 4; ++e) { o[e] = sigm(ga[e]) * a0[e] + sigm(gb[e]) * yb[e]; o[4 + e] = sigm(ga[4 + e]) * a1[e] + sigm(gb[4 + e]) * yb[4 + e]; }
        *(v4u*)(MIXIN + (size_t)row * D + col) = pack8(o); }
    __device__ __forceinline__ void operator()(int row, int pn, int cw, f32x4 a00, f32x4 a01, f32x4 a10, f32x4 a11) const {
        one(row, pn * 256 + cw, a00, a01); one(row, pn * 256 + 128 + cw, a10, a11); } };

template <bool OUT> __device__ __forceinline__ void s5_unit(int id, bf16* PROJ, const bf16* BRT, const bf16* CRT, const float* LAM, const float* dvec, float* Z, const float* X0, LAS unsigned char* wl, int lane) {
    const int b = id / (32 * NCH), rem = id % (32 * NCH), g = rem / NCH, c0 = rem % NCH, row0 = chunk_row0(b, c0), lj = lane & 15, lq = lane >> 4, n = lane;
    LAS float* BU = (LAS float*)wl; LAS unsigned char* Xs = wl + 10240;
    const bf16x8 zf = {0, 0, 0, 0, 0, 0, 0, 0};
    bf16x8 bfrag[8];
#pragma unroll
    for (int nt = 0; nt < 8; ++nt) bfrag[nt] = lq < 2 ? *(const bf16x8*)(BRT + ((size_t)(g * 128 + 16 * nt + lj) * 16 + 8 * lq)) : zf;
    bf16x8 cfrag[4]; float dd[4];
    if (OUT) {
#pragma unroll
        for (int ks = 0; ks < 4; ++ks) cfrag[ks] = *(const bf16x8*)(CRT + ((size_t)(g * 16 + lj) * 128 + 32 * ks + 8 * lq));
#pragma unroll
        for (int r = 0; r < 4; ++r) dd[r] = dvec[g * 16 + 4 * lq + r];
    }
    const float lr = LAM[(g * 64 + n) * 2], li = LAM[(g * 64 + n) * 2 + 1];
    const size_t zi = ((size_t)(b * NCH + c0)) * 4096 + g * 128 + n;
    float xr = 0.f, xi = 0.f;
    if (OUT && c0 > 0) { xr = X0[zi]; xi = X0[zi + 64]; }
    bf16* up0 = PROJ + (size_t)(row0 + lj) * PROJW + C_U + g * 16;
    bf16x8 ufn = lq < 2 ? *(const bf16x8*)(up0 + 8 * lq) : zf; v2u u4n = {0u, 0u}; if (OUT) u4n = *(const v2u*)(up0 + 4 * lq);
#pragma unroll 1
    for (int rd = 0; rd < 4; ++rd) { const bool lastrep = true;
        bf16* up = PROJ + (size_t)(row0 + 16 * rd + lj) * PROJW + C_U + g * 16;
        const bf16x8 ufrag = ufn; const v2u u4 = u4n;
        if (rd < 3) { const bf16* upn = up + (size_t)16 * PROJW; ufn = lq < 2 ? *(const bf16x8*)(upn + 8 * lq) : zf; if (OUT) u4n = *(const v2u*)(upn + 4 * lq); }
#pragma unroll
        for (int nt = 0; nt < 8; ++nt) { const f32x4 d = __builtin_amdgcn_mfma_f32_16x16x32_bf16(ufrag, bfrag[nt], (f32x4){0.f, 0.f, 0.f, 0.f}, 0, 0, 0);
            *(LAS f32x4*)(BU + (16 * nt + lj) * 20 + 4 * lq) = d; }
        asm volatile("s_waitcnt lgkmcnt(0)" ::: "memory");
#pragma unroll
        for (int t4 = 0; t4 < 4; ++t4) {
            const f32x4 br = *(const LAS f32x4*)(BU + n * 20 + 4 * t4), bi = *(const LAS f32x4*)(BU + (64 + n) * 20 + 4 * t4);
#pragma unroll
            for (int r = 0; r < 4; ++r) {
                const float nxr = lr * xr - li * xi + br[r], nxi = lr * xi + li * xr + bi[r]; xr = nxr; xi = nxi;
                if (OUT) { *(LAS bf16*)(Xs + ((4 * t4 + r) * 136 + n) * 2) = (bf16)f2bf(xr); *(LAS bf16*)(Xs + ((4 * t4 + r) * 136 + 64 + n) * 2) = (bf16)f2bf(xi); }
            }
        }
        if (OUT) {
            asm volatile("s_waitcnt lgkmcnt(0)" ::: "memory");
            f32x4 y = {0.f, 0.f, 0.f, 0.f};
#pragma unroll
            for (int ks = 0; ks < 4; ++ks) y = __builtin_amdgcn_mfma_f32_16x16x32_bf16(cfrag[ks], *(const LAS bf16x8*)(Xs + (lj * 136 + 32 * ks + 8 * lq) * 2), y, 0, 0, 0);
            const float u0 = __uint_as_float(u4.x << 16), u1 = __uint_as_float(u4.x & 0xffff0000u), u2 = __uint_as_float(u4.y << 16), u3 = __uint_as_float(u4.y & 0xffff0000u);
            if (lastrep) *(v2u*)(up + 4 * lq) = (v2u){pk2(gelu_t(y[0] + dd[0] * u0), gelu_t(y[1] + dd[1] * u1)), pk2(gelu_t(y[2] + dd[2] * u2), gelu_t(y[3] + dd[3] * u3))};
        }
        asm volatile("s_waitcnt lgkmcnt(0)" ::: "memory");
    }
    if (!OUT) { Z[zi] = xr; Z[zi + 64] = xi; }
}

template <int K> __device__ __forceinline__ void dot2b(const bf16* wrow, const bf16* a0, const bf16* a1, int lane, float& s0, float& s1) {
    float p0 = 0.f, p1 = 0.f;
#pragma unroll
    for (int kk = 0; kk < K / 512; ++kk) { float wf[8], x0[8], x1[8]; unpack8(*(const v4u*)(wrow + kk * 512 + lane * 8), wf); unpack8(*(const v4u*)(a0 + kk * 512 + lane * 8), x0); unpack8(*(const v4u*)(a1 + kk * 512 + lane * 8), x1);
#pragma unroll
        for (int e = 0; e < 8; ++e) { p0 += wf[e] * x0[e]; p1 += wf[e] * x1[e]; } }
    s0 = wave_sum(p0); s1 = wave_sum(p1);
}
template <int K> __device__ __forceinline__ void dot2f(const bf16* wrow, const float* a0, const float* a1, int lane, float& s0, float& s1) {
    float p0 = 0.f, p1 = 0.f;
#pragma unroll
    for (int kk = 0; kk < K / 512; ++kk) { float wf[8]; unpack8(*(const v4u*)(wrow + kk * 512 + lane * 8), wf);
        const f32x4 xa = *(const f32x4*)(a0 + kk * 512 + lane * 8), xb = *(const f32x4*)(a0 + kk * 512 + lane * 8 + 4), ya = *(const f32x4*)(a1 + kk * 512 + lane * 8), yb = *(const f32x4*)(a1 + kk * 512 + lane * 8 + 4);
#pragma unroll
        for (int e = 0; e < 4; ++e) { p0 += wf[e] * xa[e] + wf[4 + e] * xb[e]; p1 += wf[e] * ya[e] + wf[4 + e] * yb[e]; } }
    s0 = wave_sum(p0); s1 = wave_sum(p1);
}

struct Args { const float* in[33]; float* out; unsigned char* ws; };

__device__ __forceinline__ void transpose_item(const float* W, int K, int N, bf16* WT, int glu, float* scr, int item, int lane) {
    const int nblk = N / 32, kb = item / nblk, nb = item % nblk, k0 = 64 * kb, n0 = 32 * nb;
#pragma unroll 8
    for (int i = 0; i < 32; ++i) { const int kk = 2 * i + (lane >> 5); scr[kk * 33 + (lane & 31)] = W[(size_t)(k0 + kk) * N + n0 + (lane & 31)]; }
    asm volatile("s_waitcnt lgkmcnt(0)" ::: "memory");
    int d0 = n0; if (glu) { const int bj = n0 / 1024, rem = n0 % 1024; d0 = 256 * (rem / 128) + 128 * bj + (rem % 128); }
    const int c = lane & 7;
#pragma unroll
    for (int j = 0; j < 4; ++j) { const int n = (lane >> 3) + 8 * j; const float* s = scr + (8 * c) * 33 + n;
        v4u o; o.x = pk2(s[0 * 33], s[1 * 33]); o.y = pk2(s[2 * 33], s[3 * 33]); o.z = pk2(s[4 * 33], s[5 * 33]); o.w = pk2(s[6 * 33], s[7 * 33]);
        *(v4u*)(WT + (size_t)(d0 + n) * K + k0 + 8 * c) = o; }
    asm volatile("s_waitcnt lgkmcnt(0)" ::: "memory");
}

__device__ __forceinline__ float shiftv(const bf16* PROJ, int row, int j, int col, float mu) {
    const float cur = bf2f(PROJ[(size_t)row * PROJW + col]); const float prev = j > 0 ? bf2f(PROJ[(size_t)(row - 1) * PROJW + col]) : 0.f;
    return cur + (prev - cur) * mu;
}

#define XB_TMO      128
#define XB_XCNT(j)  (256  + 64 * (j))
#define XB_XSUB(j)  (1280 + 64 * (j))
#define XB_XGEN(j)  (2304 + 64 * (j))
#define XB_TOP      3328
#define XB_TOPGEN   3392
#define XCD_BAR_WORDS 3456
#define XB_SPIN_CAP (1u << 18)

__device__ __forceinline__ unsigned xb_ld(unsigned* p)              { return __hip_atomic_load(p, __ATOMIC_RELAXED, __HIP_MEMORY_SCOPE_AGENT); }
__device__ __forceinline__ unsigned xb_add(unsigned* p, unsigned v) { return __hip_atomic_fetch_add(p, v, __ATOMIC_RELAXED, __HIP_MEMORY_SCOPE_AGENT); }
__device__ __forceinline__ unsigned xb_xcc_id() { return (unsigned)__builtin_amdgcn_s_getreg((3 << 11) | 20) & 0xFu; }
#define XB_SPIN(cond, bar) do { unsigned _sp = 0; while (cond) { __builtin_amdgcn_s_sleep(1); \
    if ((++_sp & 255u) == 0u) { if (xb_ld(&(bar)[XB_TMO])) break; if (_sp > XB_SPIN_CAP) { atomicAdd(&(bar)[XB_TMO], 1u); break; } } } } while (0)

struct XcdBarrier {
    unsigned* bar; unsigned x;
    volatile LAS unsigned* st;
};

__device__ __forceinline__ XcdBarrier xcd_barrier_post(unsigned* bar, volatile LAS unsigned* st) {
    XcdBarrier b; b.bar = bar; b.x = xb_xcc_id(); b.st = st;
    if (threadIdx.x == 0) (void)xb_add(&bar[XB_XCNT(b.x)], 1u);
    return b;
}
__device__ __forceinline__ void xcd_barrier_complete(unsigned* bar, unsigned x, unsigned& nloc, unsigned& nx) {
    const unsigned G = gridDim.x * gridDim.y * gridDim.z;
    unsigned sum, cnt, mine, sp = 0u;
    for (;;) {
        sum = 0u; cnt = 0u; mine = 0u;
#pragma unroll
        for (unsigned j = 0; j < 16; ++j) { const unsigned c = xb_ld(&bar[XB_XCNT(j)]); sum += c; cnt += (c > 0u) ? 1u : 0u; mine = (j == x) ? c : mine; }
        if (sum == G) break;
        __builtin_amdgcn_s_sleep(1);
        if ((++sp & 255u) == 0u) { if (xb_ld(&bar[XB_TMO])) break; if (sp > XB_SPIN_CAP) { atomicAdd(&bar[XB_TMO], 1u); break; } }
    }
    nloc = mine > 0u ? mine : 1u; nx = cnt > 0u ? cnt : 1u;
}

__device__ __forceinline__ void xcd_barrier(const XcdBarrier& b) {
    asm volatile("s_waitcnt vmcnt(0)" ::: "memory");
    __syncthreads();
    if (threadIdx.x == 0) {
        unsigned* bar = b.bar;
        __builtin_amdgcn_s_waitcnt(0);
        unsigned nloc = b.st[0], nx = b.st[1];
        if (nloc == 0u) { xcd_barrier_complete(bar, b.x, nloc, nx); b.st[0] = nloc; b.st[1] = nx; }
        const unsigned old = xb_add(&bar[XB_XSUB(b.x)], 1u);
        const unsigned gen = old / nloc;
        if (old + 1u == (gen + 1u) * nloc) {
            __builtin_amdgcn_fence(__ATOMIC_RELEASE, "agent");
            asm volatile("s_waitcnt vmcnt(0)" ::: "memory");
            const unsigned og = xb_add(&bar[XB_TOP], 1u);
            const unsigned tg = og / nx;
            if (og + 1u == (tg + 1u) * nx) xb_add(&bar[XB_TOPGEN], 1u);
            else XB_SPIN(xb_ld(&bar[XB_TOPGEN]) == tg, bar);
            __builtin_amdgcn_fence(__ATOMIC_ACQUIRE, "agent");
            xb_add(&bar[XB_XGEN(b.x)], 1u);
            asm volatile("s_waitcnt vmcnt(0)" ::: "memory");
        } else {
            XB_SPIN(xb_ld(&bar[XB_XGEN(b.x)]) == gen, bar);
            __builtin_amdgcn_fence(__ATOMIC_ACQUIRE, "agent");
            asm volatile("s_waitcnt vmcnt(0)" ::: "memory");
        }
    }
    __syncthreads();
}

typedef const __attribute__((address_space(4))) Args* KArgsP;
__device__ __forceinline__ KArgsP kargs() { KArgsP p = (KArgsP)__builtin_amdgcn_kernarg_segment_ptr(); asm volatile("" : "+s"(p)); return p; }
struct RawC { unsigned vv[9], g0[9], g1[9]; v2u s[2][2][2]; bf16x8 q[2]; v2u yl[2]; float bon[8]; };
__device__ __forceinline__ void c_load(RawC& R, const bf16* PROJ, const bf16* S0B, const bf16* QT, const bf16* YR, const float* BON, int unit, int wave, int lane) {
    const int c0 = unit % NCH, bh = unit / NCH, b = bh >> 3, h = bh & 7, row0 = chunk_row0(b, c0), prow = (c0 == 1) ? NREAL + 64 * b + 63 : row0 - 1, tq = wave, c = lane, hc = h * 64 + c;
    const int ty = wave >> 1, txb = 2 * (wave & 1), lj = lane & 15, lq = lane >> 4, yy = 16 * ty + lj;
#pragma unroll
    for (int i = 0; i < 9; ++i) {
        const bool valid = (c0 > 0) || (8 * tq + i > 0);
        const int rr_ = 8 * tq + i - 1; const bf16* p = PROJ + (size_t)(rr_ >= 0 ? row0 + rr_ : (valid ? prow : row0)) * PROJW;
        R.vv[i] = valid ? p[C_V + hc] : 0u; R.g0[i] = valid ? p[C_GD + c] : 0u; R.g1[i] = valid ? p[C_GD + 64 + c] : 0u;
    }
    const bf16* sp = S0B + (size_t)(c0 > 0 ? unit - 1 : unit) * 4096; const bf16* qp = QT + (size_t)unit * 4096;
#pragma unroll
    for (int kq = 0; kq < 2; ++kq) {
        const bf16x8 zq = {0, 0, 0, 0, 0, 0, 0, 0};
        R.q[kq] = c0 > 0 ? *(const bf16x8*)(qp + yy * 64 + 32 * kq + 8 * lq) : zq;
#pragma unroll
        for (int e = 0; e < 2; ++e) { const int tx = txb + e;
            const v2u z2 = {0u, 0u};
            R.s[e][kq][0] = c0 > 0 ? *(const v2u*)(sp + ((tx * 4 + 2 * kq + (lq >> 1)) * 64 + 16 * (2 * (lq & 1)) + lj) * 4) : z2;
            R.s[e][kq][1] = c0 > 0 ? *(const v2u*)(sp + ((tx * 4 + 2 * kq + (lq >> 1)) * 64 + 16 * (2 * (lq & 1) + 1) + lj) * 4) : z2; }
    }
#pragma unroll
    for (int e = 0; e < 2; ++e) R.yl[e] = *(const v2u*)(YR + (size_t)(row0 + yy) * RW + h * 64 + 16 * (txb + e) + 4 * lq);
#pragma unroll
    for (int u = 0; u < 8; ++u) R.bon[u] = BON[(size_t)(row0 + 8 * tq + u) * 8 + h];
}
#define RWKV_C_UNIT(unit, nxt) do { \
            const int c0 = unit % NCH, bh = unit / NCH, b = bh >> 3, h = bh & 7, row0 = chunk_row0(b, c0), tq = wave, c = lane, hc = h * 64 + c; \
            float vs[8], bon[8]; \
            { \
                float vv[9], g0[9], g1[9]; \
_Pragma("unroll") \
                for (int i = 0; i < 9; ++i) { vv[i] = bf2f(rawc.vv[i]); g0[i] = bf2f(rawc.g0[i]); g1[i] = bf2f(rawc.g1[i]); } \
_Pragma("unroll") \
                for (int u = 0; u < 8; ++u) bon[u] = rawc.bon[u]; \
                const float muv = mu[C_V + hc], mg0 = mu[C_GD + c], mg1 = mu[C_GD + 64 + c]; \
_Pragma("unroll") \
                for (int u = 0; u < 8; ++u) { \
                    vs[u] = vv[u + 1] + (vv[u] - vv[u + 1]) * muv; \
                    *(LAS bf16*)(SG + ((8 * tq + u) * 136 + c) * 2) = (bf16)f2bf(sigm(g0[u + 1] + (g0[u] - g0[u + 1]) * mg0)); \
                    *(LAS bf16*)(SG + ((8 * tq + u) * 136 + 64 + c) * 2) = (bf16)f2bf(sigm(g1[u + 1] + (g1[u] - g1[u + 1]) * mg1)); \
                } \
            } \
 \
_Pragma("unroll") \
            for (int e = 0; e < 2; ++e) { \
                const int tx = txb + e, xs = 16 * tx + 4 * lq; \
                f32x4 v = {0.f, 0.f, 0.f, 0.f}; \
_Pragma("unroll") \
                for (int kq = 0; kq < 2; ++kq) { \
                    const v4u sw = {rawc.s[e][kq][0].x, rawc.s[e][kq][0].y, rawc.s[e][kq][1].x, rawc.s[e][kq][1].y}; \
                    v = __builtin_amdgcn_mfma_f32_16x16x32_bf16(__builtin_bit_cast(bf16x8, sw), rawc.q[kq], v, 0, 0, 0); \
                } \
                const v2u yl = rawc.yl[e]; \
                v[0] += __uint_as_float(yl.x << 16); v[1] += __uint_as_float(yl.x & 0xffff0000u); v[2] += __uint_as_float(yl.y << 16); v[3] += __uint_as_float(yl.y & 0xffff0000u); \
                *(f32x4*)(Yf + yy * 68 + xs) = v; \
            } \
            if ((nxt) >= 0) c_load(rawc, PROJ, S0B, QT, YR, BON, (nxt), wave, lane); \
            __syncthreads(); \
 \
_Pragma("unroll") \
            for (int e = 0; e < 2; ++e) { \
                const int x0 = 16 * (txb + e), xs = x0 + 4 * lq; \
                f32x4 v = {0.f, 0.f, 0.f, 0.f}; \
_Pragma("unroll") \
                for (int kq = 0; kq < 4; ++kq) { \
                    const bf16x8 fg = *(const bf16x8*)(GUPT + (size_t)(h * 64 + x0 + lj) * 128 + 32 * kq + 8 * lq); \
                    const bf16x8 fs = *(const LAS bf16x8*)(SG + ((y0 + lj) * 136 + 32 * kq + 8 * lq) * 2); \
                    v = __builtin_amdgcn_mfma_f32_16x16x32_bf16(fg, fs, v, 0, 0, 0); \
                } \
                *(f32x4*)(Gf32 + yy * 68 + xs) = v; \
            } \
            __syncthreads(); \
            { \
                const float lg = ln_g[hc], lb = ln_b[hc]; \
_Pragma("unroll") \
                for (int u = 0; u < 8; ++u) { \
                    const int t = 8 * tq + u; \
                    const float y = Yf[t * 68 + c]; const float mean = wave_sum(y) * (1.f / 64.f); const float dv = y - mean; const float var = wave_sum(dv * dv) * (1.f / 64.f); \
                    const float yn = dv * rsqrtf(var + 64e-5f) * lg + lb; \
                    const float bonus = bon[u] * vs[u]; \
                    YR[(size_t)(row0 + t) * RW + hc] = (bf16)f2bf((yn + bonus) * Gf32[t * 68 + c]); \
                } \
            } \
            __syncthreads(); \
} while (0)
#define RWKV_C_DEFS const float* mu = ka->in[5]; const float* ln_g = ka->in[14]; const float* ln_b = ka->in[15]; \
        LAS unsigned char* SG = ldsl; float* Yf = (float*)(lds + 17408); float* Gf32 = Yf + 64 * 68; \
        const int ty = wave >> 1, txb = 2 * (wave & 1), lj = lane & 15, lq = lane >> 4, y0 = 16 * ty, yy = y0 + lj;
#define PHASE_PTRS KArgsP ka = kargs(); unsigned char* ws = ka->ws; \
    const float* x = ka->in[0]; const float* meta = ka->in[1]; \
    bf16* WIN_T = (bf16*)(ws + WO_WIN); bf16* WBR_T = (bf16*)(ws + WO_WBR); bf16* WGLU_T = (bf16*)(ws + WO_WGLU); bf16* WOUT_T = (bf16*)(ws + WO_WOUT); \
    bf16* WUP_T = (bf16*)(ws + WO_WUP); bf16* WDN_T = (bf16*)(ws + WO_WDN); \
    bf16* HN = (bf16*)(ws + WS_HN); bf16* PROJ = (bf16*)(ws + WS_PROJ); \
    bf16* GF = (bf16*)(ws + WS_GF); bf16* HF = (bf16*)(ws + WS_HF); bf16* YR = (bf16*)(ws + WS_YR); bf16* QT = (bf16*)(ws + WS_QT); float* BON = (float*)(ws + WS_BON); \
    bf16* BRT = (bf16*)(ws + WO_BRT); bf16* CRT = (bf16*)(ws + WO_CRT); float* LAM = (float*)(ws + WO_LAM); float* LAM64 = (float*)(ws + WO_LAM64); float* ZB = (float*)(ws + WS_Z); float* X0B = (float*)(ws + WS_X0); bf16* S0B = (bf16*)(ws + WS_S0); float* YBm = (float*)(ws + 65536); float* MIXINm = YBm + 2048; float* MIXm = YBm + 4096; float* HN2m = YBm + 6144; \
    bf16* WUPT = (bf16*)(ws + WO_WUPT); bf16* AUPT = (bf16*)(ws + WO_AUPT); bf16* GUPT = (bf16*)(ws + WO_GUPT); \
    bf16* YB = (bf16*)(ws + WS_YB); bf16* MIXIN = (bf16*)(ws + WS_MIXIN); bf16* MIX = (bf16*)(ws + WS_MIX); bf16* HN2 = (bf16*)(ws + WS_HN2); bf16* UP = (bf16*)(ws + WS_UP); bf16* FB = (bf16*)(ws + WS_F);
__global__ void __launch_bounds__(512, 2) mega(Args a_unused) {
    extern __shared__ __attribute__((aligned(16))) unsigned char lds[];
    cg::grid_group grid = cg::this_grid();
    const int tid = threadIdx.x, lane = tid & 63, wave = __builtin_amdgcn_readfirstlane(tid >> 6);
    const int G = gridDim.x, gw = blockIdx.x * 8 + wave, NGW = G * 8;
    LAS unsigned char* ldsl = (LAS unsigned char*)lds;
    if (tid < 2) *(volatile LAS unsigned*)(ldsl + XB_LDS_OFF + 4 * tid) = 0u;
    if (blockIdx.x == 0) { unsigned* bw = (unsigned*)kargs()->ws; for (int i = tid; i < XCD_BAR_WORDS; i += 512) bw[i] = 0u; }

    { PHASE_PTRS
    {
        float* scr = (float*)(lds + wave * 16384);
        constexpr int I0 = 16 * 136, I1 = 8 * 32, I2 = 8 * 64, I3 = 16 * 32, I4 = 16 * 176, I5 = 44 * 32, I6 = 16, I7 = 16, I8 = 32;
        for (int rep_ = 0; rep_ < REP0; ++rep_)
        for (int it = gw; it < I0 + I1 + I2 + I3 + I4 + I5 + I6 + I7 + I8; it += NGW) {
            int r = it;
            if (r < I0) { transpose_item(ka->in[4], D, PROJW, WIN_T, 0, scr, r, lane); continue; } r -= I0;
            if (r < I1) { transpose_item(ka->in[16], RW, D, WBR_T, 0, scr, r, lane); continue; } r -= I1;
            if (r < I2) { transpose_item(ka->in[25], RW, 2 * D, WGLU_T, 1, scr, r, lane); continue; } r -= I2;
            if (r < I3) { transpose_item(ka->in[26], D, D, WOUT_T, 0, scr, r, lane); continue; } r -= I3;
            if (r < I4) { transpose_item(ka->in[29], D, UPW, WUP_T, 0, scr, r, lane); continue; } r -= I4;
            if (r < I5) { transpose_item(ka->in[32], DFF, D, WDN_T, 0, scr, r, lane); continue; } r -= I5;
            if (r < I6) { transpose_item(ka->in[7], 64, RW, WUPT, 0, scr, r, lane); continue; } r -= I6;
            if (r < I7) { transpose_item(ka->in[9], 64, RW, AUPT, 0, scr, r, lane); continue; } r -= I7;
            transpose_item(ka->in[10], 128, RW, GUPT, 0, scr, r, lane);
        }
        {
            const int gt = blockIdx.x * 512 + tid;
            if (gt < 2048) {
                const int g = gt >> 6, n = gt & 63;
                const float lre = fminf(ka->in[17][gt], -1e-4f), lim = ka->in[18][gt], dt = __expf(ka->in[19][g]);
                const float mag = __expf(lre * dt); float sn, cs; sincosf(lim * dt, &sn, &cs);
                const float lbr = mag * cs, lbi = mag * sn;
                LAM[gt * 2] = lbr; LAM[gt * 2 + 1] = lbi;
                const float m64 = __expf(64.f * lre * dt); float s64, c64; sincosf(64.f * lim * dt, &s64, &c64);
                LAM64[gt * 2] = m64 * c64; LAM64[gt * 2 + 1] = m64 * s64;
                const float den = lre * lre + lim * lim, nr = lbr - 1.f, ni = lbi;
                const float cr = (nr * lre + ni * lim) / den, ci = (ni * lre - nr * lim) / den;
                for (int i = 0; i < 16; ++i) { const float br = ka->in[20][gt * 16 + i], bi = ka->in[21][gt * 16 + i];
                    BRT[(size_t)(g * 128 + n) * 16 + i] = (bf16)f2bf(cr * br - ci * bi); BRT[(size_t)(g * 128 + 64 + n) * 16 + i] = (bf16)f2bf(cr * bi + ci * br); }
            }
            for (int idx = gt; idx < 32 * 16 * 128; idx += G * 512) { const int n2 = idx & 127, gh = idx >> 7;
                CRT[idx] = (bf16)f2bf(n2 < 64 ? ka->in[22][gh * 64 + n2] : -ka->in[23][gh * 64 + n2 - 64]); }
        }
        const float* g = ka->in[2];
        for (int rep_ = 0; rep_ < REP0; ++rep_)
        for (int row = gw; row < MP; row += NGW) {
            const int j = row < NREAL ? 64 : ((row - NREAL) & 63);
            v2u* o = (v2u*)(HN + (size_t)row * D) + lane;
            if (j < PADR) {
#pragma unroll
                for (int jj = 0; jj < 4; ++jj) o[64 * jj] = (v2u){0u, 0u};
                continue; }
            const float* src = j < 64 ? meta + (size_t)(j - PADR) * D : x + (size_t)row * D;
            f32x4 v[4]; float ss = 0.f;
#pragma unroll
            for (int jj = 0; jj < 4; ++jj) { v[jj] = ((const f32x4*)src)[lane + 64 * jj]; ss += (v[jj].x * v[jj].x + v[jj].y * v[jj].y) + (v[jj].z * v[jj].z + v[jj].w * v[jj].w); }
            const float rstd = rsqrtf(wave_sum(ss) * (1.f / D) + 1e-6f);
#pragma unroll
            for (int jj = 0; jj < 4; ++jj) { const f32x4 g4 = ((const f32x4*)g)[lane + 64 * jj];
                o[64 * jj] = (v2u){pk2(v[jj].x * rstd * g4.x, v[jj].y * rstd * g4.y), pk2(v[jj].z * rstd * g4.z, v[jj].w * rstd * g4.w)}; }
        }
    }
    }
    grid.sync();
    const XcdBarrier xb = xcd_barrier_post((unsigned*)kargs()->ws, (volatile LAS unsigned*)(ldsl + XB_LDS_OFF));
    { PHASE_PTRS
    { pg8::Gemm g{HN, WIN_T, MP, PROJW, D, D, D}; pg8::StaticOrder S; S.init(MP, PROJW, G, (int)blockIdx.x);
      pg8::EpiF<FStoreBf16> E{{PROJ, PROJW}};
      pg8::gemm_phase<pg8::EpiF<FStoreBf16>, pg8::StaticOrder, true, true>(ldsl, g, S, E); }
    }
    xcd_barrier(xb);
    { PHASE_PTRS
    {
        const float* mu = ka->in[5]; const float* w0 = ka->in[6]; const float* a0 = ka->in[8]; const float* k_k = ka->in[11]; const float* k_a = ka->in[12]; const float* r_k = ka->in[13];
        float* tot = (float*)(lds + MISC_OFF); float* WCs = tot + 512;
        float* WLf = (float*)(lds + 13 * OPB); float* ALf = WLf + 64 * 68;
        const int ty = wave >> 1, txb = 2 * (wave & 1), lj = lane & 15, lq = lane >> 4, y0 = 16 * ty, yy = y0 + lj;
        RawA raw;
        if ((int)blockIdx.x < NUNIT) a0_load(raw, PROJ, blockIdx.x, wave, lane);
        for (int unit = blockIdx.x; unit < NUNIT; unit += G) {
            const int c0 = unit % NCH, bh = unit / NCH, b = bh >> 3, h = bh & 7, row0 = chunk_row0(b, c0), tq = wave, c = lane, hc = h * 64 + c;
            float rs[8], ks[8], vs[8];
            {
                float rv[9], kv[9], vv[9], wdv[9], adv[9];
#pragma unroll
                for (int i = 0; i < 9; ++i) { rv[i] = bf2f(raw.r[i]); kv[i] = bf2f(raw.k[i]); vv[i] = bf2f(raw.v[i]); wdv[i] = bf2f(raw.w[i]); adv[i] = bf2f(raw.a[i]); }
                const float mur = mu[hc], muk = mu[C_K + hc], muv = mu[C_V + hc], muw = mu[C_WD + c], mua = mu[C_AD + c];
#pragma unroll
                for (int u = 0; u < 8; ++u) {
                    rs[u] = rv[u + 1] + (rv[u] - rv[u + 1]) * mur; ks[u] = kv[u + 1] + (kv[u] - kv[u + 1]) * muk; vs[u] = vv[u + 1] + (vv[u] - vv[u + 1]) * muv;
                    const float wd = wdv[u + 1] + (wdv[u] - wdv[u + 1]) * muw, ad = adv[u + 1] + (adv[u] - adv[u + 1]) * mua;
                    *(LAS bf16*)(SLOT(11) + ((8 * tq + u) * OP + c) * 2) = (bf16)f2bf(tanh_fast(wd));
                    *(LAS bf16*)(SLOT(12) + ((8 * tq + u) * OP + c) * 2) = (bf16)f2bf(ad);
                }
            }
            if (unit + G < NUNIT) a0_load(raw, PROJ, unit + G, wave, lane);
            __syncthreads();
#pragma unroll
            for (int e = 0; e < 2; ++e) {
                const int x0 = 16 * (txb + e), xs = x0 + 4 * lq;
                f32x4 aw = {0.f, 0.f, 0.f, 0.f}, aa = {0.f, 0.f, 0.f, 0.f};
#pragma unroll
                for (int kq = 0; kq < 2; ++kq) {
                    const bf16x8 fw = *(const bf16x8*)(WUPT + (size_t)(h * 64 + x0 + lj) * 64 + 32 * kq + 8 * lq);
                    const bf16x8 fa = *(const bf16x8*)(AUPT + (size_t)(h * 64 + x0 + lj) * 64 + 32 * kq + 8 * lq);
                    aw = __builtin_amdgcn_mfma_f32_16x16x32_bf16(fw, ldfrag(SLOT(11), y0, kq, lane), aw, 0, 0, 0);
                    aa = __builtin_amdgcn_mfma_f32_16x16x32_bf16(fa, ldfrag(SLOT(12), y0, kq, lane), aa, 0, 0, 0);
                }
                *(f32x4*)(WLf + yy * 68 + xs) = aw; *(f32x4*)(ALf + yy * 68 + xs) = aa;
            }
            __syncthreads();
            {
                float lw[8], av[8], cum[8];
                const float w0c = w0[hc], a0c = a0[hc], kkc = k_k[hc], kac = k_a[hc], rkc = r_k[hc];
#pragma unroll
                for (int u = 0; u < 8; ++u) { const int t = 8 * tq + u; lw[u] = -0.60653066f * sigm(w0c + WLf[t * 68 + c]); av[u] = sigm(a0c + ALf[t * 68 + c]); }
                cum[0] = lw[0];
#pragma unroll
                for (int u = 1; u < 8; ++u) cum[u] = cum[u - 1] + lw[u];
                tot[tq * 64 + c] = cum[7];
                __syncthreads();
                float off = 0.f, all = 0.f;
#pragma unroll
                for (int w = 0; w < 8; ++w) { const float tv = tot[w * 64 + c]; all += tv; off += (w < tq) ? tv : 0.f; }
                float kkdT[8], bdT[8], kdT[8];
#pragma unroll
                for (int u = 0; u < 8; ++u) {
                    const int t = 8 * tq + u; const float ci = off + cum[u], cx = ci - lw[u];
                    const float kkv = ks[u] * kkc; const float n2 = wave_sum(kkv * kkv); const float kk = kkv / fmaxf(sqrtf(n2), 1e-12f);
                    const float k2 = ks[u] * (1.f + (av[u] - 1.f) * kac), bb = kk * av[u];
                    const float em = __expf(-ci), ed = __expf(all - ci);
                    kkdT[u] = kk * __expf(cx); bdT[u] = bb * ed; kdT[u] = k2 * ed;
                    *(LAS bf16*)(SLOT(0) + (t * OP + c) * 2) = (bf16)f2bf(kkdT[u]);
                    *(LAS bf16*)(SLOT(1) + (t * OP + c) * 2) = (bf16)f2bf(bb * em);
                    *(LAS bf16*)(SLOT(2) + (t * OP + c) * 2) = (bf16)f2bf(k2 * em);
                    *(LAS bf16*)(SLOT(3) + (t * OP + c) * 2) = (bf16)f2bf(rs[u] * __expf(ci));
                    const float rk = wave_sum(rs[u] * k2 * rkc);
                    if (lane == 0) BON[(size_t)(row0 + t) * 8 + h] = rk;
                }
                *(LAS v4u*)(SLOT(4) + (c * OP + 8 * tq) * 2) = pack8(kkdT);
                *(LAS v4u*)(SLOT(5) + (c * OP + 8 * tq) * 2) = pack8(bdT);
                *(LAS v4u*)(SLOT(6) + (c * OP + 8 * tq) * 2) = pack8(kdT);
                *(LAS v4u*)(SLOT(7) + (c * OP + 8 * tq) * 2) = pack8(vs);
                if (tq == 0) WCs[c] = __expf(all);
            }
            __syncthreads();
            f32x4 Pacc[2];
#pragma unroll
            for (int e = 0; e < 2; ++e) {
                const int tx = txb + e, x0 = 16 * tx, xs = x0 + 4 * lq; const f32x4 z = {0.f, 0.f, 0.f, 0.f};
                const bool lo = tx <= ty, up = ty <= tx;
                f32x4 v = lo ? tmm(SLOT(1), x0, SLOT(0), y0, z, lane) : z;
#pragma unroll
                for (int r = 0; r < 4; ++r) { v[r] = (xs + r < yy) ? v[r] : 0.f; Pacc[e][r] = ((xs + r == yy) ? 1.f : 0.f) - v[r]; }
                st4(SLOT(11), yy, xs, v); st4(SLOT(15), yy, xs, Pacc[e]);
                v = up ? tmm(SLOT(0), x0, SLOT(1), y0, z, lane) : z;
#pragma unroll
                for (int r = 0; r < 4; ++r) v[r] = (yy < xs + r) ? v[r] : 0.f;
                st4(SLOT(12), yy, xs, v);
                v = lo ? tmm(SLOT(2), x0, SLOT(0), y0, z, lane) : z;
#pragma unroll
                for (int r = 0; r < 4; ++r) v[r] = (xs + r < yy) ? v[r] : 0.f;
                st4(SLOT(8), yy, xs, v);
                v = lo ? tmm(SLOT(1), x0, SLOT(3), y0, z, lane) : z;
#pragma unroll
                for (int r = 0; r < 4; ++r) v[r] = (xs + r <= yy) ? v[r] : 0.f;
                st4(SLOT(9), yy, xs, v);
                v = lo ? tmm(SLOT(2), x0, SLOT(3), y0, z, lane) : z;
#pragma unroll
                for (int r = 0; r < 4; ++r) v[r] = (xs + r <= yy) ? v[r] : 0.f;
                st4(SLOT(10), yy, xs, v);
            }
            __syncthreads();
#pragma unroll
            for (int e = 0; e < 2; ++e) {
                const int tx = txb + e, x0 = 16 * tx, xs = x0 + 4 * lq; const f32x4 z = {0.f, 0.f, 0.f, 0.f};
                st4(SLOT(13), yy, xs, tx <= ty ? tmmk(SLOT(12), x0, SLOT(11), y0, z, lane, tx <= 1, ty >= 2) : z);
                st4(SLOT(14), yy, xs, ty <= tx ? tmmk(SLOT(11), x0, SLOT(12), y0, z, lane, ty <= 1, tx >= 2) : z);
                st4(SLOT(1), yy, xs, tmmk(SLOT(8), x0, SLOT(7), y0, z, lane, true, tx >= 2));
            }
            __syncthreads();
#define NEUMANN_STAGE(LT_cur, L_cur, P_cur, P_nxt, L_nxt, LT_nxt, DO_SQ, DO_SQ_L) \
            _Pragma("unroll") for (int e = 0; e < 2; ++e) { \
                const int tx = txb + e, x0 = 16 * tx, xs = x0 + 4 * lq; const f32x4 z = {0.f, 0.f, 0.f, 0.f}; \
                if (tx <= ty) Pacc[e] = tmmk(SLOT(LT_cur), x0, SLOT(P_cur), y0, Pacc[e], lane, tx <= 1, ty >= 2); \
                st4(SLOT(P_nxt), yy, xs, Pacc[e]); \
                if (DO_SQ_L) st4(SLOT(L_nxt), yy, xs, tx <= ty ? tmmk(SLOT(LT_cur), x0, SLOT(L_cur), y0, z, lane, tx <= 1, ty >= 2) : z); \
                if (DO_SQ) st4(SLOT(LT_nxt), yy, xs, ty <= tx ? tmmk(SLOT(L_cur), x0, SLOT(LT_cur), y0, z, lane, ty <= 1, tx >= 2) : z); \
            } __syncthreads();
            NEUMANN_STAGE(14, 13, 15, 16, 11, 12, true, true)
            NEUMANN_STAGE(12, 11, 16, 15, 13, 14, true, true)
            NEUMANN_STAGE(14, 13, 15, 16, 11, 12, true, true)
            NEUMANN_STAGE(12, 11, 16, 15, 13, 14, true, false)
            NEUMANN_STAGE(14, 13, 15, 16, 11, 12, false, false)
#pragma unroll
            for (int e = 0; e < 2; ++e) {
                const int tx = txb + e, x0 = 16 * tx, xs = x0 + 4 * lq; const f32x4 z = {0.f, 0.f, 0.f, 0.f};
                st4(SLOT(0), yy, xs, tmmk(SLOT(16), x0, SLOT(4), y0, z, lane, true, tx >= 2));
                f32x4 v = tmmk(SLOT(16), x0, SLOT(1), y0, z, lane, true, tx >= 2);
                st4(SLOT(2), yy, xs, -v);
            }
            __syncthreads();
#pragma unroll
            for (int e = 0; e < 2; ++e) {
                const int tx = txb + e, x0 = 16 * tx, xs = x0 + 4 * lq; const f32x4 z = {0.f, 0.f, 0.f, 0.f};
                f32x4 v = tmm(SLOT(0), x0, SLOT(5), y0, z, lane);
                const float wc = WCs[yy];
#pragma unroll
                for (int r = 0; r < 4; ++r) v[r] = ((xs + r == yy) ? wc : 0.f) - v[r];
                *(v2u*)(GF + (size_t)unit * 4096 + ((ty * 2 + (tx >> 1)) * 64 + lane) * 8 + 4 * (tx & 1)) = (v2u){pk2(v[0], v[1]), pk2(v[2], v[3])};
                v = tmm(SLOT(5), x0, SLOT(2), y0, z, lane); v = tmm(SLOT(6), x0, SLOT(7), y0, v, lane);
                *(v2u*)(HF + (size_t)unit * 4096 + ((ty * 4 + tx) * 64 + lane) * 4) = (v2u){pk2(v[0], v[1]), pk2(v[2], v[3])};
                v = tmmk(SLOT(0), x0, SLOT(9), y0, z, lane, true, ty >= 2);
                { const v2u rd = *(const LAS v2u*)(SLOT(3) + (yy * OP + xs) * 2);
                  v[0] = __uint_as_float(rd.x << 16) - v[0]; v[1] = __uint_as_float(rd.x & 0xffff0000u) - v[1]; v[2] = __uint_as_float(rd.y << 16) - v[2]; v[3] = __uint_as_float(rd.y & 0xffff0000u) - v[3]; }
                *(v2u*)(QT + (size_t)unit * 4096 + yy * 64 + xs) = (v2u){pk2(v[0], v[1]), pk2(v[2], v[3])};
                v = tmmk(SLOT(2), x0, SLOT(9), y0, z, lane, true, ty >= 2); v = tmmk(SLOT(7), x0, SLOT(10), y0, v, lane, true, ty >= 2);
                *(v2u*)(YR + (size_t)(row0 + yy) * RW + h * 64 + xs) = (v2u){pk2(v[0], v[1]), pk2(v[2], v[3])};
            }
            __syncthreads();
        }
        const int ex_ = NUNIT % G; const bool split_ = ex_ > 0 && 4 * ex_ <= G;
        if (!split_ || (int)blockIdx.x >= ex_)
        for (int wu = split_ ? ((int)blockIdx.x - ex_) * 8 + wave : gw; wu < S5UNITS; wu += split_ ? (G - ex_) * 8 : NGW) s5_unit<false>(wu, PROJ, BRT, CRT, LAM, ka->in[24], ZB, X0B, ldsl + wave * 14592, lane);
    }
    }
    xcd_barrier(xb);
    { PHASE_PTRS
    for (int rep_ = 0; rep_ < REP3; ++rep_)
    for (int unit = blockIdx.x; unit < 48; unit += G) {
        if (unit < 32) {
            const int bh = unit;
            const bf16* gsrc = GF + (size_t)bh * NCH * 4096; const bf16* hsrc = HF + (size_t)bh * NCH * 4096;
            constexpr int DEPTH = 7;
            if (wave >= 4) {
                const int lt = tid - 256;
#define CH_ISSUE(step) do { const int st_ = (step) < NCH ? (step) : NCH - 1; const unsigned so_ = (unsigned)((step) & 7) * 16384u + (unsigned)(wave - 4) * 1024u; \
                    __builtin_amdgcn_global_load_lds((const unsigned*)(gsrc + (size_t)st_ * 4096 + lt * 8), (LAS unsigned*)(ldsl + so_), 16, 0, 0); \
                    __builtin_amdgcn_global_load_lds((const unsigned*)(gsrc + (size_t)st_ * 4096 + 2048 + lt * 8), (LAS unsigned*)(ldsl + so_ + 4096), 16, 0, 0); \
                    __builtin_amdgcn_global_load_lds((const unsigned*)(hsrc + (size_t)st_ * 4096 + lt * 8), (LAS unsigned*)(ldsl + so_ + 8192), 16, 0, 0); \
                    __builtin_amdgcn_global_load_lds((const unsigned*)(hsrc + (size_t)st_ * 4096 + 2048 + lt * 8), (LAS unsigned*)(ldsl + so_ + 12288), 16, 0, 0); } while (0)
                for (int s = 0; s < DEPTH; ++s) CH_ISSUE(s);
                for (int cidx = 0; cidx < NCH; ++cidx) {
                    asm volatile("s_waitcnt vmcnt(24)" ::: "memory");
                    __builtin_amdgcn_s_barrier();
                    CH_ISSUE(cidx + DEPTH);
                }
                asm volatile("s_waitcnt vmcnt(0)" ::: "memory");
            } else {
                const int vq = wave;
                f32x4 acc[4];
#pragma unroll
                for (int i = 0; i < 4; ++i) acc[i] = (f32x4){0.f, 0.f, 0.f, 0.f};
                for (int cidx = 0; cidx < NCH; ++cidx) {
                    __builtin_amdgcn_s_barrier();
                    const LAS unsigned char* base = ldsl + (cidx & 7) * 16384;
                    bf16x8 bfr[2];
#pragma unroll
                    for (int s = 0; s < 2; ++s) { v4u w; w.x = pk2(acc[2 * s][0], acc[2 * s][1]); w.y = pk2(acc[2 * s][2], acc[2 * s][3]); w.z = pk2(acc[2 * s + 1][0], acc[2 * s + 1][1]); w.w = pk2(acc[2 * s + 1][2], acc[2 * s + 1][3]);
                        bfr[s] = __builtin_bit_cast(bf16x8, w); }
                    f32x4 nacc[4];
#pragma unroll
                    for (int tk = 0; tk < 4; ++tk) {
                        const v2u hv = *(const LAS v2u*)(base + 8192 + ((vq * 4 + tk) * 64 + lane) * 8);
                        nacc[tk] = (f32x4){__uint_as_float(hv.x << 16), __uint_as_float(hv.x & 0xffff0000u), __uint_as_float(hv.y << 16), __uint_as_float(hv.y & 0xffff0000u)};
#pragma unroll
                        for (int s = 0; s < 2; ++s) nacc[tk] = __builtin_amdgcn_mfma_f32_16x16x32_bf16(*(const LAS bf16x8*)(base + ((tk * 2 + s) * 64 + lane) * 16), bfr[s], nacc[tk], 0, 0, 0);
                    }
#pragma unroll
                    for (int tk = 0; tk < 4; ++tk) { acc[tk] = nacc[tk];
                        *(v2u*)(S0B + ((size_t)bh * NCH + cidx) * 4096 + ((vq * 4 + tk) * 64 + lane) * 4) = (v2u){pk2(acc[tk][0], acc[tk][1]), pk2(acc[tk][2], acc[tk][3])}; }
                }
            }
            __syncthreads();
        } else {
            const int ch = (unit - 32) * 512 + tid, b = ch >> 11, gn = ch & 2047;
            const float l64r = LAM64[gn * 2], l64i = LAM64[gn * 2 + 1];
            const size_t cb = (size_t)b * NCH * 4096 + (gn >> 6) * 128 + (gn & 63);
            float xr = 0.f, xi = 0.f;
            for (int c0 = 0; c0 < NCH; c0 += 8) {
                float zr[8], zi[8];
#pragma unroll
                for (int u = 0; u < 8; ++u) { const int cc = c0 + u < NCH ? c0 + u : NCH - 1; zr[u] = ZB[cb + (size_t)cc * 4096]; zi[u] = ZB[cb + (size_t)cc * 4096 + 64]; }
#pragma unroll
                for (int u = 0; u < 8; ++u) if (c0 + u < NCH) {
                    X0B[cb + (size_t)(c0 + u) * 4096] = xr; X0B[cb + (size_t)(c0 + u) * 4096 + 64] = xi;
                    const float nxr = l64r * xr - l64i * xi + zr[u], nxi = l64r * xi + l64i * xr + zi[u]; xr = nxr; xi = nxi; }
            }
        }
    }
    const int ksh_ = G >= 60 ? 48 : 0;
    for (int k_ = (int)blockIdx.x - ksh_; k_ >= 0 && k_ < 8; k_ += G) { RWKV_C_DEFS const int munit = k_ * NCH; RawC rawc; c_load(rawc, PROJ, S0B, QT, YR, BON, munit, wave, lane); RWKV_C_UNIT(munit, -1); }
    for (int k_ = (int)blockIdx.x - ksh_ - 8; k_ < 4; k_ += G) if (k_ >= 0) s5_unit<true>((k_ * 8 + wave) * NCH, PROJ, BRT, CRT, LAM, ka->in[24], ZB, X0B, ldsl + wave * 14592, lane);
    }
    xcd_barrier(xb);
    { PHASE_PTRS
    {
        RWKV_C_DEFS
        RawC rawc; if ((int)blockIdx.x < NB * 8 * (NCH - 1)) c_load(rawc, PROJ, S0B, QT, YR, BON, ((int)blockIdx.x >> 7) * NCH + ((int)blockIdx.x & 127) + 1, wave, lane);
        for (int u4 = blockIdx.x; u4 < NB * 8 * (NCH - 1); u4 += G) { const int unit = (u4 >> 7) * NCH + (u4 & 127) + 1, un = u4 + G, nxt = un < NB * 8 * (NCH - 1) ? (un >> 7) * NCH + (un & 127) + 1 : -1; RWKV_C_UNIT(unit, nxt); }
        for (int wu = gw; wu < S5UNITS; wu += NGW) if (wu % NCH != 0) s5_unit<true>(wu, PROJ, BRT, CRT, LAM, ka->in[24], ZB, X0B, ldsl + wave * 14592, lane);
        for (int n = gw; n < D; n += NGW) {
            const int d = 256 * (n >> 7) + (n & 127); const bf16* y0p = PROJ + (size_t)(NREAL + 62) * PROJW + C_U; float a0, a1, b0, b1;
            dot2b<512>(WGLU_T + (size_t)d * RW, y0p, y0p + PROJW, lane, a0, a1); dot2b<512>(WGLU_T + (size_t)(d + 128) * RW, y0p, y0p + PROJW, lane, b0, b1);
            if (lane == 0) { YBm[n] = a0 * sigm(b0); YBm[D + n] = a1 * sigm(b1); } }
    }
    }
    xcd_barrier(xb);
    { PHASE_PTRS
    { for (int n = gw; n < D; n += NGW) {
          const bf16* y0p = YR + (size_t)(NREAL + 62) * RW; float a0, a1; dot2b<512>(WBR_T + (size_t)n * RW, y0p, y0p + RW, lane, a0, a1);
          if (lane == 0) {
#pragma unroll
              for (int r = 0; r < 2; ++r) { const bf16* pg = PROJ + (size_t)(NREAL + 62 + r) * PROJW; MIXINm[r * D + n] = sigm(bf2f(pg[C_GA + n])) * (r ? a1 : a0) + sigm(bf2f(pg[C_GB + n])) * YBm[r * D + n]; } } }
      pg8::Gemm g{PROJ + C_U, WGLU_T, NREAL, 2 * D, RW, PROJW, RW}; pg8::StaticOrder S; S.init(NREAL, 2 * D, G, (int)blockIdx.x);
      pg8::EpiF<FGlu> E{{YB}};
      pg8::gemm_phase<pg8::EpiF<FGlu>, pg8::StaticOrder, true, true>(ldsl, g, S, E); }
    }
    xcd_barrier(xb);
    { PHASE_PTRS
    { for (int n = gw; n < D; n += NGW) { float a0, a1; dot2f<1024>(WOUT_T + (size_t)n * D, MIXINm, MIXINm + D, lane, a0, a1); if (lane == 0) { MIXm[n] = a0; MIXm[D + n] = a1; } }
      pg8::Gemm g{YR, WBR_T, NREAL, D, RW, RW, RW}; pg8::StaticOrder S; S.init(NREAL, D, G, (int)blockIdx.x);
      pg8::EpiF<FMixin> E{{PROJ, YB, MIXIN}};
      pg8::gemm_phase<pg8::EpiF<FMixin>, pg8::StaticOrder, true, true>(ldsl, g, S, E); }
    }
    xcd_barrier(xb);
    { PHASE_PTRS
    { if (gw < 2) {
          const float* mrw = MIXm + gw * D; const float* hsrc = meta + (size_t)(14 + gw) * D; const float* gp = ka->in[3]; const float* gf = ka->in[27];
          f32x4 m[4], hv[4]; float ss = 0.f;
#pragma unroll
          for (int jj = 0; jj < 4; ++jj) { m[jj] = ((const f32x4*)mrw)[lane + 64 * jj]; hv[jj] = ((const f32x4*)hsrc)[lane + 64 * jj]; ss += (m[jj].x * m[jj].x + m[jj].y * m[jj].y) + (m[jj].z * m[jj].z + m[jj].w * m[jj].w); }
          const float rstd = rsqrtf(wave_sum(ss) * (1.f / D) + 1e-6f); float s2 = 0.f;
#pragma unroll
          for (int jj = 0; jj < 4; ++jj) { const f32x4 g4 = ((const f32x4*)gp)[lane + 64 * jj]; hv[jj] = hv[jj] + m[jj] * rstd * g4; s2 += (hv[jj].x * hv[jj].x + hv[jj].y * hv[jj].y) + (hv[jj].z * hv[jj].z + hv[jj].w * hv[jj].w); }
          const float rstd2 = rsqrtf(wave_sum(s2) * (1.f / D) + 1e-6f);
#pragma unroll
          for (int jj = 0; jj < 4; ++jj) { const f32x4 g4 = ((const f32x4*)gf)[lane + 64 * jj]; ((f32x4*)(HN2m + gw * D))[lane + 64 * jj] = hv[jj] * rstd2 * g4; } }
      pg8::Gemm g{MIXIN, WOUT_T, NREAL, D, D, D, D}; pg8::StaticOrder S; S.init(NREAL, D, G, (int)blockIdx.x);
      pg8::EpiF<FStoreBf16> E{{MIX, D}};
      pg8::gemm_phase<pg8::EpiF<FStoreBf16>, pg8::StaticOrder, true, true>(ldsl, g, S, E); }
    }
    xcd_barrier(xb);
    { PHASE_PTRS
    {
        const float* gp = ka->in[3]; const float* gf = ka->in[27];
        for (int n = gw; n < DFF; n += NGW) { float a0, a1; dot2f<1024>(WUP_T + (size_t)n * D, HN2m, HN2m + D, lane, a0, a1);
            if (lane == 0) { UP[(size_t)(NREAL + 62) * UPW + n] = (bf16)f2bf(a0); UP[(size_t)(NREAL + 63) * UPW + n] = (bf16)f2bf(a1); } }
        for (int row = gw; row < NREAL; row += NGW) {
            const int j = 64;
            v2u* o = (v2u*)(HN2 + (size_t)row * D) + lane;
            if (j < PADR) {
#pragma unroll
                for (int jj = 0; jj < 4; ++jj) o[64 * jj] = (v2u){0u, 0u};
                continue; }
            const float* src = j < 64 ? meta + (size_t)(j - PADR) * D : x + (size_t)row * D;
            const v2u* mr = (const v2u*)(MIX + (size_t)row * D);
            f32x4 m[4], hv[4]; float ss = 0.f;
#pragma unroll
            for (int jj = 0; jj < 4; ++jj) { { const v2u q = mr[lane + 64 * jj]; m[jj] = (f32x4){__uint_as_float(q.x << 16), __uint_as_float(q.x & 0xffff0000u), __uint_as_float(q.y << 16), __uint_as_float(q.y & 0xffff0000u)}; } hv[jj] = ((const f32x4*)src)[lane + 64 * jj]; ss += (m[jj].x * m[jj].x + m[jj].y * m[jj].y) + (m[jj].z * m[jj].z + m[jj].w * m[jj].w); }
            const float rstd = rsqrtf(wave_sum(ss) * (1.f / D) + 1e-6f); float s2 = 0.f;
#pragma unroll
            for (int jj = 0; jj < 4; ++jj) { const f32x4 g4 = ((const f32x4*)gp)[lane + 64 * jj]; hv[jj] = hv[jj] + m[jj] * rstd * g4;
                s2 += (hv[jj].x * hv[jj].x + hv[jj].y * hv[jj].y) + (hv[jj].z * hv[jj].z + hv[jj].w * hv[jj].w); }
            const float rstd2 = rsqrtf(wave_sum(s2) * (1.f / D) + 1e-6f);
            if (j >= 64) { f32x4* od = (f32x4*)(ka->out + (size_t)row * D);
#pragma unroll
                for (int jj = 0; jj < 4; ++jj) od[lane + 64 * jj] = hv[jj]; }
#pragma unroll
            for (int jj = 0; jj < 4; ++jj) { const f32x4 g4 = ((const f32x4*)gf)[lane + 64 * jj];
                o[64 * jj] = (v2u){pk2(hv[jj].x * rstd2 * g4.x, hv[jj].y * rstd2 * g4.y), pk2(hv[jj].z * rstd2 * g4.z, hv[jj].w * rstd2 * g4.w)}; }
        }
    }
    }
    xcd_barrier(xb);
    { PHASE_PTRS
    { pg8::Gemm g{HN2, WUP_T, NREAL, UPW, D, D, D}; pg8::StaticOrder S; S.init(NREAL, UPW, G, (int)blockIdx.x);
      pg8::EpiF<FStoreBf16> E{{UP, UPW}};
      pg8::gemm_phase<pg8::EpiF<FStoreBf16>, pg8::StaticOrder, true, true>(ldsl, g, S, E); }
    }
    xcd_barrier(xb);
    { PHASE_PTRS
    {
        const float* cw = ka->in[30]; const float* cb = ka->in[31];
        const unsigned total = (unsigned)NREAL * (DFF / 8);
        for (unsigned idx = blockIdx.x * 512u + tid; idx < total; idx += (unsigned)G * 512u) {
            const int row = (int)(idx / (unsigned)(DFF / 8)), c = (int)(idx % (unsigned)(DFF / 8)) * 8, j = row & (SEQ - 1), mrow = NREAL + 63;
            const bf16* p = UP + (size_t)row * UPW + c;
            float a0[8], a1[8], a2[8], gt[8], o[8];
            unpack8(*(const v4u*)p, a0); unpack8(*(const v4u*)(p + DFF), gt);
            unpack8(*(const v4u*)(j >= 1 ? p - UPW : UP + (size_t)mrow * UPW + c), a1);
            unpack8(*(const v4u*)(j >= 2 ? p - 2 * UPW : UP + (size_t)(mrow - 1 + j) * UPW + c), a2);
#pragma unroll
            for (int e = 0; e < 8; ++e) { const float cv = cw[c + e] * a2[e] + cw[DFF + c + e] * a1[e] + cw[2 * DFF + c + e] * a0[e] + cb[c + e]; o[e] = gelu_t(cv) * gt[e]; }
            *(v4u*)(UP + (size_t)row * UPW + DFF + c) = pack8(o);
        }
    }
    }
    xcd_barrier(xb);
    { PHASE_PTRS
    { pg8::Gemm g{UP + DFF, WDN_T, NREAL, D, DFF, UPW, DFF}; pg8::StaticOrder S; S.init(NREAL, D, G, (int)blockIdx.x);
      pg8::EpiF<FStoreBf16> E{{FB, D}};
      pg8::gemm_phase<pg8::EpiF<FStoreBf16>, pg8::StaticOrder, true, true>(ldsl, g, S, E); }
    }
    xcd_barrier(xb);
    { PHASE_PTRS
    {
        const float* gq = ka->in[28];
        for (int r = gw; r < NB * SEQ; r += NGW) {
            const int row = r;
            const v2u* fr = (const v2u*)(FB + (size_t)row * D);
            f32x4 fv[4]; float ss = 0.f;
#pragma unroll
            for (int jj = 0; jj < 4; ++jj) { const v2u q = fr[lane + 64 * jj]; fv[jj] = (f32x4){__uint_as_float(q.x << 16), __uint_as_float(q.x & 0xffff0000u), __uint_as_float(q.y << 16), __uint_as_float(q.y & 0xffff0000u)};
                ss += (fv[jj].x * fv[jj].x + fv[jj].y * fv[jj].y) + (fv[jj].z * fv[jj].z + fv[jj].w * fv[jj].w); }
            const float rstd = rsqrtf(wave_sum(ss) * (1.f / D) + 1e-6f);
            f32x4* od = (f32x4*)(ka->out + (size_t)r * D);
#pragma unroll
            for (int jj = 0; jj < 4; ++jj) { const f32x4 g4 = ((const f32x4*)gq)[lane + 64 * jj]; od[lane + 64 * jj] = od[lane + 64 * jj] + fv[jj] * rstd * g4; }
        }
    }
    }
}

extern "C" void kernel_launch(void* const* d_in, const int* in_sizes, int n_in, void* d_out, int out_size, void* d_ws, size_t ws_size, hipStream_t stream) {
    static int grid = 0;
    if (grid == 0) {
        if (n_in != 33 || ws_size < WS_END) { fprintf(stderr, "kernel_launch: unexpected n_in %d / ws_size %zu\n", n_in, ws_size); grid = -1; return; }
        int dev = 0, cus = 0, per_cu = 0;
        (void)hipGetDevice(&dev); (void)hipDeviceGetAttribute(&cus, hipDeviceAttributeMultiprocessorCount, dev);
        (void)hipFuncSetAttribute((const void*)mega, hipFuncAttributeMaxDynamicSharedMemorySize, LDS_BYTES);
        (void)hipOccupancyMaxActiveBlocksPerMultiprocessor(&per_cu, (const void*)mega, 512, LDS_BYTES);
        if (per_cu < 1) { fprintf(stderr, "kernel_launch: occupancy query says %d blocks/CU\n", per_cu); per_cu = 1; }
        (void)hipGetLastError();
        grid = cus * per_cu;
    }
    if (grid < 0) return;
    Args a{};
    for (int i = 0; i < 33; ++i) a.in[i] = (const float*)d_in[i];
    a.out = (float*)d_out; a.ws = (unsigned char*)d_ws;
    void* args[] = {&a};
    hipError_t e = hipLaunchCooperativeKernel((const void*)mega, dim3(grid), dim3(512), args, LDS_BYTES, stream);
    if (e != hipSuccess) fprintf(stderr, "cooperative launch failed: %s (grid %d)\n", hipGetErrorString(e), grid);
}
```
